# Optimizing an MI355X kernel written in HIP

```python
import jax, jax.numpy as jnp
from jax import lax
import numpy as np

D_MODEL = 1024
BATCH = 2
SEQ = 8192
DEPTH = 4
DEC_BATCH = 8
DEC_SEQ = 4096
PAST_LEN = 128

HEAD_DIM = 128
N_HEADS = D_MODEL // HEAD_DIM
N_KV_HEADS = 2
GROUP = N_HEADS // N_KV_HEADS
Q_DIM = N_HEADS * HEAD_DIM
KV_DIM = N_KV_HEADS * HEAD_DIM
QKV_DIM = Q_DIM + 2 * KV_DIM
Q_BLOCK = 128
GRID_W = 64
AXIS_ROT_DIM = HEAD_DIM // 2
ROPE_THETA = 10000.0
N_FGROUPS = 8
FGROUP_DIM = D_MODEL // N_FGROUPS
D_FF = ((8 * D_MODEL + 3 * 256 - 1) // (3 * 256)) * 256
N_FOURIER_LAYERS = (DEPTH + 1) // 2
N_ATTN_LAYERS = DEPTH // 2
EPS = 1e-6

kernel_name = "fnet_gqa_axial_interleaved_encoder"


def rms_norm(x, g):
    xf = x.astype(jnp.float32)
    y = xf * lax.rsqrt(jnp.mean(xf * xf, axis=-1, keepdims=True) + EPS)
    return (y * g.astype(jnp.float32)).astype(x.dtype)


def axial_rope_tables(seq_len):
    rows = seq_len // GRID_W
    row = jnp.repeat(jnp.arange(rows, dtype=jnp.float32), GRID_W)
    col = jnp.tile(jnp.arange(GRID_W, dtype=jnp.float32), rows)
    inv = ROPE_THETA ** (-jnp.arange(0, AXIS_ROT_DIM, 2, dtype=jnp.float32) / AXIS_ROT_DIM)
    ang = jnp.concatenate([row[:, None] * inv, col[:, None] * inv], axis=-1)
    return jnp.cos(ang), jnp.sin(ang)


def apply_rope(x, cos, sin):
    xf = x.astype(jnp.float32).reshape(*x.shape[:-1], HEAD_DIM // 2, 2)
    x0, x1 = xf[..., 0], xf[..., 1]
    c = cos[None, :, None, :]
    s = sin[None, :, None, :]
    out = jnp.stack([x0 * c - x1 * s, x0 * s + x1 * c], axis=-1).reshape(x.shape)
    return out.astype(x.dtype)


def fourier_mixer(x, g, w):
    b, s, d = x.shape
    h = rms_norm(x, g).astype(jnp.float32).reshape(b, s, N_FGROUPS, FGROUP_DIM)
    mixed = jnp.real(jnp.fft.fft2(h, axes=(1, 3), norm="ortho"))
    return mixed.reshape(b, s, d).astype(x.dtype) @ w


def attention_mixer(x, g, w_qkv, q_gain, k_gain, w_o, cos, sin):
    b, s, _ = x.shape
    h = rms_norm(x, g)
    qkv = h @ w_qkv
    q, k, v = jnp.split(qkv, [Q_DIM, Q_DIM + KV_DIM], axis=-1)
    q = apply_rope(rms_norm(q.reshape(b, s, N_HEADS, HEAD_DIM), q_gain), cos, sin)
    k = apply_rope(rms_norm(k.reshape(b, s, N_KV_HEADS, HEAD_DIM), k_gain), cos, sin)
    v = v.reshape(b, s, N_KV_HEADS, HEAD_DIM)
    n_blk = s // Q_BLOCK
    qb = q.reshape(b, n_blk, Q_BLOCK, N_KV_HEADS, GROUP, HEAD_DIM).transpose(1, 0, 2, 3, 4, 5)
    scale = HEAD_DIM ** -0.5

    def block(qi):
        sc = jnp.einsum('bqkgd,bskd->bkgqs', qi, k).astype(jnp.float32) * scale
        p = jax.nn.softmax(sc, axis=-1).astype(v.dtype)
        return jnp.einsum('bkgqs,bskd->bqkgd', p, v)

    o = lax.map(block, qb)
    o = o.transpose(1, 0, 2, 3, 4, 5).reshape(b, s, Q_DIM)
    return o @ w_o


def swiglu_ffn(x, g, w_gate, w_up, w_down):
    h = rms_norm(x, g)
    return (jax.nn.silu(h @ w_gate) * (h @ w_up)) @ w_down


def setup_inputs(seed: int = 0) -> dict:
    key = jax.random.key(seed)
    ks = jax.random.split(key, 12)
    f32 = jnp.float32
    d = D_MODEL
    return {
        "x_prompt": jax.random.normal(ks[0], (BATCH, SEQ, d), f32),
        "x_sample": jax.random.normal(ks[1], (DEC_BATCH, DEC_SEQ, d), f32),
        "norm_mix": 1.0 + 0.02 * jax.random.normal(ks[2], (DEPTH, d), f32),
        "norm_ffn": 1.0 + 0.02 * jax.random.normal(ks[3], (DEPTH, d), f32),
        "fourier_w": jax.random.normal(ks[4], (N_FOURIER_LAYERS, d, d), f32) * d ** -0.5,
        "attn_w_qkv": jax.random.normal(ks[5], (N_ATTN_LAYERS, d, QKV_DIM), f32) * d ** -0.5,
        "attn_q_norm": 1.0 + 0.02 * jax.random.normal(ks[6], (N_ATTN_LAYERS, HEAD_DIM), f32),
        "attn_k_norm": 1.0 + 0.02 * jax.random.normal(ks[7], (N_ATTN_LAYERS, HEAD_DIM), f32),
        "attn_w_o": jax.random.normal(ks[8], (N_ATTN_LAYERS, Q_DIM, d), f32) * Q_DIM ** -0.5,
        "ffn_w_gate": jax.random.normal(ks[9], (DEPTH, d, D_FF), f32) * d ** -0.5,
        "ffn_w_up": jax.random.normal(ks[10], (DEPTH, d, D_FF), f32) * d ** -0.5,
        "ffn_w_down": jax.random.normal(ks[11], (DEPTH, D_FF, d), f32) * D_FF ** -0.5,
    }


def reference(x_prompt, x_sample, norm_mix, norm_ffn, fourier_w, attn_w_qkv, attn_q_norm,
              attn_k_norm, attn_w_o, ffn_w_gate, ffn_w_up, ffn_w_down):
    def run_trunk(x):
        cos, sin = axial_rope_tables(x.shape[1])
        for i in range(DEPTH):
            j = i // 2
            if i % 2 == 0:
                x = x + fourier_mixer(x, norm_mix[i], fourier_w[j])
            else:
                x = x + attention_mixer(x, norm_mix[i], attn_w_qkv[j], attn_q_norm[j],
                                        attn_k_norm[j], attn_w_o[j], cos, sin)
            x = x + swiglu_ffn(x, norm_ffn[i], ffn_w_gate[i], ffn_w_up[i], ffn_w_down[i])
        return x

    y_prompt = run_trunk(x_prompt)
    y_sample = run_trunk(x_sample)
    return (y_prompt, y_sample)
```

```cpp
#include <hip/hip_runtime.h>
#include <hip/hip_bf16.h>
#include <hip/hip_cooperative_groups.h>
#include <cstdio>
#include <cstdint>
namespace cg = cooperative_groups;

#ifndef EN_P0
#define EN_P0 1
#endif
#ifndef EN_FFT
#define EN_FFT 1
#endif
#ifndef EN_QKV
#define EN_QKV 1
#endif
#ifndef EN_MISC
#define EN_MISC 1
#endif
#ifndef EN_ATT
#define EN_ATT 1
#endif
#ifndef EN_RES
#define EN_RES 1
#endif
#ifndef EN_GU
#define EN_GU 1
#endif
#ifndef MK_ONE_LAUNCH
#define MK_ONE_LAUNCH 1
#endif

__device__ __forceinline__ int mk_tid() { int t = threadIdx.x; asm volatile("" : "+v"(t)); return t; }
namespace pg8 {
#define PG8_LAS __attribute__((address_space(3)))
typedef unsigned short bf16_t;
typedef short bf16x8 __attribute__((ext_vector_type(8)));
typedef float f32x4 __attribute__((ext_vector_type(4)));
typedef unsigned u32x4 __attribute__((ext_vector_type(4)));
constexpr int BM = 256, BK = 64, HALF = 128, HTB = HALF * BK * 2  , STAGE_BYTES = 8 * HTB, NXCD = 8, WGM = 8;

__host__ __device__ __forceinline__ int lds_byte(int r, int c) { const int st = (r >> 4) * 2 + (c >> 5), rr = r & 15, cc = c & 31, ob = rr * 64 + cc * 2; return st * 1024 + (ob ^ (((ob >> 9) & 1) << 5)); }
__host__ __device__ __forceinline__ void stage_rc(int b, int& R, int& C) { const int st = b / 1024, sb = b % 1024, swz = sb ^ (((sb >> 9) & 1) << 5); R = (st >> 1) * 16 + swz / 64; C = (st & 1) * 32 + (swz % 64) / 2; }
__host__ __device__ __forceinline__ int perm32(int rho) { const int n = rho >> 4, i = rho & 15; return 8 * (i >> 2) + 4 * n + (i & 3); }

struct Unit { int pm, pn; };
struct Gemm { const bf16_t* A; const bf16_t* Bt; int M, N, K; };

struct StaticOrder {
    int nM, nN, nwg, G, c;
    __host__ __device__ void init(int M, int N, int G_, int c_) { nM = M / BM; nN = N / BM; nwg = nM * nN; G = G_; c = c_; }
    __host__ __device__ bool next(int i, Unit& u) const {
        const long L = (long)i * G + c; if (L >= nwg) return false;
        int wgid = (int)L; { const int q = nwg / NXCD, r = nwg % NXCD, xcd = wgid % NXCD, off = wgid / NXCD; wgid = (xcd < r ? xcd * (q + 1) : r * (q + 1) + (xcd - r) * q) + off; }
        const int nig = WGM * nN, gid = wgid / nig, fm = gid * WGM, gsz = (nM - fm) < WGM ? (nM - fm) : WGM;
        u.pm = fm + ((wgid % nig) % gsz); u.pn = (wgid % nig) / gsz; return true;
    }
    __device__ __forceinline__ void a_ready(const Unit&) const {}
    __device__ __forceinline__ void done(const Unit&) const {}
};

__device__ __forceinline__ unsigned cvt_pk_bf16(float lo, float hi) { unsigned r; asm volatile("v_cvt_pk_bf16_f32 %0, %1, %2" : "=v"(r) : "v"(lo), "v"(hi)); return r; }
typedef float f32x2 __attribute__((ext_vector_type(2)));

struct EpiRes {
    static constexpr bool PERM = false, AFTER_DRAIN = false;
    float* out; int ldc;
    __device__ __forceinline__ void operator()(const f32x4 (&acc)[2][2][4][2], const Unit& u, int wr, int wc, int fr, int fq) const {
        const int row0 = u.pm * BM + wr * 64 + fr, col0 = u.pn * BM + wc * 32 + 4 * fq;
#pragma unroll
        for (int ai = 0; ai < 2; ++ai)
#pragma unroll
            for (int m = 0; m < 4; ++m) { float* rowp = out + (size_t)(row0 + ai * HALF + m * 16) * ldc + col0;
                f32x4 bs[2][2];
#pragma unroll
                for (int bj = 0; bj < 2; ++bj)
#pragma unroll
                    for (int n = 0; n < 2; ++n) bs[bj][n] = *(const f32x4*)(rowp + bj * HALF + n * 16);
#pragma unroll
                for (int bj = 0; bj < 2; ++bj)
#pragma unroll
                    for (int n = 0; n < 2; ++n) *(f32x4*)(rowp + bj * HALF + n * 16) = bs[bj][n] + acc[ai][bj][m][n];
                if (m & 1) asm volatile("" ::: "memory"); }
    }
};
__device__ __forceinline__ float silu_mul(float g, float u) { return g * u * __builtin_amdgcn_rcpf(1.0f + __builtin_amdgcn_exp2f(-1.4426950408889634f * g)); }
struct EpiSwiGLU {
    static constexpr bool PERM = true, AFTER_DRAIN = false;
    bf16_t* H; int ldh;
    __device__ __forceinline__ void operator()(const f32x4 (&acc)[2][2][4][2], const Unit& u, int wr, int wc, int fr, int fq) const {
        const int row0 = u.pm * BM + wr * 64 + fr, col0 = u.pn * HALF + wc * 32 + 8 * fq;
#pragma unroll
        for (int ai = 0; ai < 2; ++ai)
#pragma unroll
            for (int m = 0; m < 4; ++m) { bf16_t* rowp = H + (size_t)(row0 + ai * HALF + m * 16) * ldh + col0;
                const f32x4 g0 = acc[ai][0][m][0], g1 = acc[ai][0][m][1], u0 = acc[ai][1][m][0], u1 = acc[ai][1][m][1];
                u32x4 w;
                w.x = cvt_pk_bf16(silu_mul(g0[0], u0[0]), silu_mul(g0[1], u0[1])); w.y = cvt_pk_bf16(silu_mul(g0[2], u0[2]), silu_mul(g0[3], u0[3]));
                w.z = cvt_pk_bf16(silu_mul(g1[0], u1[0]), silu_mul(g1[1], u1[1])); w.w = cvt_pk_bf16(silu_mul(g1[2], u1[2]), silu_mul(g1[3], u1[3]));
                *(u32x4*)rowp = w; }
    }
};
struct EpiQKV {
    static constexpr bool PERM = true, AFTER_DRAIN = false;
    bf16_t *Q, *K, *V;
    __device__ __forceinline__ void operator()(const f32x4 (&acc)[2][2][4][2], const Unit& u, int wr, int wc, int fr, int fq) const {
        const int row0 = u.pm * BM + wr * 64 + fr;
        bf16_t* base = u.pn < 4 ? Q + u.pn * BM : (u.pn == 4 ? K : V); const int ldc = u.pn < 4 ? 1024 : 256;
        const int col0 = wc * 32 + 8 * fq;
#pragma unroll
        for (int ai = 0; ai < 2; ++ai)
#pragma unroll
            for (int m = 0; m < 4; ++m) { bf16_t* rowp = base + (size_t)(row0 + ai * HALF + m * 16) * ldc + col0;
#pragma unroll
                for (int bj = 0; bj < 2; ++bj) { const f32x4 v0 = acc[ai][bj][m][0], v1 = acc[ai][bj][m][1]; u32x4 w;
                    w.x = cvt_pk_bf16(v0[0], v0[1]); w.y = cvt_pk_bf16(v0[2], v0[3]); w.z = cvt_pk_bf16(v1[0], v1[1]); w.w = cvt_pk_bf16(v1[2], v1[3]);
                    *(u32x4*)(rowp + bj * HALF) = w; } }
    }
};
template <class Epi, class Sched, bool ALIGN_EPI = false, bool SP2 = false>
__device__ __forceinline__ void gemm_phase(PG8_LAS unsigned char* lds, const Gemm g, const Sched& S, const Epi& E) {
    const int tid = mk_tid(), wid = __builtin_amdgcn_readfirstlane(tid >> 6), lane = tid & 63, wr = wid >> 2, wc = wid & 3, fr = lane & 15, fq = lane >> 4;
    const int K = g.K, nt = K / BK;
    unsigned voffA[2], voffB[2];
#pragma unroll
    for (int i = 0; i < 2; ++i) { int R, C; stage_rc(tid * 16 + i * 8192, R, C); const int Rb = Epi::PERM ? ((R & ~31) + perm32(R & 31)) : R;
        voffA[i] = (unsigned)(R * K + C) * 2u; voffB[i] = (unsigned)(Rb * K + C) * 2u; }
    const size_t kstep = (size_t)(BK * 2);
    const size_t hstep = (size_t)HALF * K * 2;
    const size_t tstep = 2 * hstep;
    const unsigned ldsw = (unsigned)wid * 1024u;
    const int aoff = lds_byte(wr * 64 + fr, fq * 8), boff = lds_byte(wc * 32 + fr, fq * 8);
#define PG8_SA(b, h) (((b) * 2 + (h)) * HTB)
#define PG8_SB(b, h) ((4 + (b) * 2 + (h)) * HTB)
#define PG8_STAGE(bufoff, gbase, voff) do { _Pragma("unroll") for (int _i = 0; _i < 2; ++_i) \
        __builtin_amdgcn_global_load_lds((const unsigned*)((const char*)(gbase) + (voff)[_i]), (PG8_LAS unsigned*)(lds + (bufoff) + ldsw + _i * 8192), 16, 0, 0); } while (0)
#define PG8_LDA(dst, b, h) do { _Pragma("unroll") for (int m = 0; m < 4; ++m) _Pragma("unroll") for (int k = 0; k < 2; ++k) dst[m][k] = *(const PG8_LAS bf16x8*)(lds + PG8_SA(b, h) + aoff + m * 2048 + k * 1024); } while (0)
#define PG8_LDB(dst, b, h) do { _Pragma("unroll") for (int n = 0; n < 2; ++n) _Pragma("unroll") for (int k = 0; k < 2; ++k) dst[n][k] = *(const PG8_LAS bf16x8*)(lds + PG8_SB(b, h) + boff + n * 2048 + k * 1024); } while (0)
#define PG8_MMA(ai, bj, At, Bt) do { __builtin_amdgcn_s_setprio(1); _Pragma("unroll") for (int m = 0; m < 4; ++m) _Pragma("unroll") for (int n = 0; n < 2; ++n) _Pragma("unroll") for (int k = 0; k < 2; ++k) \
        acc[ai][bj][m][n] = __builtin_amdgcn_mfma_f32_16x16x32_bf16(Bt[n][k], At[m][k], acc[ai][bj][m][n], 0, 0, 0); __builtin_amdgcn_s_setprio(0); } while (0)
#define PG8_WAIT_V(n) asm volatile("s_waitcnt vmcnt(" #n ")" ::: "memory")
#define PG8_WAIT_L(n) asm volatile("s_waitcnt lgkmcnt(" #n ")" ::: "memory")
#define PG8_BAR __builtin_amdgcn_s_barrier()
#define PG8_SCHED __builtin_amdgcn_sched_barrier(0)
    Unit cur, nxt; int ui = 0;
    if (!S.next(0, cur)) return;
    f32x4 acc[2][2][4][2];
#pragma unroll
    for (int a = 0; a < 2; ++a)
#pragma unroll
        for (int b = 0; b < 2; ++b)
#pragma unroll
            for (int m = 0; m < 4; ++m)
#pragma unroll
                for (int n = 0; n < 2; ++n) acc[a][b][m][n] = (f32x4){0.f, 0.f, 0.f, 0.f};
    bf16x8 At[4][2], B0[2][2], B1[2][2];
    const char* cA = (const char*)g.A + (size_t)cur.pm * tstep; const char* cB = (const char*)g.Bt + (size_t)cur.pn * tstep;
    S.a_ready(cur);
    if constexpr (SP2) {
        PG8_STAGE(PG8_SB(0, 0), cB, voffB); PG8_STAGE(PG8_SB(0, 1), cB + hstep, voffB); PG8_STAGE(PG8_SA(0, 0), cA, voffA); PG8_STAGE(PG8_SA(0, 1), cA + hstep, voffA);
        if (wr == 1) PG8_BAR;
        PG8_WAIT_V(2); PG8_BAR;
        PG8_STAGE(PG8_SB(1, 0), cB + kstep, voffB); PG8_STAGE(PG8_SA(1, 0), cA + kstep, voffA); PG8_STAGE(PG8_SB(1, 1), cB + hstep + kstep, voffB);
        PG8_WAIT_V(6); PG8_BAR;
    } else {
        PG8_STAGE(PG8_SB(0, 0), cB, voffB); PG8_STAGE(PG8_SA(0, 0), cA, voffA); PG8_STAGE(PG8_SB(0, 1), cB + hstep, voffB); PG8_STAGE(PG8_SA(0, 1), cA + hstep, voffA);
        if (wr == 1) PG8_BAR;
        PG8_WAIT_V(4); PG8_BAR;
        PG8_STAGE(PG8_SB(1, 0), cB + kstep, voffB); PG8_STAGE(PG8_SA(1, 0), cA + kstep, voffA); PG8_STAGE(PG8_SB(1, 1), cB + hstep + kstep, voffB);
        PG8_WAIT_V(6); PG8_BAR;
    }
    for (;;) {
        const bool has_next = S.next(ui + 1, nxt);
        const char* nA = has_next ? (const char*)g.A + (size_t)nxt.pm * tstep : cA; const char* nB = has_next ? (const char*)g.Bt + (size_t)nxt.pn * tstep : cB;
        for (int t = 0; t < nt; t += 2) {
            const bool last = (t == nt - 2);
            const char* a1 = cA + (size_t)(t + 1) * kstep;
            const char* a2 = last ? nA : cA + (size_t)(t + 2) * kstep; const char* b2 = last ? nB : cB + (size_t)(t + 2) * kstep;
            const char* a3 = a2 + kstep; const char* b3 = b2 + kstep;
            if (last && has_next) S.a_ready(nxt);
            if constexpr (SP2) {
            PG8_LDB(B0, 0, 0); PG8_LDB(B1, 0, 1); PG8_SCHED; PG8_LDA(At, 0, 0); PG8_STAGE(PG8_SA(1, 1), a1 + hstep, voffA);
            PG8_WAIT_V(8); PG8_WAIT_L(0); PG8_BAR; PG8_MMA(0, 0, At, B0); PG8_MMA(0, 1, At, B1); PG8_BAR; PG8_SCHED;
            PG8_LDA(At, 0, 1); PG8_STAGE(PG8_SB(0, 0), b2, voffB); PG8_STAGE(PG8_SB(0, 1), b2 + hstep, voffB); PG8_STAGE(PG8_SA(0, 0), a2, voffA);
            PG8_WAIT_V(8); PG8_WAIT_L(0); PG8_BAR; PG8_MMA(1, 0, At, B0); PG8_MMA(1, 1, At, B1); PG8_BAR; PG8_SCHED;
            PG8_LDB(B0, 1, 0); PG8_LDB(B1, 1, 1); PG8_SCHED; PG8_LDA(At, 1, 0); PG8_STAGE(PG8_SA(0, 1), a2 + hstep, voffA);
            PG8_WAIT_V(8); PG8_WAIT_L(0); PG8_BAR; PG8_MMA(0, 0, At, B0); PG8_MMA(0, 1, At, B1); PG8_BAR; PG8_SCHED;
            PG8_LDA(At, 1, 1); PG8_STAGE(PG8_SB(1, 0), b3, voffB); PG8_STAGE(PG8_SB(1, 1), b3 + hstep, voffB); PG8_STAGE(PG8_SA(1, 0), a3, voffA);
            PG8_WAIT_V(8); PG8_WAIT_L(0); PG8_BAR; PG8_MMA(1, 0, At, B0); PG8_MMA(1, 1, At, B1); PG8_BAR; PG8_SCHED;
            } else {
            PG8_LDB(B0, 0, 0); PG8_SCHED; PG8_LDA(At, 0, 0); PG8_STAGE(PG8_SA(1, 1), a1 + hstep, voffA);
            PG8_WAIT_L(8); PG8_BAR; PG8_WAIT_L(0); PG8_MMA(0, 0, At, B0); PG8_BAR; PG8_SCHED;
            PG8_LDB(B1, 0, 1); PG8_STAGE(PG8_SB(0, 0), b2, voffB);
            PG8_BAR; PG8_WAIT_L(0); PG8_MMA(0, 1, At, B1); PG8_BAR;
            PG8_LDA(At, 0, 1); PG8_STAGE(PG8_SA(0, 0), a2, voffA);
            PG8_BAR; PG8_WAIT_L(0); PG8_MMA(1, 0, At, B0); PG8_BAR; PG8_SCHED;
            PG8_STAGE(PG8_SB(0, 1), b2 + hstep, voffB);
            PG8_WAIT_V(6); PG8_BAR; PG8_MMA(1, 1, At, B1); PG8_BAR;
            PG8_LDB(B0, 1, 0); PG8_SCHED; PG8_LDA(At, 1, 0); PG8_STAGE(PG8_SA(0, 1), a2 + hstep, voffA);
            PG8_WAIT_L(8); PG8_BAR; PG8_WAIT_L(0); PG8_MMA(0, 0, At, B0); PG8_BAR; PG8_SCHED;
            PG8_LDB(B1, 1, 1); PG8_STAGE(PG8_SB(1, 0), b3, voffB);
            PG8_BAR; PG8_WAIT_L(0); PG8_MMA(0, 1, At, B1); PG8_BAR;
            PG8_LDA(At, 1, 1); PG8_STAGE(PG8_SA(1, 0), a3, voffA);
            PG8_BAR; PG8_WAIT_L(0); PG8_MMA(1, 0, At, B0); PG8_BAR; PG8_SCHED;
            PG8_STAGE(PG8_SB(1, 1), b3 + hstep, voffB);
            PG8_WAIT_V(6); PG8_BAR; PG8_MMA(1, 1, At, B1); PG8_BAR;
            }
        }
        if constexpr (ALIGN_EPI) { if (wr == 0) PG8_BAR; }
        if constexpr (!Epi::AFTER_DRAIN) { E(acc, cur, wr, wc, fr, fq); S.done(cur); }
        if (!has_next) break;
#pragma unroll
        for (int a = 0; a < 2; ++a)
#pragma unroll
            for (int b = 0; b < 2; ++b)
#pragma unroll
                for (int m = 0; m < 4; ++m)
#pragma unroll
                    for (int n = 0; n < 2; ++n) acc[a][b][m][n] = (f32x4){0.f, 0.f, 0.f, 0.f};
        cur = nxt; cA = nA; cB = nB; ++ui;
        if constexpr (ALIGN_EPI) { if (wr == 1) PG8_BAR; }
    }
    PG8_WAIT_V(0);
    if constexpr (!ALIGN_EPI) { if (wr == 0) PG8_BAR; }
    PG8_BAR;
    if constexpr (Epi::AFTER_DRAIN) { E.fused(acc, cur, wr, wc, fr, fq, lds, wid, lane); S.done(cur); }
#undef PG8_SA
#undef PG8_SB
#undef PG8_STAGE
#undef PG8_LDA
#undef PG8_LDB
#undef PG8_MMA
#undef PG8_WAIT_V
#undef PG8_WAIT_L
#undef PG8_BAR
#undef PG8_SCHED
}
}

namespace att {
using bf16 = __hip_bfloat16;
constexpr int   D = 128, NW = 8, QBLK = 32, KVBLK = 64;
constexpr float SCALE = 0.088388347648318440f;
constexpr float THR = 8.f;
constexpr int SDEPTH = 2;
constexpr int LDQ = 1024, LDK = 256, LDO = 1024;
constexpr size_t SHM_V = KVBLK * D * 2, SHM_K = KVBLK * D * 2, SHM_ATTN = 2 * SHM_V + 2 * SHM_K + NW * 64 * 4;
constexpr size_t OST_OFF = 69632;
using bf16x8 = __attribute__((ext_vector_type(8))) short;
using s16x4  = __attribute__((ext_vector_type(4))) short;
using f32x16 = __attribute__((ext_vector_type(16))) float;
using f32x8  = __attribute__((ext_vector_type(8))) float;
using u32x4  = __attribute__((ext_vector_type(4))) unsigned;
#define KSWZ(row, colB) ((row) * 256 + ((colB) ^ (((row) & 7) << 4)))
#define SBAR() __builtin_amdgcn_sched_barrier(0)
__device__ __forceinline__ int crow(int r, int hi) { return (r & 3) + 8 * (r >> 2) + 4 * hi; }
__device__ __forceinline__ unsigned cvtpk(float lo, float hi) {
  unsigned r; asm volatile("v_cvt_pk_bf16_f32 %0, %1, %2" : "=v"(r) : "v"(lo), "v"(hi)); return r;
}
template <typename TIn> struct Stage;
template <> struct Stage<bf16>  { using T = bf16x8;
  __device__ static __forceinline__ T ld8(const bf16* p) { return *reinterpret_cast<const bf16x8*>(p); }
  __device__ static __forceinline__ bf16x8 tobf(T x) { return x; } };
template <> struct Stage<float> { using T = f32x8;
  __device__ static __forceinline__ T ld8(const float* p) { return *reinterpret_cast<const f32x8*>(p); }
  __device__ static __forceinline__ bf16x8 tobf(T x) {
    u32x4 w = {cvtpk(x[0], x[1]), cvtpk(x[2], x[3]), cvtpk(x[4], x[5]), cvtpk(x[6], x[7])}; return *reinterpret_cast<bf16x8*>(&w); } };

__device__ __forceinline__ void partialSM(f32x16& p0, f32x16& p1, float& m_reg, float& mn, float& alpha) {
  constexpr float C = SCALE * 1.4426950408889634f;
  float pmax = p0[0]; for (int r = 1; r < 16; ++r) pmax = fmaxf(pmax, p0[r]); for (int r = 0; r < 16; ++r) pmax = fmaxf(pmax, p1[r]);
  { auto rr = __builtin_amdgcn_permlane32_swap(__float_as_uint(pmax), __float_as_uint(pmax), false, false);
    pmax = fmaxf(__uint_as_float(rr[0]), __uint_as_float(rr[1])); }
  if (__builtin_expect(__all(pmax - m_reg <= THR / SCALE), 1)) { mn = m_reg; alpha = 1.f; }
  else { mn = fmaxf(m_reg, pmax); alpha = __builtin_amdgcn_exp2f((m_reg - mn) * C); m_reg = mn; }
  float mnC = -mn * C;
  for (int r = 0; r < 16; ++r) p0[r] = fmaf(p0[r], C, mnC); for (int r = 0; r < 16; ++r) p1[r] = fmaf(p1[r], C, mnC);
  for (int r = 0; r < 16; ++r) p0[r] = __builtin_amdgcn_exp2f(p0[r]);
}
__device__ __forceinline__ void finishSM(f32x16& p0, f32x16& p1, float alpha, float& l_reg, bf16x8& pa0, bf16x8& pa1, bf16x8& pa2, bf16x8& pa3) {
  for (int r = 0; r < 16; ++r) p1[r] = __builtin_amdgcn_exp2f(p1[r]);
  float ps = 0; for (int r = 0; r < 16; ++r) ps += p0[r]; for (int r = 0; r < 16; ++r) ps += p1[r];
  { auto rr = __builtin_amdgcn_permlane32_swap(__float_as_uint(ps), __float_as_uint(ps), false, false);
    ps = __uint_as_float(rr[0]) + __uint_as_float(rr[1]); }
  l_reg = l_reg * alpha + ps;
#define PK4(P, BASE, OUT) do { unsigned a0 = cvtpk(P[BASE + 0], P[BASE + 1]), a1 = cvtpk(P[BASE + 2], P[BASE + 3]);   \
    unsigned b0 = cvtpk(P[BASE + 4], P[BASE + 5]), b1 = cvtpk(P[BASE + 6], P[BASE + 7]);                              \
    auto r0 = __builtin_amdgcn_permlane32_swap(a0, b0, false, false); auto r1 = __builtin_amdgcn_permlane32_swap(a1, b1, false, false); \
    u32x4 w = {r0[0], r1[0], r0[1], r1[1]}; OUT = *reinterpret_cast<bf16x8*>(&w); } while (0)
  PK4(p0, 0, pa0); PK4(p0, 8, pa1); PK4(p1, 0, pa2); PK4(p1, 8, pa3);
#undef PK4
}
__device__ __forceinline__ void qkt(f32x16& p0, f32x16& p1, const bf16* Ks, const bf16x8* qr, int r32, int hi) {
  p0 = f32x16{}; p1 = f32x16{};
  for (int d0 = 0; d0 < 8; ++d0) { int cb = (d0 * 16 + hi * 8) * 2;
    bf16x8 b0 = *reinterpret_cast<const bf16x8*>((const char*)Ks + KSWZ(r32, cb));
    bf16x8 b1 = *reinterpret_cast<const bf16x8*>((const char*)Ks + KSWZ(32 + r32, cb));
    p0 = __builtin_amdgcn_mfma_f32_32x32x16_bf16(b0, qr[d0], p0, 0, 0, 0);
    p1 = __builtin_amdgcn_mfma_f32_32x32x16_bf16(b1, qr[d0], p1, 0, 0, 0); }
}
__device__ __forceinline__ int v_st(int k, int c) { const int kk = (k & ~0xC) | ((k & 4) << 1) | ((k & 8) >> 1); return ((kk >> 3) * 4 + (c >> 5)) * 512 + ((kk & 7) * 32 + (c & 31)) * 2; }
__device__ __forceinline__ int v_rd_base(int lane) { return ((lane & 3) << 3) | (((lane >> 2) & 3) << 6) | (((lane >> 4) & 1) << 5) | (((lane >> 5) & 1) << 8); }
constexpr int v_rd_off(int d0, int ks, int half) { return d0 * 512 + ks * 4096 + half * 2048; }
template <int OFF> __device__ __forceinline__ s16x4 tr_read(int vb) {
  s16x4 r; asm volatile("ds_read_b64_tr_b16 %0, %1 offset:%2" : "=&v"(r) : "v"(vb), "i"(OFF) : "memory"); return r;
}
template <int D0> __device__ __forceinline__ void pv_one(f32x16& od, int vb, bf16x8 pa0, bf16x8 pa1, bf16x8 pa2, bf16x8 pa3) {
  const s16x4 l0 = tr_read<v_rd_off(D0, 0, 0)>(vb), h0 = tr_read<v_rd_off(D0, 0, 1)>(vb), l1 = tr_read<v_rd_off(D0, 1, 0)>(vb), h1 = tr_read<v_rd_off(D0, 1, 1)>(vb);
  const s16x4 l2 = tr_read<v_rd_off(D0, 2, 0)>(vb), h2 = tr_read<v_rd_off(D0, 2, 1)>(vb), l3 = tr_read<v_rd_off(D0, 3, 0)>(vb), h3 = tr_read<v_rd_off(D0, 3, 1)>(vb);
  asm volatile("s_waitcnt lgkmcnt(0)" ::: "memory"); SBAR();
#define PK(L, H) (bf16x8){L[0], L[1], L[2], L[3], H[0], H[1], H[2], H[3]}
  od = __builtin_amdgcn_mfma_f32_32x32x16_bf16(pa0, PK(l0, h0), od, 0, 0, 0);
  od = __builtin_amdgcn_mfma_f32_32x32x16_bf16(pa1, PK(l1, h1), od, 0, 0, 0);
  od = __builtin_amdgcn_mfma_f32_32x32x16_bf16(pa2, PK(l2, h2), od, 0, 0, 0);
  od = __builtin_amdgcn_mfma_f32_32x32x16_bf16(pa3, PK(l3, h3), od, 0, 0, 0);
#undef PK
}
__device__ __forceinline__ void pv_d0(f32x16* o, int vb, bf16x8 pa0, bf16x8 pa1, bf16x8 pa2, bf16x8 pa3) {
  pv_one<0>(o[0], vb, pa0, pa1, pa2, pa3); pv_one<1>(o[1], vb, pa0, pa1, pa2, pa3); pv_one<2>(o[2], vb, pa0, pa1, pa2, pa3); pv_one<3>(o[3], vb, pa0, pa1, pa2, pa3);
}

__device__ __forceinline__ float bf2f(short s) { return __uint_as_float(((unsigned)(unsigned short)s) << 16); }

__device__ __forceinline__ void attn_unit(const bf16* Qb, const bf16* __restrict__ Kh, const bf16* __restrict__ Vh,
                                          bf16* Ob, int seq, int t0, const float* __restrict__ qgain, const float2* __restrict__ rope, char* lds) {
  using St = Stage<bf16>;
  const int tid = mk_tid(), wid = tid >> 6, lane = tid & 63, r32 = lane & 31, hi = lane >> 5;
  bf16* V_lds = (bf16*)lds; bf16* K_lds = (bf16*)(lds + 2 * SHM_V);
  float* ws = (float*)(lds + 2 * SHM_V + 2 * SHM_K) + wid * 64; float* li_l = ws; float* al_l = ws + 32;
  float m_reg = -1e30f, l_reg = 0; f32x16 o[4] = {}; bf16x8 qr[8];
  const bf16* Qw = Qb + (long)(wid * QBLK + r32) * LDQ + hi * 8;
  {
    bf16x8 qraw[8]; float ss = 0.f;
#pragma unroll
    for (int d0 = 0; d0 < 8; ++d0) qraw[d0] = St::ld8(Qw + d0 * 16);
#pragma unroll
    for (int d0 = 0; d0 < 8; ++d0)
#pragma unroll
      for (int e = 0; e < 8; ++e) { const float v = bf2f(qraw[d0][e]); ss += v * v; }
    { auto rr = __builtin_amdgcn_permlane32_swap(__float_as_uint(ss), __float_as_uint(ss), false, false); ss = __uint_as_float(rr[0]) + __uint_as_float(rr[1]); }
    const float rstd = 1.0f / sqrtf(ss * (1.0f / 128.0f) + 1e-6f);
    const int t = t0 + wid * QBLK + r32, trow = t >> 6, tcol = t & 63;
#pragma unroll
    for (int d0 = 0; d0 < 8; ++d0) {
      const int pos = d0 < 4 ? trow : tcol;
      const float2* rp = rope + pos * 32 + ((8 * d0 + 4 * hi) & 31); const float* gp = qgain + 16 * d0 + 8 * hi;
      u32x4 w;
#pragma unroll
      for (int e2 = 0; e2 < 4; ++e2) {
        const float x0 = bf2f(qraw[d0][2 * e2]) * rstd * gp[2 * e2], x1 = bf2f(qraw[d0][2 * e2 + 1]) * rstd * gp[2 * e2 + 1];
        const float2 cs = rp[e2];
        w[e2] = cvtpk(x0 * cs.x - x1 * cs.y, x0 * cs.y + x1 * cs.x);
      }
      qr[d0] = *reinterpret_cast<bf16x8*>(&w);
    }
  }
  const int sr = tid >> 4, sc = (tid & 15) * 8, vst0 = v_st(sr, sc), vst1 = v_st(32 + sr, sc);
  const int vb0 = (int)(uintptr_t)V_lds + v_rd_base(lane);
  struct { typename St::T vs0, vs1, ks0, ks1; } sr_[SDEPTH];
#define SLOAD(i, k0) do { sr_[i].vs0 = St::ld8(&Vh[(long)((k0) + sr) * LDK + sc]); sr_[i].vs1 = St::ld8(&Vh[(long)((k0) + 32 + sr) * LDK + sc]); \
    sr_[i].ks0 = St::ld8(&Kh[(long)((k0) + sr) * LDK + sc]); sr_[i].ks1 = St::ld8(&Kh[(long)((k0) + 32 + sr) * LDK + sc]); } while (0)
#define SWRITE(b, i) do { *(bf16x8*)((char*)V_lds + (b) * SHM_V + vst0) = St::tobf(sr_[i].vs0);          \
    *(bf16x8*)((char*)V_lds + (b) * SHM_V + vst1) = St::tobf(sr_[i].vs1); int kc = sc * 2;               \
    *(bf16x8*)((char*)K_lds + (b) * SHM_K + KSWZ(sr, kc)) = St::tobf(sr_[i].ks0);                       \
    *(bf16x8*)((char*)K_lds + (b) * SHM_K + KSWZ(32 + sr, kc)) = St::tobf(sr_[i].ks1); } while (0)
#define SWAIT() do { if constexpr (SDEPTH == 2) asm volatile("s_waitcnt vmcnt(4)" ::: "memory"); else asm volatile("s_waitcnt vmcnt(0)" ::: "memory"); } while (0)
#define RESC(a) do { if (__any((a) < 1.f)) { if (hi == 0) al_l[r32] = (a); asm volatile("s_waitcnt lgkmcnt(0)" ::: "memory"); \
    for (int d = 0; d < 4; ++d) for (int r = 0; r < 16; ++r) o[d][r] *= al_l[crow(r, hi)]; } } while (0)
  f32x16 pA0, pA1, pB0, pB1; float mnA, mnB, alA, alB; bf16x8 pa0, pa1, pa2, pa3; const int NT = seq / KVBLK;
  constexpr int SE = 0, SO = SDEPTH - 1;
  SLOAD(SE, 0); asm volatile("s_waitcnt vmcnt(0)" ::: "memory"); SWRITE(0, SE); __syncthreads();
  qkt(pA0, pA1, K_lds, qr, r32, hi); partialSM(pA0, pA1, m_reg, mnA, alA);
  SLOAD(SO, KVBLK); if constexpr (SDEPTH == 2) { if (2 < NT) SLOAD(SE, 2 * KVBLK); }
  SWAIT(); SWRITE(1, SO); __syncthreads();
  for (int j = 1; j + 1 < NT; j += 2) {
    SBAR(); qkt(pB0, pB1, (bf16*)((char*)K_lds + SHM_K), qr, r32, hi);
    finishSM(pA0, pA1, alA, l_reg, pa0, pa1, pa2, pa3); SBAR();
    SLOAD(SO, (j + SDEPTH) * KVBLK); SBAR();
    pv_d0(o, vb0, pa0, pa1, pa2, pa3); partialSM(pB0, pB1, m_reg, mnB, alB);
    __syncthreads(); SWAIT(); SWRITE(0, SE);
    RESC(alB); __syncthreads();
    SBAR(); qkt(pA0, pA1, K_lds, qr, r32, hi);
    finishSM(pB0, pB1, alB, l_reg, pa0, pa1, pa2, pa3); SBAR();
    if (SDEPTH == 1 || j + 3 < NT) SLOAD(SE, (j + 1 + SDEPTH) * KVBLK); SBAR();
    pv_d0(o, vb0 + (int)SHM_V, pa0, pa1, pa2, pa3); partialSM(pA0, pA1, m_reg, mnA, alA);
    __syncthreads(); SWAIT(); SWRITE(1, SO);
    RESC(alA); __syncthreads();
  }
  SBAR(); qkt(pB0, pB1, (bf16*)((char*)K_lds + SHM_K), qr, r32, hi);
  finishSM(pA0, pA1, alA, l_reg, pa0, pa1, pa2, pa3); SBAR();
  pv_d0(o, vb0, pa0, pa1, pa2, pa3); partialSM(pB0, pB1, m_reg, mnB, alB);
  __syncthreads(); RESC(alB);
  finishSM(pB0, pB1, alB, l_reg, pa0, pa1, pa2, pa3); SBAR();
  pv_d0(o, vb0 + (int)SHM_V, pa0, pa1, pa2, pa3);
  if (hi == 0) li_l[r32] = l_reg; asm volatile("s_waitcnt lgkmcnt(0)" ::: "memory");
  float rli[16];
#pragma unroll
  for (int r = 0; r < 16; ++r) rli[r] = __builtin_amdgcn_rcpf(li_l[crow(r, hi)]);
  { bf16* stg = (bf16*)(lds + OST_OFF) + wid * (32 * 128);
#pragma unroll
    for (int r = 0; r < 16; ++r) { const int orow = crow(r, hi);
#pragma unroll
      for (int d0 = 0; d0 < 4; ++d0) stg[orow * 128 + d0 * 32 + r32] = __float2bfloat16(o[d0][r] * rli[r]); }
    asm volatile("s_waitcnt lgkmcnt(0)" ::: "memory");
    bf16* Ow = Ob + (long)(wid * QBLK) * LDO;
#pragma unroll
    for (int i = 0; i < 8; ++i) { const int row = i * 4 + (lane >> 4), ch = lane & 15; const u32x4 v = *(const u32x4*)(stg + row * 128 + ch * 8); *(u32x4*)(Ow + (long)row * LDO + ch * 8) = v; }
    asm volatile("s_waitcnt lgkmcnt(0)" ::: "memory"); }
  __syncthreads();
#undef SLOAD
#undef SWRITE
#undef SWAIT
#undef RESC
}
}

#define LAS __attribute__((address_space(3)))
typedef unsigned short bf16_t;
typedef unsigned v4u __attribute__((ext_vector_type(4)));
typedef float f32x4 __attribute__((ext_vector_type(4)));
typedef float f32x16 __attribute__((ext_vector_type(16)));
typedef short bf16x8 __attribute__((ext_vector_type(8)));
typedef short s16x4 __attribute__((ext_vector_type(4)));
#define LDS_WAIT() asm volatile("s_waitcnt lgkmcnt(0)" ::: "memory")

constexpr int NWAVES = 8, NTHREADS = 512;
constexpr int DM = 1024, DFF = 2816, NQKV = 1536;
constexpr int NTOK_P = 16384, NTOK_S = 32768, NTOK = 49152, SEQ_P = 8192, SEQ_S = 4096, NB_P = 2, NB_S = 8;
constexpr float EPS = 1e-6f;
constexpr size_t MiB = 1u << 20;
constexpr size_t WS_WGU = 1 * MiB, WS_WD = 45 * MiB, WS_WQKV = 67 * MiB, WS_WO = 73 * MiB, WS_W2 = 77 * MiB, WS_A1P = 85 * MiB, WS_A1S = 89 * MiB, WS_A2 = 90 * MiB, WS_ROPE = 90 * MiB + 65536, WS_QKG = 90 * MiB + 131072;
constexpr size_t WS_XN = 92 * MiB, WS_B = 188 * MiB, WS_C = 284 * MiB, WS_END = 476 * MiB;
constexpr size_t WS_F = WS_XN, WS_T = WS_C, WS_HID = WS_B, WS_QO = WS_B, WS_K = WS_C, WS_V = WS_C + 24 * MiB;
constexpr int LDS_BYTES = 147456;

__device__ __forceinline__ unsigned f2bf(float f) { unsigned u = __builtin_bit_cast(unsigned, f); return (u + 0x7fffu + ((u >> 16) & 1u)) >> 16; }
__device__ __forceinline__ unsigned pk2(float lo, float hi) { return f2bf(lo) | (f2bf(hi) << 16); }
__device__ __forceinline__ float wave_sum(float v) {
#pragma unroll
    for (int o = 1; o < 64; o <<= 1) v += __shfl_xor(v, o);
    return v;
}

template <class RowMap>
__device__ __forceinline__ void transpose_item(const float* __restrict__ W, int K, int N, bf16_t* WT, int ldk, const float* __restrict__ gain, RowMap rm, LAS float* scr, int item, int lane) {
    const int nblk = N / 32, kb = item / nblk, nb = item % nblk, k0 = 64 * kb, n0 = 32 * nb;
#pragma unroll 8
    for (int i = 0; i < 32; ++i) { const int kk = 2 * i + (lane >> 5); float v = W[(size_t)(k0 + kk) * N + n0 + (lane & 31)]; if (gain) v *= gain[k0 + kk]; scr[kk * 33 + (lane & 31)] = v; }
    LDS_WAIT(); asm volatile("" ::: "memory");
    const int c = lane & 7;
#pragma unroll
    for (int j = 0; j < 4; ++j) { const int n = (lane >> 3) + 8 * j; const LAS float* s = scr + (8 * c) * 33 + n;
        v4u o; o.x = pk2(s[0 * 33], s[1 * 33]); o.y = pk2(s[2 * 33], s[3 * 33]); o.z = pk2(s[4 * 33], s[5 * 33]); o.w = pk2(s[6 * 33], s[7 * 33]);
        *(v4u*)(WT + (size_t)rm(n0 + n) * ldk + k0 + 8 * c) = o; }
    LDS_WAIT(); asm volatile("" ::: "memory");
}
struct RmId { __device__ __forceinline__ int operator()(int n) const { return n; } };
struct RmGU { int off; __device__ __forceinline__ int operator()(int n) const { return ((n >> 7) << 8) + (n & 127) + off; } };

__device__ __forceinline__ void norm_row(const float* xrow, float* copy_to, bf16_t* orow, int lane) {
    const f32x4* xr = (const f32x4*)xrow + lane;
    f32x4 v[4]; float s = 0.f;
#pragma unroll
    for (int j = 0; j < 4; ++j) { v[j] = xr[64 * j]; s += (v[j].x * v[j].x + v[j].y * v[j].y) + (v[j].z * v[j].z + v[j].w * v[j].w); }
    if (copy_to) { f32x4* cr = (f32x4*)copy_to + lane;
#pragma unroll
        for (int j = 0; j < 4; ++j) cr[64 * j] = v[j]; }
    const float rstd = 1.f / sqrtf(wave_sum(s) * (1.f / DM) + EPS);
    unsigned long long* o8 = (unsigned long long*)orow + lane;
#pragma unroll
    for (int j = 0; j < 4; ++j) o8[64 * j] = (unsigned long long)pk2(v[j].x * rstd, v[j].y * rstd) | ((unsigned long long)pk2(v[j].z * rstd, v[j].w * rstd) << 32);
}

template <int OFF> __device__ __forceinline__ s16x4 tr_read_off(unsigned vb) {
    s16x4 r; asm volatile("ds_read_b64_tr_b16 %0, %1 offset:%2" : "=&v"(r) : "v"(vb), "i"(OFF) : "memory"); return r;
}
template <int KS, int NKS> struct BLoad {
    static __device__ __forceinline__ void run(bf16x8 (&b0)[NKS], bf16x8 (&b1)[NKS], unsigned base0, unsigned base1) {
        const s16x4 l0 = tr_read_off<(16 * KS) * 128>(base0), h0 = tr_read_off<(16 * KS + 4) * 128>(base0);
        const s16x4 l1 = tr_read_off<(16 * KS) * 128>(base1), h1 = tr_read_off<(16 * KS + 4) * 128>(base1);
        asm volatile("s_waitcnt lgkmcnt(0)" ::: "memory");
        b0[KS] = (bf16x8){l0[0], l0[1], l0[2], l0[3], h0[0], h0[1], h0[2], h0[3]};
        b1[KS] = (bf16x8){l1[0], l1[1], l1[2], l1[3], h1[0], h1[1], h1[2], h1[3]};
        if constexpr (KS + 1 < NKS) BLoad<KS + 1, NKS>::run(b0, b1, base0, base1);
    }
};
template <int KT, int MT>
__device__ __forceinline__ void fft_unit(const bf16_t* __restrict__ A, const bf16_t* __restrict__ in, size_t in_stride, bf16_t* out, size_t so1, size_t so0, char* wl, int lane) {
    constexpr int NKS = KT / 16;
    const int r32 = lane & 31, hi = lane >> 5;
    { const int lr = lane >> 3, ch = lane & 7;
#pragma unroll
      for (int i = 0; i < KT / 8; ++i) { const int row = i * 8 + lr; const v4u v = *(const v4u*)(in + (size_t)row * in_stride + ch * 8);
          *(v4u*)(wl + row * 128 + 16 * (ch ^ (((row >> 1) & 1) << 2))) = v; } }
    LDS_WAIT(); asm volatile("" ::: "memory");
    bf16x8 b0[NKS], b1[NKS];
    { const int blk = (lane >> 4) & 1, q = (lane & 15) >> 2, p = lane & 3, qb = (q >> 1) & 1;
      const unsigned basel = (unsigned)(uintptr_t)wl + (unsigned)((8 * hi + q) * 128 + 16 * (2 * blk + (p >> 1)) + 8 * (p & 1));
      BLoad<0, NKS>::run(b0, b1, basel + 64u * (unsigned)qb, basel + 64u * (unsigned)(1 - qb)); }
    asm volatile("" ::: "memory");
    bf16_t* stg = (bf16_t*)wl;
#pragma unroll 1
    for (int mb = 0; mb < MT / 32; ++mb) {
        bf16x8 af[NKS];
#pragma unroll
        for (int ks = 0; ks < NKS; ++ks) af[ks] = *(const bf16x8*)(A + (size_t)(32 * mb + r32) * KT + 16 * ks + 8 * hi);
        f32x16 c0 = {}, c1 = {};
#pragma unroll
        for (int ks = 0; ks < NKS; ++ks) { c0 = __builtin_amdgcn_mfma_f32_32x32x16_bf16(af[ks], b0[ks], c0, 0, 0, 0); c1 = __builtin_amdgcn_mfma_f32_32x32x16_bf16(af[ks], b1[ks], c1, 0, 0, 0); }
#pragma unroll
        for (int r = 0; r < 16; ++r) { const int orow = (r & 3) + 8 * (r >> 2) + 4 * hi; stg[orow * 64 + r32] = (bf16_t)f2bf(c0[r]); stg[orow * 64 + 32 + r32] = (bf16_t)f2bf(c1[r]); }
        LDS_WAIT(); asm volatile("" ::: "memory");
#pragma unroll
        for (int i = 0; i < 4; ++i) { const int row = i * 8 + (lane >> 3), ch = lane & 7, m = 32 * mb + row; const v4u v = *(const v4u*)(stg + row * 64 + ch * 8);
            *(v4u*)(out + (size_t)(m >> 1) * so1 + (size_t)(m & 1) * so0 + ch * 8) = v; }
        LDS_WAIT(); asm volatile("" ::: "memory");
    }
}

struct Args { const float* in[12]; float* out; unsigned char* ws; int ph_lo, ph_hi; };

__global__ void __launch_bounds__(NTHREADS, 2) mk_fwd(Args args) {
    extern __shared__ __attribute__((aligned(16))) unsigned char lds[];
    const int G = gridDim.x; const int bx = blockIdx.x; const int vcu = (G % 8 == 0) ? (bx % 8) * (G / 8) + bx / 8 : bx;
    const int NGW = G * NWAVES;
    unsigned char* ws = args.ws; float* X = args.out;
    bf16_t* Wgu = (bf16_t*)(ws + WS_WGU); bf16_t* Wd = (bf16_t*)(ws + WS_WD); bf16_t* Wqkv = (bf16_t*)(ws + WS_WQKV); bf16_t* Wo = (bf16_t*)(ws + WS_WO); bf16_t* W2 = (bf16_t*)(ws + WS_W2);
    bf16_t* A1P = (bf16_t*)(ws + WS_A1P); bf16_t* A1S = (bf16_t*)(ws + WS_A1S); bf16_t* A2 = (bf16_t*)(ws + WS_A2); float2* ROPE = (float2*)(ws + WS_ROPE); float* QKG = (float*)(ws + WS_QKG);
    bf16_t* XN = (bf16_t*)(ws + WS_XN); bf16_t* FB = (bf16_t*)(ws + WS_F); bf16_t* TB = (bf16_t*)(ws + WS_T); bf16_t* HID = (bf16_t*)(ws + WS_HID);
    bf16_t* QO = (bf16_t*)(ws + WS_QO); bf16_t* KB = (bf16_t*)(ws + WS_K); bf16_t* VB = (bf16_t*)(ws + WS_V);
    LAS unsigned char* ldsl = (LAS unsigned char*)lds;
    const int lo = args.ph_lo, hi = args.ph_hi;
    int ph = 0;
#define PH_BEGIN if (ph >= lo && ph < hi) { const int tid = mk_tid(), lane = tid & 63, wave = __builtin_amdgcn_readfirstlane(tid >> 6), gw = vcu * NWAVES + wave; (void)lane; (void)gw;
#define PH_END } ++ph; if (ph > lo && ph < hi) { cg::this_grid().sync(); }

    PH_BEGIN
    if (EN_P0) {
        LAS float* scr = (LAS float*)(ldsl + wave * 16384);
        constexpr int I_G = 16 * 88, I_D = 44 * 32, I_QKV = 16 * 48, I_O = 16 * 32;
        constexpr int NITEMS = 4 * (2 * I_G + I_D) + 2 * (I_QKV + I_O);
        for (int it = gw; it < NITEMS; it += NGW) {
            int r = it;
            if (r < 4 * I_G) { const int l = r / I_G; transpose_item(args.in[9] + (size_t)l * DM * DFF, DM, DFF, Wgu + (size_t)l * 2 * DFF * DM, DM, args.in[3] + l * DM, RmGU{0}, scr, r % I_G, lane); continue; } r -= 4 * I_G;
            if (r < 4 * I_G) { const int l = r / I_G; transpose_item(args.in[10] + (size_t)l * DM * DFF, DM, DFF, Wgu + (size_t)l * 2 * DFF * DM, DM, args.in[3] + l * DM, RmGU{128}, scr, r % I_G, lane); continue; } r -= 4 * I_G;
            if (r < 4 * I_D) { const int l = r / I_D; transpose_item(args.in[11] + (size_t)l * DFF * DM, DFF, DM, Wd + (size_t)l * DM * DFF, DFF, (const float*)nullptr, RmId{}, scr, r % I_D, lane); continue; } r -= 4 * I_D;
            if (r < 2 * I_QKV) { const int j = r / I_QKV; transpose_item(args.in[5] + (size_t)j * DM * NQKV, DM, NQKV, Wqkv + (size_t)j * NQKV * DM, DM, args.in[2] + (2 * j + 1) * DM, RmId{}, scr, r % I_QKV, lane); continue; } r -= 2 * I_QKV;
            { const int j = r / I_O; transpose_item(args.in[8] + (size_t)j * DM * DM, DM, DM, Wo + (size_t)j * DM * DM, DM, (const float*)nullptr, RmId{}, scr, r % I_O, lane); }
        }
        { LAS float* tab = scr;
          for (int i = lane; i < 128; i += 64) { tab[i] = cospif((float)i * (1.0f / 64.0f)); tab[128 + i] = sinpif((float)i * (1.0f / 64.0f)); }
          LDS_WAIT(); asm volatile("" ::: "memory");
          for (int task = gw; task < 2048; task += NGW) {
              const int nb = task & 15, cc = (task >> 4) & 3, g = (task >> 6) & 7, p = (task >> 9) & 1, j = task >> 10;
              const int n = nb * 64 + lane; const float* w = args.in[4] + (size_t)j * DM * DM + (size_t)(g * 128) * DM + n; const LAS float* tb = tab + p * 128;
              float acc[32];
#pragma unroll
              for (int ci = 0; ci < 32; ++ci) acc[ci] = 0.f;
              for (int jp = 0; jp < 128; ++jp) { const float wv = w[(size_t)jp * DM];
#pragma unroll
                  for (int ci = 0; ci < 32; ++ci) acc[ci] += tb[((cc * 32 + ci) * jp) & 127] * wv; }
              const float* gain = args.in[2] + (2 * j) * DM + g * 128 + cc * 32;
              bf16_t* dst = W2 + (size_t)j * DM * 2048 + (size_t)n * 2048 + p * 1024 + g * 128 + cc * 32;
#pragma unroll
              for (int q4 = 0; q4 < 4; ++q4) { v4u o; const float sc = 0.08838834764831845f;
                  o.x = pk2(acc[8 * q4 + 0] * gain[8 * q4 + 0] * sc, acc[8 * q4 + 1] * gain[8 * q4 + 1] * sc); o.y = pk2(acc[8 * q4 + 2] * gain[8 * q4 + 2] * sc, acc[8 * q4 + 3] * gain[8 * q4 + 3] * sc);
                  o.z = pk2(acc[8 * q4 + 4] * gain[8 * q4 + 4] * sc, acc[8 * q4 + 5] * gain[8 * q4 + 5] * sc); o.w = pk2(acc[8 * q4 + 6] * gain[8 * q4 + 6] * sc, acc[8 * q4 + 7] * gain[8 * q4 + 7] * sc);
                  *(v4u*)(dst + 8 * q4) = o; }
          }
          LDS_WAIT(); asm volatile("" ::: "memory");
        }
        { const int gt = gw * 64 + lane, NGT = NGW * 64;
          for (int e2 = gt; e2 < 64 * 256 * 64; e2 += NGT) {
              const int s1 = (e2 & 63) * 2, m = (e2 >> 6) & 255, s2 = e2 >> 14, k1 = m >> 1, pp = m & 1; float v[2];
#pragma unroll
              for (int d = 0; d < 2; ++d) { const int s = 64 * (s1 + d) + s2, r = (k1 * s) & 8191; const float x = (float)r * (1.0f / 4096.0f); v[d] = (pp ? -sinpif(x) : cospif(x)) * 0.08838834764831845f; }
              ((unsigned*)A1P)[e2] = pk2(v[0], v[1]); }
          for (int e2 = gt; e2 < 64 * 128 * 32; e2 += NGT) {
              const int s1 = (e2 & 31) * 2, m = (e2 >> 5) & 127, s2 = e2 >> 12, k1 = m >> 1, pp = m & 1; float v[2];
#pragma unroll
              for (int d = 0; d < 2; ++d) { const int s = 64 * (s1 + d) + s2, r = (k1 * s) & 4095; const float x = (float)r * (1.0f / 2048.0f); v[d] = (pp ? -sinpif(x) : cospif(x)) * 0.125f; }
              ((unsigned*)A1S)[e2] = pk2(v[0], v[1]); }
          for (int e2 = gt; e2 < 128 * 64; e2 += NGT) {
              const int k = (e2 & 63) * 2, m = e2 >> 6, k2 = m >> 1, pp = m & 1, p = k >> 6; float v[2];
#pragma unroll
              for (int d = 0; d < 2; ++d) { const int s2 = (k + d) & 63, r = (k2 * s2) & 63; const float x = (float)r * (1.0f / 32.0f); const float c = cospif(x), s = sinpif(x);
                  v[d] = (pp == 0 ? (p == 0 ? c : s) : (p == 0 ? -s : c)) * 0.125f; }
              ((unsigned*)A2)[e2] = pk2(v[0], v[1]); }
          for (int e = gt; e < 512; e += NGT) { const int j = e >> 8, r = e & 255; QKG[e] = r < 128 ? args.in[6][j * 128 + r] : args.in[7][j * 128 + r - 128]; }
          for (int e = gt; e < 128 * 32; e += NGT) { const int i = e & 31, pos = e >> 5; const float inv = powf(10000.0f, -(float)i * (1.0f / 32.0f)); const float a = (float)pos * inv; ROPE[e] = make_float2(cosf(a), sinf(a)); }
        }
        for (int m = gw; m < NTOK; m += NGW) { const float* src = m < NTOK_P ? args.in[0] + (size_t)m * DM : args.in[1] + (size_t)(m - NTOK_P) * DM; norm_row(src, X + (size_t)m * DM, XN + (size_t)m * DM, lane); }
    }
    PH_END

    for (int layer = 0; layer < 4; ++layer) {
        const int jj = layer >> 1;
        if ((layer & 1) == 0) {
            PH_BEGIN
            if (EN_FFT) {
                char* wl = (char*)lds + wave * 16384;
                for (int u = gw; u < 2048; u += NGW) { const int cb = u & 15, s2 = (u >> 4) & 63, b = u >> 10;
                    fft_unit<128, 256>(A1P + (size_t)s2 * 256 * 128, XN + ((size_t)b * SEQ_P + s2) * DM + cb * 64, (size_t)64 * DM, TB + ((size_t)b * 2 * SEQ_P + s2) * DM + cb * 64, (size_t)2 * 64 * DM, (size_t)64 * DM, wl, lane); }
                for (int u = gw; u < 8192; u += NGW) { const int cb = u & 15, s2 = (u >> 4) & 63, b = u >> 10;
                    fft_unit<64, 128>(A1S + (size_t)s2 * 128 * 64, XN + ((size_t)NTOK_P + (size_t)b * SEQ_S + s2) * DM + cb * 64, (size_t)64 * DM, TB + ((size_t)2 * NTOK_P + (size_t)b * 2 * SEQ_S + s2) * DM + cb * 64, (size_t)2 * 64 * DM, (size_t)64 * DM, wl, lane); }
            }
            PH_END
            PH_BEGIN
            if (EN_FFT) {
                char* wl = (char*)lds + wave * 16384;
                for (int u = gw; u < 4096 + 8192; u += NGW) {
                    const bool P = u < 4096; const int v = P ? u : u - 4096; const int cb = v & 15; const int k1 = P ? ((v >> 4) & 127) : ((v >> 4) & 63); const int b = P ? (v >> 11) : (v >> 10);
                    const size_t trow = P ? ((size_t)b * 2 * SEQ_P + (size_t)k1 * 128) : ((size_t)2 * NTOK_P + (size_t)b * 2 * SEQ_S + (size_t)k1 * 128);
                    const size_t frow = P ? ((size_t)b * SEQ_P + k1) : ((size_t)NTOK_P + (size_t)b * SEQ_S + k1);
                    fft_unit<128, 128>(A2, TB + trow * DM + cb * 64, (size_t)DM, FB + frow * 2048 + cb * 64, P ? (size_t)128 * 2048 : (size_t)64 * 2048, (size_t)1024, wl, lane);
                }
            }
            PH_END
        } else {
            PH_BEGIN
            if (EN_QKV) {
                pg8::Gemm g{XN, Wqkv + (size_t)jj * NQKV * DM, NTOK, NQKV, DM}; pg8::StaticOrder S; S.init(NTOK, NQKV, G, bx);
                pg8::EpiQKV E{QO, KB, VB};
                pg8::gemm_phase<pg8::EpiQKV, pg8::StaticOrder, true, true>(ldsl, g, S, E);
            }
            PH_END
            PH_BEGIN
            if (EN_MISC) {
                const float* kg = QKG + jj * 256 + 128;
                for (int rix = gw; rix < NTOK * 2; rix += NGW) {
                    const int tok = rix >> 1, kvh = rix & 1; const int t = tok < NTOK_P ? (tok & (SEQ_P - 1)) : ((tok - NTOK_P) & (SEQ_S - 1));
                    unsigned* kp = (unsigned*)(KB + (size_t)tok * 256 + kvh * 128) + lane; const unsigned raw = *kp;
                    float x0 = __uint_as_float(raw << 16), x1 = __uint_as_float(raw & 0xffff0000u);
                    const float rstd = 1.f / sqrtf(wave_sum(x0 * x0 + x1 * x1) * (1.0f / 128.0f) + EPS);
                    x0 *= rstd * kg[2 * lane]; x1 *= rstd * kg[2 * lane + 1];
                    const int pos = lane < 32 ? (t >> 6) : (t & 63); const float2 cs = ROPE[pos * 32 + (lane & 31)];
                    *kp = pk2(x0 * cs.x - x1 * cs.y, x0 * cs.y + x1 * cs.x);
                }
            }
            PH_END
            PH_BEGIN
            if (EN_ATT) {
                const float* qg = QKG + jj * 256;
                for (int j = vcu; j < 1536; j += G) {
                    int b, h, qb, tok0, seq;
                    if (j < 512) { const int bh = j >> 5; qb = j & 31; b = bh >> 3; h = bh & 7; tok0 = b * SEQ_P; seq = SEQ_P; }
                    else { const int v = j - 512, bh = v >> 4; qb = v & 15; b = bh >> 3; h = bh & 7; tok0 = NTOK_P + b * SEQ_S; seq = SEQ_S; }
                    const att::bf16* Qb = (const att::bf16*)QO + ((size_t)tok0 + qb * 256) * 1024 + h * 128;
                    const att::bf16* Kh = (const att::bf16*)KB + (size_t)tok0 * 256 + (h >> 2) * 128;
                    const att::bf16* Vh = (const att::bf16*)VB + (size_t)tok0 * 256 + (h >> 2) * 128;
                    att::attn_unit(Qb, Kh, Vh, (att::bf16*)Qb, seq, qb * 256, qg, ROPE, (char*)lds);
                }
            }
            PH_END
        }
        PH_BEGIN
        if (EN_RES) {
            pg8::Gemm g = (layer & 1) ? pg8::Gemm{QO, Wo + (size_t)jj * DM * DM, NTOK, DM, DM} : pg8::Gemm{FB, W2 + (size_t)jj * DM * 2048, NTOK, DM, 2048};
            pg8::StaticOrder S; S.init(NTOK, DM, G, bx); pg8::EpiRes E{X, DM};
            pg8::gemm_phase<pg8::EpiRes, pg8::StaticOrder, true, true>(ldsl, g, S, E);
        }
        PH_END
        PH_BEGIN
        { for (int m = gw; m < NTOK; m += NGW) norm_row(X + (size_t)m * DM, nullptr, XN + (size_t)m * DM, lane); }
        PH_END
        PH_BEGIN
        if (EN_GU) {
            pg8::Gemm g{XN, Wgu + (size_t)layer * 2 * DFF * DM, NTOK, 2 * DFF, DM}; pg8::StaticOrder S; S.init(NTOK, 2 * DFF, G, bx);
            pg8::EpiSwiGLU E{HID, DFF};
            pg8::gemm_phase<pg8::EpiSwiGLU, pg8::StaticOrder, true, true>(ldsl, g, S, E);
        }
        PH_END
        PH_BEGIN
        if (EN_RES) {
            pg8::Gemm g{HID, Wd + (size_t)layer * DM * DFF, NTOK, DM, DFF}; pg8::StaticOrder S; S.init(NTOK, DM, G, bx); pg8::EpiRes E{X, DM};
            pg8::gemm_phase<pg8::EpiRes, pg8::StaticOrder, true, true>(ldsl, g, S, E);
        }
        PH_END
        if (layer < 3) {
            PH_BEGIN
            { for (int m = gw; m < NTOK; m += NGW) norm_row(X + (size_t)m * DM, nullptr, XN + (size_t)m * DM, lane); }
            PH_END
        }
    }
#undef PH_BEGIN
#undef PH_END
}
constexpr int NPHASES = 30;

extern "C" void kernel_launch(void* const* d_in, const int* in_sizes, int n_in, void* d_out, int out_size, void* d_ws, size_t ws_size, hipStream_t stream) {
    static int grid = 0;
    if (grid == 0) {
        if (n_in != 12 || out_size != NTOK * DM || ws_size < WS_END) { fprintf(stderr, "kernel_launch: unexpected shapes: n_in %d out %d ws %zu (need %zu)\n", n_in, out_size, ws_size, (size_t)WS_END); grid = -1; return; }
        int dev = 0, cus = 0, per_cu = 0;
        hipGetDevice(&dev); hipDeviceGetAttribute(&cus, hipDeviceAttributeMultiprocessorCount, dev);
        if (hipFuncSetAttribute((const void*)mk_fwd, hipFuncAttributeMaxDynamicSharedMemorySize, LDS_BYTES) != hipSuccess) { fprintf(stderr, "kernel_launch: hipFuncSetAttribute failed\n"); grid = -1; return; }
        if (hipOccupancyMaxActiveBlocksPerMultiprocessor(&per_cu, (const void*)mk_fwd, NTHREADS, LDS_BYTES) != hipSuccess || per_cu < 1) { fprintf(stderr, "kernel_launch: occupancy query gave %d\n", per_cu); per_cu = 1; }
        (void)hipGetLastError();
        grid = cus * per_cu;
        fprintf(stderr, "kernel_launch: grid %d (cus %d x %d)\n", grid, cus, per_cu);
    }
    if (grid < 0) return;
    Args a{};
    for (int i = 0; i < 12; ++i) a.in[i] = (const float*)d_in[i];
    a.out = (float*)d_out; a.ws = (unsigned char*)d_ws;
#if MK_ONE_LAUNCH
    a.ph_lo = 0; a.ph_hi = NPHASES;
    void* kargs[] = {&a};
    hipError_t e = hipLaunchCooperativeKernel((const void*)mk_fwd, dim3(grid), dim3(NTHREADS), kargs, LDS_BYTES, stream);
    if (e != hipSuccess) fprintf(stderr, "kernel_launch: cooperative launch failed: %s (grid %d)\n", hipGetErrorString(e), grid);
#else
    for (int p = 0; p < NPHASES; ++p) { a.ph_lo = p; a.ph_hi = p + 1; hipLaunchKernelGGL(mk_fwd, dim3(grid), dim3(NTHREADS), LDS_BYTES, stream, a); }
    hipError_t e = hipPeekAtLastError();
    if (e != hipSuccess) fprintf(stderr, "kernel_launch: launch failed: %s\n", hipGetErrorString(e));
#endif
}
```

```cpp
#include <hip/hip_runtime.h>
#define ATT_SDEPTH 1
#define ATT_NEGM 1
#include <hip/hip_bf16.h>
#include <hip/hip_cooperative_groups.h>
#include <cstdio>
#include <cstdint>
namespace cg = cooperative_groups;

#ifndef EN_P0
#define EN_P0 1
#endif
#ifndef EN_FFT
#define EN_FFT 1
#endif
#ifndef EN_QKV
#define EN_QKV 1
#endif
#ifndef EN_MISC
#define EN_MISC 1
#endif
#ifndef EN_ATT
#define EN_ATT 1
#endif
#ifndef EN_RES
#define EN_RES 1
#endif
#ifndef EN_GU
#define EN_GU 1
#endif
#ifndef MK_PROBE
#define MK_PROBE 0
#endif
#ifndef MK_MASK_A
#define MK_MASK_A 0u
#endif
#ifndef MK_MASK_B
#define MK_MASK_B 0u
#endif
#ifndef MK_SLEEP_US
#define MK_SLEEP_US 0
#endif
#ifndef MK_EXTRA_SYNC
#define MK_EXTRA_SYNC 0
#endif
#ifndef MK_CG_ONLY
#define MK_CG_ONLY 0
#endif
#ifndef ATT_SDEPTH
#define ATT_SDEPTH 2
#endif
#ifndef ATT_SB
#define ATT_SB 0
#endif
#ifndef ATT_NEGM
#define ATT_NEGM 0
#endif
#ifndef GU_ALIGN
#define GU_ALIGN true
#endif
#ifndef GEMM_SP2
#define GEMM_SP2 true
#endif
#ifndef MK_PROBE2
#define MK_PROBE2 0
#endif
#ifndef MK_PA
#define MK_PA 0
#endif
#ifndef MK_PB
#define MK_PB 1
#endif
#ifndef MK_DREV
#define MK_DREV 1
#endif
#ifndef MK_ONE_LAUNCH
#define MK_ONE_LAUNCH 1
#endif

__device__ __forceinline__ int mk_tid() { int t = threadIdx.x; asm volatile("" : "+v"(t)); return t; }
namespace pg8 {
#define PG8_LAS __attribute__((address_space(3)))
typedef unsigned short bf16_t;
typedef short bf16x8 __attribute__((ext_vector_type(8)));
typedef float f32x4 __attribute__((ext_vector_type(4)));
typedef unsigned u32x4 __attribute__((ext_vector_type(4)));
constexpr int BM = 256, BK = 64, HALF = 128, HTB = HALF * BK * 2  , STAGE_BYTES = 8 * HTB, NXCD = 8, WGM = 8;

__host__ __device__ __forceinline__ int lds_byte(int r, int c) { const int st = (r >> 4) * 2 + (c >> 5), rr = r & 15, cc = c & 31, ob = rr * 64 + cc * 2; return st * 1024 + (ob ^ (((ob >> 9) & 1) << 5)); }
__host__ __device__ __forceinline__ void stage_rc(int b, int& R, int& C) { const int st = b / 1024, sb = b % 1024, swz = sb ^ (((sb >> 9) & 1) << 5); R = (st >> 1) * 16 + swz / 64; C = (st & 1) * 32 + (swz % 64) / 2; }
__host__ __device__ __forceinline__ int perm32(int rho) { const int n = rho >> 4, i = rho & 15; return 8 * (i >> 2) + 4 * n + (i & 3); }

struct Unit { int pm, pn; };
struct Gemm { const bf16_t* A; const bf16_t* Bt; int M, N, K; };

struct StaticOrder {
    int nM, nN, nwg, G, c, rev;
    __host__ __device__ void init(int M, int N, int G_, int c_) { nM = M / BM; nN = N / BM; nwg = nM * nN; G = G_; c = c_; rev = 0; }
    __host__ __device__ bool next(int i, Unit& u) const {
        const long L = (long)i * G + c; if (L >= nwg) return false;
        int wgid = (int)L; { const int q = nwg / NXCD, r = nwg % NXCD, xcd = wgid % NXCD, off = wgid / NXCD; wgid = (xcd < r ? xcd * (q + 1) : r * (q + 1) + (xcd - r) * q) + off; }
        const int nig = WGM * nN, gid = wgid / nig, fm = gid * WGM, gsz = (nM - fm) < WGM ? (nM - fm) : WGM;
        u.pm = fm + ((wgid % nig) % gsz); u.pn = (wgid % nig) / gsz; if (rev) u.pm = nM - 1 - u.pm; return true;
    }
    __device__ __forceinline__ void a_ready(const Unit&) const {}
    __device__ __forceinline__ void done(const Unit&) const {}
};

__device__ __forceinline__ unsigned cvt_pk_bf16(float lo, float hi) { unsigned r; asm volatile("v_cvt_pk_bf16_f32 %0, %1, %2" : "=v"(r) : "v"(lo), "v"(hi)); return r; }
typedef float f32x2 __attribute__((ext_vector_type(2)));
typedef float f32x2 __attribute__((ext_vector_type(2)));

__device__ __forceinline__ float bflo(unsigned w) { return __uint_as_float(w << 16); }
__device__ __forceinline__ float bfhi(unsigned w) { return __uint_as_float(w & 0xffff0000u); }
__device__ __forceinline__ float rstd_of(const float* rssp, size_t row) { const f32x4 p = *(const f32x4*)(rssp + row * 4); return __builtin_amdgcn_rsqf(((p[0] + p[1]) + (p[2] + p[3])) * (1.0f / 1024.0f) + 1e-6f); }
struct EpiResB {
    static constexpr bool PERM = true, AFTER_DRAIN = false;
    const bf16_t* xin; bf16_t* xout; float* fout; float* rssp; PG8_LAS float* P;
    __device__ __forceinline__ void operator()(const f32x4 (&acc)[2][2][4][2], const Unit& u, int wr, int wc, int fr, int fq) const {
        const int row0 = u.pm * BM + wr * 64 + fr, col0 = u.pn * BM + wc * 32 + 8 * fq;
#pragma unroll
        for (int ai = 0; ai < 2; ++ai) {
            u32x4 xo[4][2];
#pragma unroll
            for (int m = 0; m < 4; ++m)
#pragma unroll
                for (int bj = 0; bj < 2; ++bj) xo[m][bj] = *(const u32x4*)(xin + (size_t)(row0 + ai * HALF + m * 16) * 1024 + col0 + bj * HALF);
#pragma unroll
            for (int m = 0; m < 4; ++m) {
                const size_t roff = (size_t)(row0 + ai * HALF + m * 16) * 1024 + col0; float ss = 0.f;
#pragma unroll
                for (int bj = 0; bj < 2; ++bj) {
                    const u32x4 w = xo[m][bj]; const f32x4 a0 = acc[ai][bj][m][0], a1 = acc[ai][bj][m][1]; f32x4 v0, v1;
                    v0[0] = bflo(w.x) + a0[0]; v0[1] = bfhi(w.x) + a0[1]; v0[2] = bflo(w.y) + a0[2]; v0[3] = bfhi(w.y) + a0[3];
                    v1[0] = bflo(w.z) + a1[0]; v1[1] = bfhi(w.z) + a1[1]; v1[2] = bflo(w.w) + a1[2]; v1[3] = bfhi(w.w) + a1[3];
                    ss += (v0[0] * v0[0] + v0[1] * v0[1]) + (v0[2] * v0[2] + v0[3] * v0[3]) + (v1[0] * v1[0] + v1[1] * v1[1]) + (v1[2] * v1[2] + v1[3] * v1[3]);
                    if (fout) { *(f32x4*)(fout + roff + bj * HALF) = v0; *(f32x4*)(fout + roff + bj * HALF + 4) = v1; }
                    else { u32x4 o; o.x = cvt_pk_bf16(v0[0], v0[1]); o.y = cvt_pk_bf16(v0[2], v0[3]); o.z = cvt_pk_bf16(v1[0], v1[1]); o.w = cvt_pk_bf16(v1[2], v1[3]); *(u32x4*)(xout + roff + bj * HALF) = o; }
                }
                if (rssp) { ss += __shfl_xor(ss, 16); ss += __shfl_xor(ss, 32); if (fq == 0) P[(ai * HALF + wr * 64 + m * 16 + fr) * 4 + wc] = ss; }
            }
        }
        if (rssp) {
            asm volatile("s_waitcnt lgkmcnt(0)" ::: "memory"); __builtin_amdgcn_s_barrier(); asm volatile("" ::: "memory");
            const int t = (wr * 4 + wc) * 64 + fq * 16 + fr;
            if (t < 256) { const f32x4 p = *((const PG8_LAS f32x4*)P + t); rssp[(size_t)(u.pm * BM + t) * 4 + u.pn] = (p[0] + p[1]) + (p[2] + p[3]); }
        }
    }
};
__device__ __forceinline__ float silu_mul(float g, float u) { return g * u * __builtin_amdgcn_rcpf(1.0f + __builtin_amdgcn_exp2f(-1.4426950408889634f * g)); }
struct EpiSwiGLU {
    static constexpr bool PERM = true, AFTER_DRAIN = false;
    bf16_t* H; int ldh; const float* rssp;
    __device__ __forceinline__ void operator()(const f32x4 (&acc)[2][2][4][2], const Unit& u, int wr, int wc, int fr, int fq) const {
        const int row0 = u.pm * BM + wr * 64 + fr, col0 = u.pn * HALF + wc * 32 + 8 * fq;
        f32x4 pp[2][4];
#pragma unroll
        for (int ai = 0; ai < 2; ++ai)
#pragma unroll
            for (int m = 0; m < 4; ++m) pp[ai][m] = *(const f32x4*)(rssp + (size_t)(row0 + ai * HALF + m * 16) * 4);
#pragma unroll
        for (int ai = 0; ai < 2; ++ai)
#pragma unroll
            for (int m = 0; m < 4; ++m) { const int row = row0 + ai * HALF + m * 16; bf16_t* rowp = H + (size_t)row * ldh + col0; const f32x4 p = pp[ai][m]; const float rs = __builtin_amdgcn_rsqf(((p[0] + p[1]) + (p[2] + p[3])) * (1.0f / 1024.0f) + 1e-6f);
                const f32x4 g0 = acc[ai][0][m][0] * rs, g1 = acc[ai][0][m][1] * rs, u0 = acc[ai][1][m][0] * rs, u1 = acc[ai][1][m][1] * rs;
                u32x4 w;
                w.x = cvt_pk_bf16(silu_mul(g0[0], u0[0]), silu_mul(g0[1], u0[1])); w.y = cvt_pk_bf16(silu_mul(g0[2], u0[2]), silu_mul(g0[3], u0[3]));
                w.z = cvt_pk_bf16(silu_mul(g1[0], u1[0]), silu_mul(g1[1], u1[1])); w.w = cvt_pk_bf16(silu_mul(g1[2], u1[2]), silu_mul(g1[3], u1[3]));
                *(u32x4*)rowp = w; }
    }
};
struct EpiQKV {
    static constexpr bool PERM = true, AFTER_DRAIN = false;
    bf16_t *Q, *K, *V; const float* rssp;
    __device__ __forceinline__ void operator()(const f32x4 (&acc)[2][2][4][2], const Unit& u, int wr, int wc, int fr, int fq) const {
        const int row0 = u.pm * BM + wr * 64 + fr;
        bf16_t* base = u.pn < 4 ? Q + u.pn * BM : (u.pn == 4 ? K : V); const int ldc = u.pn < 4 ? 1024 : 256;
        const int col0 = wc * 32 + 8 * fq;
        f32x4 pp[2][4];
#pragma unroll
        for (int ai = 0; ai < 2; ++ai)
#pragma unroll
            for (int m = 0; m < 4; ++m) pp[ai][m] = *(const f32x4*)(rssp + (size_t)(row0 + ai * HALF + m * 16) * 4);
#pragma unroll
        for (int ai = 0; ai < 2; ++ai)
#pragma unroll
            for (int m = 0; m < 4; ++m) { const int row = row0 + ai * HALF + m * 16; bf16_t* rowp = base + (size_t)row * ldc + col0; const f32x4 p = pp[ai][m]; const float rs = __builtin_amdgcn_rsqf(((p[0] + p[1]) + (p[2] + p[3])) * (1.0f / 1024.0f) + 1e-6f);
#pragma unroll
                for (int bj = 0; bj < 2; ++bj) { const f32x4 v0 = acc[ai][bj][m][0] * rs, v1 = acc[ai][bj][m][1] * rs; u32x4 w;
                    w.x = cvt_pk_bf16(v0[0], v0[1]); w.y = cvt_pk_bf16(v0[2], v0[3]); w.z = cvt_pk_bf16(v1[0], v1[1]); w.w = cvt_pk_bf16(v1[2], v1[3]);
                    *(u32x4*)(rowp + bj * HALF) = w; } }
    }
};
template <class Epi, class Sched, bool ALIGN_EPI = false, bool SP2 = false>
__device__ __forceinline__ void gemm_phase(PG8_LAS unsigned char* lds, const Gemm g, const Sched& S, const Epi& E) {
    const int tid = mk_tid(), wid = __builtin_amdgcn_readfirstlane(tid >> 6), lane = tid & 63, wr = wid >> 2, wc = wid & 3, fr = lane & 15, fq = lane >> 4;
    const int K = g.K, nt = K / BK;
    unsigned voffA[2], voffB[2];
#pragma unroll
    for (int i = 0; i < 2; ++i) { int R, C; stage_rc(tid * 16 + i * 8192, R, C); const int Rb = Epi::PERM ? ((R & ~31) + perm32(R & 31)) : R;
        voffA[i] = (unsigned)(R * K + C) * 2u; voffB[i] = (unsigned)(Rb * K + C) * 2u; }
    const size_t kstep = (size_t)(BK * 2);
    const size_t hstep = (size_t)HALF * K * 2;
    const size_t tstep = 2 * hstep;
    const unsigned ldsw = (unsigned)wid * 1024u;
    const int aoff = lds_byte(wr * 64 + fr, fq * 8), boff = lds_byte(wc * 32 + fr, fq * 8);
#define PG8_SA(b, h) (((b) * 2 + (h)) * HTB)
#define PG8_SB(b, h) ((4 + (b) * 2 + (h)) * HTB)
#define PG8_STAGE(bufoff, gbase, voff) do { _Pragma("unroll") for (int _i = 0; _i < 2; ++_i) \
        __builtin_amdgcn_global_load_lds((const unsigned*)((const char*)(gbase) + (voff)[_i]), (PG8_LAS unsigned*)(lds + (bufoff) + ldsw + _i * 8192), 16, 0, 0); } while (0)
#define PG8_LDA(dst, b, h) do { _Pragma("unroll") for (int m = 0; m < 4; ++m) _Pragma("unroll") for (int k = 0; k < 2; ++k) dst[m][k] = *(const PG8_LAS bf16x8*)(lds + PG8_SA(b, h) + aoff + m * 2048 + k * 1024); } while (0)
#define PG8_LDB(dst, b, h) do { _Pragma("unroll") for (int n = 0; n < 2; ++n) _Pragma("unroll") for (int k = 0; k < 2; ++k) dst[n][k] = *(const PG8_LAS bf16x8*)(lds + PG8_SB(b, h) + boff + n * 2048 + k * 1024); } while (0)
#define PG8_MMA(ai, bj, At, Bt) do { __builtin_amdgcn_s_setprio(1); _Pragma("unroll") for (int m = 0; m < 4; ++m) _Pragma("unroll") for (int n = 0; n < 2; ++n) _Pragma("unroll") for (int k = 0; k < 2; ++k) \
        acc[ai][bj][m][n] = __builtin_amdgcn_mfma_f32_16x16x32_bf16(Bt[n][k], At[m][k], acc[ai][bj][m][n], 0, 0, 0); __builtin_amdgcn_s_setprio(0); } while (0)
#define PG8_WAIT_V(n) asm volatile("s_waitcnt vmcnt(" #n ")" ::: "memory")
#define PG8_WAIT_L(n) asm volatile("s_waitcnt lgkmcnt(" #n ")" ::: "memory")
#define PG8_BAR __builtin_amdgcn_s_barrier()
#define PG8_SCHED __builtin_amdgcn_sched_barrier(0)
    Unit cur, nxt; int ui = 0;
    if (!S.next(0, cur)) return;
    f32x4 acc[2][2][4][2];
#pragma unroll
    for (int a = 0; a < 2; ++a)
#pragma unroll
        for (int b = 0; b < 2; ++b)
#pragma unroll
            for (int m = 0; m < 4; ++m)
#pragma unroll
                for (int n = 0; n < 2; ++n) acc[a][b][m][n] = (f32x4){0.f, 0.f, 0.f, 0.f};
    bf16x8 At[4][2], B0[2][2], B1[2][2];
    const char* cA = (const char*)g.A + (size_t)cur.pm * tstep; const char* cB = (const char*)g.Bt + (size_t)cur.pn * tstep;
    S.a_ready(cur);
    if constexpr (SP2) {
        PG8_STAGE(PG8_SB(0, 0), cB, voffB); PG8_STAGE(PG8_SB(0, 1), cB + hstep, voffB); PG8_STAGE(PG8_SA(0, 0), cA, voffA); PG8_STAGE(PG8_SA(0, 1), cA + hstep, voffA);
        if (wr == 1) PG8_BAR;
        PG8_WAIT_V(2); PG8_BAR;
        PG8_STAGE(PG8_SB(1, 0), cB + kstep, voffB); PG8_STAGE(PG8_SA(1, 0), cA + kstep, voffA); PG8_STAGE(PG8_SB(1, 1), cB + hstep + kstep, voffB);
        PG8_WAIT_V(6); PG8_BAR;
    } else {
        PG8_STAGE(PG8_SB(0, 0), cB, voffB); PG8_STAGE(PG8_SA(0, 0), cA, voffA); PG8_STAGE(PG8_SB(0, 1), cB + hstep, voffB); PG8_STAGE(PG8_SA(0, 1), cA + hstep, voffA);
        if (wr == 1) PG8_BAR;
        PG8_WAIT_V(4); PG8_BAR;
        PG8_STAGE(PG8_SB(1, 0), cB + kstep, voffB); PG8_STAGE(PG8_SA(1, 0), cA + kstep, voffA); PG8_STAGE(PG8_SB(1, 1), cB + hstep + kstep, voffB);
        PG8_WAIT_V(6); PG8_BAR;
    }
    for (;;) {
        const bool has_next = S.next(ui + 1, nxt);
        const char* nA = has_next ? (const char*)g.A + (size_t)nxt.pm * tstep : cA; const char* nB = has_next ? (const char*)g.Bt + (size_t)nxt.pn * tstep : cB;
        for (int t = 0; t < nt; t += 2) {
            const bool last = (t == nt - 2);
            const char* a1 = cA + (size_t)(t + 1) * kstep;
            const char* a2 = last ? nA : cA + (size_t)(t + 2) * kstep; const char* b2 = last ? nB : cB + (size_t)(t + 2) * kstep;
            const char* a3 = a2 + kstep; const char* b3 = b2 + kstep;
            if (last && has_next) S.a_ready(nxt);
            if constexpr (SP2) {
            PG8_LDB(B0, 0, 0); PG8_LDB(B1, 0, 1); PG8_SCHED; PG8_LDA(At, 0, 0); PG8_STAGE(PG8_SA(1, 1), a1 + hstep, voffA);
            PG8_WAIT_V(8); PG8_WAIT_L(0); PG8_BAR; PG8_MMA(0, 0, At, B0); PG8_MMA(0, 1, At, B1); PG8_BAR; PG8_SCHED;
            PG8_LDA(At, 0, 1); PG8_STAGE(PG8_SB(0, 0), b2, voffB); PG8_STAGE(PG8_SB(0, 1), b2 + hstep, voffB); PG8_STAGE(PG8_SA(0, 0), a2, voffA);
            PG8_WAIT_V(8); PG8_WAIT_L(0); PG8_BAR; PG8_MMA(1, 0, At, B0); PG8_MMA(1, 1, At, B1); PG8_BAR; PG8_SCHED;
            PG8_LDB(B0, 1, 0); PG8_LDB(B1, 1, 1); PG8_SCHED; PG8_LDA(At, 1, 0); PG8_STAGE(PG8_SA(0, 1), a2 + hstep, voffA);
            PG8_WAIT_V(8); PG8_WAIT_L(0); PG8_BAR; PG8_MMA(0, 0, At, B0); PG8_MMA(0, 1, At, B1); PG8_BAR; PG8_SCHED;
            PG8_LDA(At, 1, 1); PG8_STAGE(PG8_SB(1, 0), b3, voffB); PG8_STAGE(PG8_SB(1, 1), b3 + hstep, voffB); PG8_STAGE(PG8_SA(1, 0), a3, voffA);
            PG8_WAIT_V(8); PG8_WAIT_L(0); PG8_BAR; PG8_MMA(1, 0, At, B0); PG8_MMA(1, 1, At, B1); PG8_BAR; PG8_SCHED;
            } else {
            PG8_LDB(B0, 0, 0); PG8_SCHED; PG8_LDA(At, 0, 0); PG8_STAGE(PG8_SA(1, 1), a1 + hstep, voffA);
            PG8_WAIT_L(8); PG8_BAR; PG8_WAIT_L(0); PG8_MMA(0, 0, At, B0); PG8_BAR; PG8_SCHED;
            PG8_LDB(B1, 0, 1); PG8_STAGE(PG8_SB(0, 0), b2, voffB);
            PG8_BAR; PG8_WAIT_L(0); PG8_MMA(0, 1, At, B1); PG8_BAR;
            PG8_LDA(At, 0, 1); PG8_STAGE(PG8_SA(0, 0), a2, voffA);
            PG8_BAR; PG8_WAIT_L(0); PG8_MMA(1, 0, At, B0); PG8_BAR; PG8_SCHED;
            PG8_STAGE(PG8_SB(0, 1), b2 + hstep, voffB);
            PG8_WAIT_V(6); PG8_BAR; PG8_MMA(1, 1, At, B1); PG8_BAR;
            PG8_LDB(B0, 1, 0); PG8_SCHED; PG8_LDA(At, 1, 0); PG8_STAGE(PG8_SA(0, 1), a2 + hstep, voffA);
            PG8_WAIT_L(8); PG8_BAR; PG8_WAIT_L(0); PG8_MMA(0, 0, At, B0); PG8_BAR; PG8_SCHED;
            PG8_LDB(B1, 1, 1); PG8_STAGE(PG8_SB(1, 0), b3, voffB);
            PG8_BAR; PG8_WAIT_L(0); PG8_MMA(0, 1, At, B1); PG8_BAR;
            PG8_LDA(At, 1, 1); PG8_STAGE(PG8_SA(1, 0), a3, voffA);
            PG8_BAR; PG8_WAIT_L(0); PG8_MMA(1, 0, At, B0); PG8_BAR; PG8_SCHED;
            PG8_STAGE(PG8_SB(1, 1), b3 + hstep, voffB);
            PG8_WAIT_V(6); PG8_BAR; PG8_MMA(1, 1, At, B1); PG8_BAR;
            }
        }
        if constexpr (ALIGN_EPI) { if (wr == 0) PG8_BAR; }
        if constexpr (!Epi::AFTER_DRAIN) { E(acc, cur, wr, wc, fr, fq); S.done(cur); }
        if (!has_next) break;
#pragma unroll
        for (int a = 0; a < 2; ++a)
#pragma unroll
            for (int b = 0; b < 2; ++b)
#pragma unroll
                for (int m = 0; m < 4; ++m)
#pragma unroll
                    for (int n = 0; n < 2; ++n) acc[a][b][m][n] = (f32x4){0.f, 0.f, 0.f, 0.f};
        cur = nxt; cA = nA; cB = nB; ++ui;
        if constexpr (ALIGN_EPI) { if (wr == 1) PG8_BAR; }
    }
    PG8_WAIT_V(0);
    if constexpr (!ALIGN_EPI) { if (wr == 0) PG8_BAR; }
    PG8_BAR;
    if constexpr (Epi::AFTER_DRAIN) { E.fused(acc, cur, wr, wc, fr, fq, lds, wid, lane); S.done(cur); }
#undef PG8_SA
#undef PG8_SB
#undef PG8_STAGE
#undef PG8_LDA
#undef PG8_LDB
#undef PG8_MMA
#undef PG8_WAIT_V
#undef PG8_WAIT_L
#undef PG8_BAR
#undef PG8_SCHED
}
}

namespace att {
using bf16 = __hip_bfloat16;
constexpr int   D = 128, NW = 8, QBLK = 32, KVBLK = 64;
constexpr float SCALE = 0.088388347648318440f;
constexpr float THR = 8.f;
constexpr int SDEPTH = ATT_SDEPTH;
constexpr int LDQ = 1024, LDK = 256, LDO = 1024;
constexpr size_t SHM_V = KVBLK * D * 2, SHM_K = KVBLK * D * 2, SHM_ATTN = 2 * SHM_V + 2 * SHM_K + NW * 64 * 4;
constexpr size_t OST_OFF = 69632;
using bf16x8 = __attribute__((ext_vector_type(8))) short;
using s16x4  = __attribute__((ext_vector_type(4))) short;
using f32x16 = __attribute__((ext_vector_type(16))) float;
using f32x8  = __attribute__((ext_vector_type(8))) float;
using u32x4  = __attribute__((ext_vector_type(4))) unsigned;
#define KSWZ(row, colB) ((row) * 256 + ((colB) ^ (((row) & 7) << 4)))
#define SBAR() __builtin_amdgcn_sched_barrier(0)
__device__ __forceinline__ int crow(int r, int hi) { return (r & 3) + 8 * (r >> 2) + 4 * hi; }
__device__ __forceinline__ unsigned cvtpk(float lo, float hi) {
  unsigned r; asm volatile("v_cvt_pk_bf16_f32 %0, %1, %2" : "=v"(r) : "v"(lo), "v"(hi)); return r;
}
template <typename TIn> struct Stage;
template <> struct Stage<bf16>  { using T = bf16x8;
  __device__ static __forceinline__ T ld8(const bf16* p) { return *reinterpret_cast<const bf16x8*>(p); }
  __device__ static __forceinline__ bf16x8 tobf(T x) { return x; } };
template <> struct Stage<float> { using T = f32x8;
  __device__ static __forceinline__ T ld8(const float* p) { return *reinterpret_cast<const f32x8*>(p); }
  __device__ static __forceinline__ bf16x8 tobf(T x) {
    u32x4 w = {cvtpk(x[0], x[1]), cvtpk(x[2], x[3]), cvtpk(x[4], x[5]), cvtpk(x[6], x[7])}; return *reinterpret_cast<bf16x8*>(&w); } };

__device__ __forceinline__ void partialSM(f32x16& p0, f32x16& p1, float& m_reg, float& mn, float& alpha) {
  constexpr float C = SCALE * 1.4426950408889634f;
  float pmax = p0[0]; for (int r = 1; r < 16; ++r) pmax = fmaxf(pmax, p0[r]); for (int r = 0; r < 16; ++r) pmax = fmaxf(pmax, p1[r]);
  { auto rr = __builtin_amdgcn_permlane32_swap(__float_as_uint(pmax), __float_as_uint(pmax), false, false);
    pmax = fmaxf(__uint_as_float(rr[0]), __uint_as_float(rr[1])); }
  if (__builtin_expect(__all(pmax - m_reg <= THR / SCALE), 1)) { mn = m_reg; alpha = 1.f; }
  else { mn = fmaxf(m_reg, pmax); alpha = __builtin_amdgcn_exp2f((m_reg - mn) * C); m_reg = mn; }
  float mnC = -mn * C;
  for (int r = 0; r < 16; ++r) p0[r] = fmaf(p0[r], C, mnC); for (int r = 0; r < 16; ++r) p1[r] = fmaf(p1[r], C, mnC);
  for (int r = 0; r < 16; ++r) p0[r] = __builtin_amdgcn_exp2f(p0[r]);
}
__device__ __forceinline__ void finishSM(f32x16& p0, f32x16& p1, float alpha, float& l_reg, bf16x8& pa0, bf16x8& pa1, bf16x8& pa2, bf16x8& pa3) {
  for (int r = 0; r < 16; ++r) p1[r] = __builtin_amdgcn_exp2f(p1[r]);
  float ps = 0; for (int r = 0; r < 16; ++r) ps += p0[r]; for (int r = 0; r < 16; ++r) ps += p1[r];
  { auto rr = __builtin_amdgcn_permlane32_swap(__float_as_uint(ps), __float_as_uint(ps), false, false);
    ps = __uint_as_float(rr[0]) + __uint_as_float(rr[1]); }
  l_reg = l_reg * alpha + ps;
#define PK4(P, BASE, OUT) do { unsigned a0 = cvtpk(P[BASE + 0], P[BASE + 1]), a1 = cvtpk(P[BASE + 2], P[BASE + 3]);   \
    unsigned b0 = cvtpk(P[BASE + 4], P[BASE + 5]), b1 = cvtpk(P[BASE + 6], P[BASE + 7]);                              \
    auto r0 = __builtin_amdgcn_permlane32_swap(a0, b0, false, false); auto r1 = __builtin_amdgcn_permlane32_swap(a1, b1, false, false); \
    u32x4 w = {r0[0], r1[0], r0[1], r1[1]}; OUT = *reinterpret_cast<bf16x8*>(&w); } while (0)
  PK4(p0, 0, pa0); PK4(p0, 8, pa1); PK4(p1, 0, pa2); PK4(p1, 8, pa3);
#undef PK4
}
__device__ __forceinline__ void qkt(f32x16& p0, f32x16& p1, const bf16* Ks, const bf16x8* qr, int r32, int hi) {
  p0 = f32x16{}; p1 = f32x16{};
  for (int d0 = 0; d0 < 8; ++d0) { int cb = (d0 * 16 + hi * 8) * 2;
    bf16x8 b0 = *reinterpret_cast<const bf16x8*>((const char*)Ks + KSWZ(r32, cb));
    bf16x8 b1 = *reinterpret_cast<const bf16x8*>((const char*)Ks + KSWZ(32 + r32, cb));
    p0 = __builtin_amdgcn_mfma_f32_32x32x16_bf16(b0, qr[d0], p0, 0, 0, 0);
    p1 = __builtin_amdgcn_mfma_f32_32x32x16_bf16(b1, qr[d0], p1, 0, 0, 0); }
}
__device__ __forceinline__ int v_st(int k, int c) { const int kk = (k & ~0xC) | ((k & 4) << 1) | ((k & 8) >> 1); return ((kk >> 3) * 4 + (c >> 5)) * 512 + ((kk & 7) * 32 + (c & 31)) * 2; }
__device__ __forceinline__ int v_rd_base(int lane) { return ((lane & 3) << 3) | (((lane >> 2) & 3) << 6) | (((lane >> 4) & 1) << 5) | (((lane >> 5) & 1) << 8); }
constexpr int v_rd_off(int d0, int ks, int half) { return d0 * 512 + ks * 4096 + half * 2048; }
template <int OFF> __device__ __forceinline__ s16x4 tr_read(int vb) {
  s16x4 r; asm volatile("ds_read_b64_tr_b16 %0, %1 offset:%2" : "=&v"(r) : "v"(vb), "i"(OFF) : "memory"); return r;
}
template <int D0> __device__ __forceinline__ void pv_one(f32x16& od, int vb, bf16x8 pa0, bf16x8 pa1, bf16x8 pa2, bf16x8 pa3) {
  const s16x4 l0 = tr_read<v_rd_off(D0, 0, 0)>(vb), h0 = tr_read<v_rd_off(D0, 0, 1)>(vb), l1 = tr_read<v_rd_off(D0, 1, 0)>(vb), h1 = tr_read<v_rd_off(D0, 1, 1)>(vb);
  const s16x4 l2 = tr_read<v_rd_off(D0, 2, 0)>(vb), h2 = tr_read<v_rd_off(D0, 2, 1)>(vb), l3 = tr_read<v_rd_off(D0, 3, 0)>(vb), h3 = tr_read<v_rd_off(D0, 3, 1)>(vb);
  asm volatile("s_waitcnt lgkmcnt(0)" ::: "memory"); SBAR();
#define PK(L, H) (bf16x8){L[0], L[1], L[2], L[3], H[0], H[1], H[2], H[3]}
  od = __builtin_amdgcn_mfma_f32_32x32x16_bf16(pa0, PK(l0, h0), od, 0, 0, 0);
  od = __builtin_amdgcn_mfma_f32_32x32x16_bf16(pa1, PK(l1, h1), od, 0, 0, 0);
  od = __builtin_amdgcn_mfma_f32_32x32x16_bf16(pa2, PK(l2, h2), od, 0, 0, 0);
  od = __builtin_amdgcn_mfma_f32_32x32x16_bf16(pa3, PK(l3, h3), od, 0, 0, 0);
#undef PK
}
__device__ __forceinline__ void pv_d0(f32x16* o, int vb, bf16x8 pa0, bf16x8 pa1, bf16x8 pa2, bf16x8 pa3) {
  pv_one<0>(o[0], vb, pa0, pa1, pa2, pa3); pv_one<1>(o[1], vb, pa0, pa1, pa2, pa3); pv_one<2>(o[2], vb, pa0, pa1, pa2, pa3); pv_one<3>(o[3], vb, pa0, pa1, pa2, pa3);
}

__device__ __forceinline__ float bf2f(short s) { return __uint_as_float(((unsigned)(unsigned short)s) << 16); }

__device__ __forceinline__ void qkt2(f32x16& p0, f32x16& p1, const bf16* Ks, const bf16x8* qr, const f32x16& negm, int r32, int hi) {
  p0 = negm; p1 = negm;
#pragma unroll
  for (int d0 = 0; d0 < 8; ++d0) { int cb = (d0 * 16 + hi * 8) * 2;
    bf16x8 b0 = *reinterpret_cast<const bf16x8*>((const char*)Ks + KSWZ(r32, cb));
    bf16x8 b1 = *reinterpret_cast<const bf16x8*>((const char*)Ks + KSWZ(32 + r32, cb));
    p0 = __builtin_amdgcn_mfma_f32_32x32x16_bf16(b0, qr[d0], p0, 0, 0, 0); p1 = __builtin_amdgcn_mfma_f32_32x32x16_bf16(b1, qr[d0], p1, 0, 0, 0); }
}
__device__ __forceinline__ void expA(f32x16& p0, float negmc) {
#pragma unroll
  for (int r = 0; r < 16; ++r) p0[r] = __builtin_amdgcn_exp2f(ATT_NEGM ? p0[r] : p0[r] + negmc);
}
__device__ __forceinline__ void finishSM2(f32x16& p0, f32x16& p1, float negmc, float& l_reg, bf16x8& pa0, bf16x8& pa1, bf16x8& pa2, bf16x8& pa3) {
#pragma unroll
  for (int r = 0; r < 16; ++r) p1[r] = __builtin_amdgcn_exp2f(ATT_NEGM ? p1[r] : p1[r] + negmc);
  float ps = 0;
#pragma unroll
  for (int r = 0; r < 16; ++r) ps += p0[r];
#pragma unroll
  for (int r = 0; r < 16; ++r) ps += p1[r];
  l_reg += ps;
#define PK4(P, BASE, OUT) do { unsigned a0 = cvtpk(P[BASE + 0], P[BASE + 1]), a1 = cvtpk(P[BASE + 2], P[BASE + 3]);   \
    unsigned b0 = cvtpk(P[BASE + 4], P[BASE + 5]), b1 = cvtpk(P[BASE + 6], P[BASE + 7]);                              \
    auto r0 = __builtin_amdgcn_permlane32_swap(a0, b0, false, false); auto r1 = __builtin_amdgcn_permlane32_swap(a1, b1, false, false); \
    u32x4 w = {r0[0], r1[0], r0[1], r1[1]}; OUT = *reinterpret_cast<bf16x8*>(&w); } while (0)
  PK4(p0, 0, pa0); PK4(p0, 8, pa1); PK4(p1, 0, pa2); PK4(p1, 8, pa3);
#undef PK4
}

__device__ __forceinline__ void attn_unit(const bf16* Qb, const bf16* __restrict__ Kh, const bf16* __restrict__ Vh,
                                          bf16* Ob, int seq, int t0, const float* __restrict__ qgain, const float2* __restrict__ rope, float negmc, char* lds) {
  using St = Stage<bf16>;
  const int tid = mk_tid(), wid = tid >> 6, lane = tid & 63, r32 = lane & 31, hi = lane >> 5;
  bf16* V_lds = (bf16*)lds; bf16* K_lds = (bf16*)(lds + 2 * SHM_V);
  float* ws = (float*)(lds + 2 * SHM_V + 2 * SHM_K) + wid * 64; float* li_l = ws;
  float l_reg = 0; f32x16 o[4] = {}; bf16x8 qr[8]; f32x16 negm; for (int r = 0; r < 16; ++r) negm[r] = ATT_NEGM ? negmc : 0.f; if (ATT_NEGM) asm volatile("" : "+v"(negm));
  const bf16* Qw = Qb + (long)(wid * QBLK + r32) * LDQ + hi * 8;
  {
    bf16x8 qraw[8]; float ss = 0.f;
#pragma unroll
    for (int d0 = 0; d0 < 8; ++d0) qraw[d0] = St::ld8(Qw + d0 * 16);
#pragma unroll
    for (int d0 = 0; d0 < 8; ++d0)
#pragma unroll
      for (int e = 0; e < 8; ++e) { const float v = bf2f(qraw[d0][e]); ss += v * v; }
    { auto rr = __builtin_amdgcn_permlane32_swap(__float_as_uint(ss), __float_as_uint(ss), false, false); ss = __uint_as_float(rr[0]) + __uint_as_float(rr[1]); }
    const float rstd = (SCALE * 1.4426950408889634f) / sqrtf(ss * (1.0f / 128.0f) + 1e-6f);
    const int t = t0 + wid * QBLK + r32, trow = t >> 6, tcol = t & 63;
#pragma unroll
    for (int d0 = 0; d0 < 8; ++d0) {
      const int pos = d0 < 4 ? trow : tcol;
      const float2* rp = rope + pos * 32 + ((8 * d0 + 4 * hi) & 31); const float* gp = qgain + 16 * d0 + 8 * hi;
      u32x4 w;
#pragma unroll
      for (int e2 = 0; e2 < 4; ++e2) {
        const float x0 = bf2f(qraw[d0][2 * e2]) * rstd * gp[2 * e2], x1 = bf2f(qraw[d0][2 * e2 + 1]) * rstd * gp[2 * e2 + 1];
        const float2 cs = rp[e2];
        w[e2] = cvtpk(x0 * cs.x - x1 * cs.y, x0 * cs.y + x1 * cs.x);
      }
      qr[d0] = *reinterpret_cast<bf16x8*>(&w);
    }
  }
  const int sr = tid >> 4, sc = (tid & 15) * 8, vst0 = v_st(sr, sc), vst1 = v_st(32 + sr, sc);
  const int vb0 = (int)(uintptr_t)V_lds + v_rd_base(lane);
  struct { typename St::T vs0, vs1, ks0, ks1; } sr_[SDEPTH];
#define SLOAD(i, k0) do { sr_[i].vs0 = St::ld8(&Vh[(long)((k0) + sr) * LDK + sc]); sr_[i].vs1 = St::ld8(&Vh[(long)((k0) + 32 + sr) * LDK + sc]); \
    sr_[i].ks0 = St::ld8(&Kh[(long)((k0) + sr) * LDK + sc]); sr_[i].ks1 = St::ld8(&Kh[(long)((k0) + 32 + sr) * LDK + sc]); } while (0)
#define SWRITE(b, i) do { *(bf16x8*)((char*)V_lds + (b) * SHM_V + vst0) = St::tobf(sr_[i].vs0);          \
    *(bf16x8*)((char*)V_lds + (b) * SHM_V + vst1) = St::tobf(sr_[i].vs1); int kc = sc * 2;               \
    *(bf16x8*)((char*)K_lds + (b) * SHM_K + KSWZ(sr, kc)) = St::tobf(sr_[i].ks0);                       \
    *(bf16x8*)((char*)K_lds + (b) * SHM_K + KSWZ(32 + sr, kc)) = St::tobf(sr_[i].ks1); } while (0)
#define SWAIT() do { if constexpr (SDEPTH == 2) asm volatile("s_waitcnt vmcnt(4)" ::: "memory"); else asm volatile("s_waitcnt vmcnt(0)" ::: "memory"); } while (0)
  f32x16 pA0, pA1, pB0, pB1; bf16x8 pa0, pa1, pa2, pa3; const int NT = seq / KVBLK;
  constexpr int SE = 0, SO = SDEPTH - 1;
  SLOAD(SE, 0); asm volatile("s_waitcnt vmcnt(0)" ::: "memory"); SWRITE(0, SE); __syncthreads();
  qkt2(pA0, pA1, K_lds, qr, negm, r32, hi); expA(pA0, negmc);
  SLOAD(SO, KVBLK); if constexpr (SDEPTH == 2) { if (2 < NT) SLOAD(SE, 2 * KVBLK); }
  SWAIT(); SWRITE(1, SO); __syncthreads();
  for (int j = 1; j + 1 < NT; j += 2) {
    SBAR(); qkt2(pB0, pB1, (bf16*)((char*)K_lds + SHM_K), qr, negm, r32, hi); if (ATT_SB) SBAR();
    finishSM2(pA0, pA1, negmc, l_reg, pa0, pa1, pa2, pa3); SBAR();
    SLOAD(SO, (j + SDEPTH) * KVBLK); SBAR();
    pv_d0(o, vb0, pa0, pa1, pa2, pa3); SBAR(); expA(pB0, negmc); SBAR();
    __syncthreads(); SWAIT(); SWRITE(0, SE);
    __syncthreads();
    SBAR(); qkt2(pA0, pA1, K_lds, qr, negm, r32, hi); if (ATT_SB) SBAR();
    finishSM2(pB0, pB1, negmc, l_reg, pa0, pa1, pa2, pa3); SBAR();
    if (SDEPTH == 1 || j + 3 < NT) SLOAD(SE, (j + 1 + SDEPTH) * KVBLK); SBAR();
    pv_d0(o, vb0 + (int)SHM_V, pa0, pa1, pa2, pa3); SBAR(); expA(pA0, negmc); SBAR();
    __syncthreads(); SWAIT(); SWRITE(1, SO);
    __syncthreads();
  }
  SBAR(); qkt2(pB0, pB1, (bf16*)((char*)K_lds + SHM_K), qr, negm, r32, hi);
  finishSM2(pA0, pA1, negmc, l_reg, pa0, pa1, pa2, pa3); SBAR();
  pv_d0(o, vb0, pa0, pa1, pa2, pa3); expA(pB0, negmc);
  __syncthreads();
  finishSM2(pB0, pB1, negmc, l_reg, pa0, pa1, pa2, pa3); SBAR();
  pv_d0(o, vb0 + (int)SHM_V, pa0, pa1, pa2, pa3);
  { auto rr = __builtin_amdgcn_permlane32_swap(__float_as_uint(l_reg), __float_as_uint(l_reg), false, false); l_reg = __uint_as_float(rr[0]) + __uint_as_float(rr[1]); }
  if (hi == 0) li_l[r32] = l_reg; asm volatile("s_waitcnt lgkmcnt(0)" ::: "memory");
  float rli[16];
#pragma unroll
  for (int r = 0; r < 16; ++r) rli[r] = __builtin_amdgcn_rcpf(li_l[crow(r, hi)]);
  { bf16* stg = (bf16*)(lds + OST_OFF) + wid * (32 * 128);
#pragma unroll
    for (int r = 0; r < 16; ++r) { const int orow = crow(r, hi);
#pragma unroll
      for (int d0 = 0; d0 < 4; ++d0) stg[orow * 128 + d0 * 32 + r32] = __float2bfloat16(o[d0][r] * rli[r]); }
    asm volatile("s_waitcnt lgkmcnt(0)" ::: "memory");
    bf16* Ow = Ob + (long)(wid * QBLK) * LDO;
#pragma unroll
    for (int i = 0; i < 8; ++i) { const int row = i * 4 + (lane >> 4), ch = lane & 15; const u32x4 v = *(const u32x4*)(stg + row * 128 + ch * 8); *(u32x4*)(Ow + (long)row * LDO + ch * 8) = v; }
    asm volatile("s_waitcnt lgkmcnt(0)" ::: "memory"); }
  __syncthreads();
#undef SLOAD
#undef SWRITE
#undef SWAIT
}
}

#define LAS __attribute__((address_space(3)))
typedef unsigned short bf16_t;
typedef unsigned v4u __attribute__((ext_vector_type(4)));
typedef float f32x4 __attribute__((ext_vector_type(4)));
typedef float f32x16 __attribute__((ext_vector_type(16)));
typedef short bf16x8 __attribute__((ext_vector_type(8)));
typedef short s16x4 __attribute__((ext_vector_type(4)));
#define LDS_WAIT() asm volatile("s_waitcnt lgkmcnt(0)" ::: "memory")

constexpr int NWAVES = 8, NTHREADS = 512;
constexpr int DM = 1024, DFF = 2816, NQKV = 1536;
constexpr int NTOK_P = 16384, NTOK_S = 32768, NTOK = 49152, SEQ_P = 8192, SEQ_S = 4096, NB_P = 2, NB_S = 8;
constexpr float EPS = 1e-6f;
constexpr size_t MiB = 1u << 20;
constexpr size_t WS_WGU = 1 * MiB, WS_WD = 45 * MiB, WS_WQKV = 67 * MiB, WS_WO = 73 * MiB, WS_W2 = 77 * MiB, WS_A1P = 85 * MiB, WS_A1S = 89 * MiB, WS_A2 = 90 * MiB, WS_ROPE = 90 * MiB + 65536, WS_QKG = 90 * MiB + 131072;
constexpr size_t WS_POOL = 92 * MiB, WS_RSS = 476 * MiB, WS_END = 482 * MiB, WS_TS = 90 * MiB + 196608;
constexpr size_t WS_F = WS_POOL, WS_T = WS_POOL + 192 * MiB, WS_HID = WS_POOL, WS_QO = WS_POOL, WS_K = WS_POOL + 96 * MiB, WS_V = WS_POOL + 120 * MiB, WS_XH = WS_POOL + 288 * MiB;
constexpr size_t RSS_STRIDE = (size_t)49152 * 4;
constexpr int LDS_BYTES = 147456;

__device__ __forceinline__ unsigned f2bf(float f) { unsigned u = __builtin_bit_cast(unsigned, f); return (u + 0x7fffu + ((u >> 16) & 1u)) >> 16; }
__device__ __forceinline__ unsigned pk2(float lo, float hi) { return f2bf(lo) | (f2bf(hi) << 16); }
__device__ __forceinline__ float wave_sum(float v) {
#pragma unroll
    for (int o = 1; o < 64; o <<= 1) v += __shfl_xor(v, o);
    return v;
}

template <class RowMap>
__device__ __forceinline__ void transpose_item(const float* __restrict__ W, int K, int N, bf16_t* WT, int ldk, const float* __restrict__ gain, RowMap rm, LAS float* scr, int item, int lane) {
    const int nblk = N / 64, kb = item / nblk, nb = item % nblk, k0 = 64 * kb, n0 = 64 * nb;
#pragma unroll
    for (int h = 0; h < 2; ++h) {
        float v[32];
#pragma unroll
        for (int i = 0; i < 32; ++i) v[i] = W[(size_t)(k0 + 32 * h + i) * N + n0 + lane];
#pragma unroll
        for (int i = 0; i < 32; ++i) { const int kk = 32 * h + i; float x = v[i]; if (gain) x *= gain[k0 + kk]; scr[kk * 64 + (lane ^ (kk & 0x38))] = x; }
    }
    LDS_WAIT(); asm volatile("" ::: "memory");
    const int c = lane & 7;
#pragma unroll
    for (int j = 0; j < 8; ++j) { const int n = (lane >> 3) + 8 * j; const LAS float* s = scr + (8 * c) * 64 + (n ^ (8 * c));
        v4u o; o.x = pk2(s[0 * 64], s[1 * 64]); o.y = pk2(s[2 * 64], s[3 * 64]); o.z = pk2(s[4 * 64], s[5 * 64]); o.w = pk2(s[6 * 64], s[7 * 64]);
        *(v4u*)(WT + (size_t)rm(n0 + n) * ldk + k0 + 8 * c) = o; }
    LDS_WAIT(); asm volatile("" ::: "memory");
}
struct RmId { __device__ __forceinline__ int operator()(int n) const { return n; } };
struct RmGU { int off; __device__ __forceinline__ int operator()(int n) const { return ((n >> 7) << 8) + (n & 127) + off; } };

__device__ __forceinline__ void cvt_row2(const float* xa, const float* xb, bf16_t* oa, bf16_t* ob, float* ra, float* rb, int lane) {
    const f32x4* pa = (const f32x4*)xa + lane; const f32x4* pb = (const f32x4*)xb + lane;
    f32x4 va[4], vb[4]; float sa = 0.f, sb = 0.f;
#pragma unroll
    for (int j = 0; j < 4; ++j) { va[j] = pa[64 * j]; vb[j] = pb[64 * j]; }
#pragma unroll
    for (int j = 0; j < 4; ++j) { sa += (va[j].x * va[j].x + va[j].y * va[j].y) + (va[j].z * va[j].z + va[j].w * va[j].w); sb += (vb[j].x * vb[j].x + vb[j].y * vb[j].y) + (vb[j].z * vb[j].z + vb[j].w * vb[j].w); }
    unsigned long long* qa = (unsigned long long*)oa + lane; unsigned long long* qb = (unsigned long long*)ob + lane;
#pragma unroll
    for (int j = 0; j < 4; ++j) { qa[64 * j] = (unsigned long long)pk2(va[j].x, va[j].y) | ((unsigned long long)pk2(va[j].z, va[j].w) << 32); qb[64 * j] = (unsigned long long)pk2(vb[j].x, vb[j].y) | ((unsigned long long)pk2(vb[j].z, vb[j].w) << 32); }
    sa = wave_sum(sa); sb = wave_sum(sb);
    if (lane == 0) { *(f32x4*)ra = (f32x4){sa, 0.f, 0.f, 0.f}; *(f32x4*)rb = (f32x4){sb, 0.f, 0.f, 0.f}; }
}

template <int OFF> __device__ __forceinline__ s16x4 tr_read_off(unsigned vb) {
    s16x4 r; asm volatile("ds_read_b64_tr_b16 %0, %1 offset:%2" : "=&v"(r) : "v"(vb), "i"(OFF) : "memory"); return r;
}
template <int KS, int NKS> struct BLoad {
    static __device__ __forceinline__ void run(bf16x8 (&b0)[NKS], bf16x8 (&b1)[NKS], unsigned base0, unsigned base1) {
        const s16x4 l0 = tr_read_off<(16 * KS) * 128>(base0), h0 = tr_read_off<(16 * KS + 4) * 128>(base0);
        const s16x4 l1 = tr_read_off<(16 * KS) * 128>(base1), h1 = tr_read_off<(16 * KS + 4) * 128>(base1);
        asm volatile("s_waitcnt lgkmcnt(0)" ::: "memory");
        b0[KS] = (bf16x8){l0[0], l0[1], l0[2], l0[3], h0[0], h0[1], h0[2], h0[3]};
        b1[KS] = (bf16x8){l1[0], l1[1], l1[2], l1[3], h1[0], h1[1], h1[2], h1[3]};
        if constexpr (KS + 1 < NKS) BLoad<KS + 1, NKS>::run(b0, b1, base0, base1);
    }
};
template <int KT, int MT, bool SC>
__device__ __forceinline__ void fft_unit(const bf16_t* __restrict__ A, const bf16_t* __restrict__ in, size_t in_stride, bf16_t* out, size_t so1, size_t so0, char* wl, int lane, const float* rs = nullptr, size_t rs_stride = 0) {
    constexpr int NKS = KT / 16;
    const int r32 = lane & 31, hi = lane >> 5;
    { const int lr = lane >> 3, ch = lane & 7;
      v4u dv[KT / 8]; f32x4 pq[SC ? KT / 8 : 1];
#pragma unroll
      for (int i = 0; i < KT / 8; ++i) dv[i] = *(const v4u*)(in + (size_t)(i * 8 + lr) * in_stride + ch * 8);
      if constexpr (SC) {
#pragma unroll
          for (int i = 0; i < KT / 8; ++i) pq[i] = *(const f32x4*)(rs + (size_t)(i * 8 + lr) * rs_stride * 4);
      }
#pragma unroll
      for (int i = 0; i < KT / 8; ++i) { const int row = i * 8 + lr; v4u v = dv[i];
          if constexpr (SC) { const float r = __builtin_amdgcn_rsqf(((pq[i][0] + pq[i][1]) + (pq[i][2] + pq[i][3])) * (1.0f / 1024.0f) + 1e-6f);
              v.x = pg8::cvt_pk_bf16(pg8::bflo(v.x) * r, pg8::bfhi(v.x) * r); v.y = pg8::cvt_pk_bf16(pg8::bflo(v.y) * r, pg8::bfhi(v.y) * r); v.z = pg8::cvt_pk_bf16(pg8::bflo(v.z) * r, pg8::bfhi(v.z) * r); v.w = pg8::cvt_pk_bf16(pg8::bflo(v.w) * r, pg8::bfhi(v.w) * r); }
          *(v4u*)(wl + row * 128 + 16 * (ch ^ (((row >> 1) & 1) << 2))) = v; } }
    LDS_WAIT(); asm volatile("" ::: "memory");
    bf16x8 b0[NKS], b1[NKS];
    { const int blk = (lane >> 4) & 1, q = (lane & 15) >> 2, p = lane & 3, qb = (q >> 1) & 1;
      const unsigned basel = (unsigned)(uintptr_t)wl + (unsigned)((8 * hi + q) * 128 + 16 * (2 * blk + (p >> 1)) + 8 * (p & 1));
      BLoad<0, NKS>::run(b0, b1, basel + 64u * (unsigned)qb, basel + 64u * (unsigned)(1 - qb)); }
    asm volatile("" ::: "memory");
    bf16_t* stg = (bf16_t*)wl;
    bf16x8 af[NKS], an[NKS];
#pragma unroll
    for (int ks = 0; ks < NKS; ++ks) an[ks] = *(const bf16x8*)(A + (size_t)r32 * KT + 16 * ks + 8 * hi);
#pragma unroll 1
    for (int mb = 0; mb < MT / 32; ++mb) {
#pragma unroll
        for (int ks = 0; ks < NKS; ++ks) af[ks] = an[ks];
        { const int mbn = mb + 1 < MT / 32 ? mb + 1 : mb;
#pragma unroll
          for (int ks = 0; ks < NKS; ++ks) an[ks] = *(const bf16x8*)(A + (size_t)(32 * mbn + r32) * KT + 16 * ks + 8 * hi); }
        f32x16 c0 = {}, c1 = {};
#pragma unroll
        for (int ks = 0; ks < NKS; ++ks) { c0 = __builtin_amdgcn_mfma_f32_32x32x16_bf16(af[ks], b0[ks], c0, 0, 0, 0); c1 = __builtin_amdgcn_mfma_f32_32x32x16_bf16(af[ks], b1[ks], c1, 0, 0, 0); }
#pragma unroll
        for (int r = 0; r < 16; ++r) { const int orow = (r & 3) + 8 * (r >> 2) + 4 * hi; stg[orow * 64 + r32] = (bf16_t)f2bf(c0[r]); stg[orow * 64 + 32 + r32] = (bf16_t)f2bf(c1[r]); }
        LDS_WAIT(); asm volatile("" ::: "memory");
#pragma unroll
        for (int i = 0; i < 4; ++i) { const int row = i * 8 + (lane >> 3), ch = lane & 7, m = 32 * mb + row; const v4u v = *(const v4u*)(stg + row * 64 + ch * 8);
            *(v4u*)(out + (size_t)(m >> 1) * so1 + (size_t)(m & 1) * so0 + ch * 8) = v; }
        LDS_WAIT(); asm volatile("" ::: "memory");
    }
}

typedef __attribute__((address_space(1))) unsigned gu32;
#define XB_TMO      128
#define XB_XCNT(j)  (256  + 64 * (j))
#define XB_XSUB(j)  (1280 + 64 * (j))
#define XB_XGEN(j)  (2304 + 64 * (j))
#define XB_TOP      3328
#define XB_TOPGEN   3392
#define XCD_BAR_WORDS 3456
#define XB_SPIN_CAP (1u << 22)

__device__ __forceinline__ unsigned xb_ld(unsigned* p)              { return __hip_atomic_load(p, __ATOMIC_RELAXED, __HIP_MEMORY_SCOPE_AGENT); }
__device__ __forceinline__ unsigned xb_add(unsigned* p, unsigned v) { return __hip_atomic_fetch_add(p, v, __ATOMIC_RELAXED, __HIP_MEMORY_SCOPE_AGENT); }
__device__ __forceinline__ unsigned xb_xcc_id() { return (unsigned)__builtin_amdgcn_s_getreg((3 << 11) | 20) & 0xFu; }
#define XB_SPIN(cond, bar) do { unsigned _sp = 0; while (cond) { __builtin_amdgcn_s_sleep(1); \
    if ((++_sp & 255u) == 0u) { if (xb_ld(&(bar)[XB_TMO])) break; if (_sp > XB_SPIN_CAP) { atomicAdd(&(bar)[XB_TMO], 1u); break; } } } } while (0)

struct XcdBarrier {
    unsigned* bar; unsigned x;
    volatile LAS unsigned* st;
};

__device__ __forceinline__ XcdBarrier xcd_barrier_post(unsigned* bar, volatile LAS unsigned* st) {
    XcdBarrier b; b.bar = bar; b.x = xb_xcc_id(); b.st = st;
    if (threadIdx.x == 0) (void)xb_add(&bar[XB_XCNT(b.x)], 1u);
    return b;
}
__device__ __forceinline__ void xcd_barrier_complete(unsigned* bar, unsigned x, unsigned& nloc, unsigned& nx) {
    const unsigned G = gridDim.x * gridDim.y * gridDim.z;
    unsigned sum, cnt, mine, sp = 0u;
    for (;;) {
        sum = 0u; cnt = 0u; mine = 0u;
#pragma unroll
        for (unsigned j = 0; j < 16; ++j) { const unsigned c = xb_ld(&bar[XB_XCNT(j)]); sum += c; cnt += (c > 0u) ? 1u : 0u; mine = (j == x) ? c : mine; }
        if (sum == G) break;
        __builtin_amdgcn_s_sleep(1);
        if ((++sp & 255u) == 0u) { if (xb_ld(&bar[XB_TMO])) break; if (sp > XB_SPIN_CAP) { atomicAdd(&bar[XB_TMO], 1u); break; } }
    }
    nloc = mine > 0u ? mine : 1u; nx = cnt > 0u ? cnt : 1u;
}

__device__ __forceinline__ void xcd_barrier(const XcdBarrier& b) {
    asm volatile("s_waitcnt vmcnt(0)" ::: "memory");
    __syncthreads();
    if (threadIdx.x == 0) {
        unsigned* bar = b.bar;
        __builtin_amdgcn_s_waitcnt(0);
        unsigned nloc = b.st[0], nx = b.st[1];
        if (nloc == 0u) { xcd_barrier_complete(bar, b.x, nloc, nx); b.st[0] = nloc; b.st[1] = nx; }
        const unsigned old = xb_add(&bar[XB_XSUB(b.x)], 1u);
        const unsigned gen = old / nloc;
        if (old + 1u == (gen + 1u) * nloc) {
            __builtin_amdgcn_fence(__ATOMIC_RELEASE, "agent");
            asm volatile("s_waitcnt vmcnt(0)" ::: "memory");
            const unsigned og = xb_add(&bar[XB_TOP], 1u);
            const unsigned tg = og / nx;
            if (og + 1u == (tg + 1u) * nx) xb_add(&bar[XB_TOPGEN], 1u);
            else XB_SPIN(xb_ld(&bar[XB_TOPGEN]) == tg, bar);
            __builtin_amdgcn_fence(__ATOMIC_ACQUIRE, "agent");
            xb_add(&bar[XB_XGEN(b.x)], 1u);
            asm volatile("s_waitcnt vmcnt(0)" ::: "memory");
        } else {
            XB_SPIN(xb_ld(&bar[XB_XGEN(b.x)]) == gen, bar);
            __builtin_amdgcn_fence(__ATOMIC_ACQUIRE, "agent");
            asm volatile("s_waitcnt vmcnt(0)" ::: "memory");
        }
    }
    __syncthreads();
}
constexpr int NPH_C = 23;
struct Args { const float* in[12]; float* out; unsigned char* ws; int ph_lo, ph_hi; };

__global__ void __launch_bounds__(NTHREADS, 2) mk_fwd(Args args) {
    extern __shared__ __attribute__((aligned(16))) unsigned char lds[];
    const int G = gridDim.x; const int bx = blockIdx.x; const int vcu = (G % 8 == 0) ? (bx % 8) * (G / 8) + bx / 8 : bx;
    const int NGW = G * NWAVES;
    unsigned char* ws = args.ws; float* X = args.out;
    bf16_t* Wgu = (bf16_t*)(ws + WS_WGU); bf16_t* Wd = (bf16_t*)(ws + WS_WD); bf16_t* Wqkv = (bf16_t*)(ws + WS_WQKV); bf16_t* Wo = (bf16_t*)(ws + WS_WO); bf16_t* W2 = (bf16_t*)(ws + WS_W2);
    bf16_t* A1P = (bf16_t*)(ws + WS_A1P); bf16_t* A1S = (bf16_t*)(ws + WS_A1S); bf16_t* A2 = (bf16_t*)(ws + WS_A2); float2* ROPE = (float2*)(ws + WS_ROPE); float* QKG = (float*)(ws + WS_QKG);
    bf16_t* XB0 = (bf16_t*)args.out; bf16_t* XBH = (bf16_t*)(ws + WS_XH); float* RSS = (float*)(ws + WS_RSS); bf16_t* FB = (bf16_t*)(ws + WS_F); bf16_t* TB = (bf16_t*)(ws + WS_T); bf16_t* HID = (bf16_t*)(ws + WS_HID);
    bf16_t* QO = (bf16_t*)(ws + WS_QO); bf16_t* KB = (bf16_t*)(ws + WS_K); bf16_t* VB = (bf16_t*)(ws + WS_V);
    LAS unsigned char* ldsl = (LAS unsigned char*)lds;
    const int lo = args.ph_lo, hi = args.ph_hi;
    int ph = 0;
    volatile LAS unsigned* MISC = (volatile LAS unsigned*)(ldsl + 131072 + 8192);
    if (threadIdx.x < 64) MISC[threadIdx.x] = 0u;
    __syncthreads();
    XcdBarrier xbar = xcd_barrier_post((unsigned*)(ws + 16384), MISC + 8);
    unsigned long long* TS = (unsigned long long*)(ws + WS_TS);
    if (MK_PROBE && bx == 0 && threadIdx.x == 0) TS[0] = __builtin_amdgcn_s_memrealtime();
#define PH_BEGIN if (ph >= lo && ph < hi) { const int tid = mk_tid(), lane = tid & 63, wave = __builtin_amdgcn_readfirstlane(tid >> 6), gw = vcu * NWAVES + wave; (void)lane; (void)gw;
#define PH_END } ++ph; if (ph > lo && ph < hi) { if (ph == 1 || MK_CG_ONLY) cg::this_grid().sync(); else xcd_barrier(xbar); } if (MK_PROBE && bx == 0 && threadIdx.x == 0) TS[ph] = __builtin_amdgcn_s_memrealtime();

    PH_BEGIN
    if (EN_P0) {
        LAS float* scr = (LAS float*)(ldsl + wave * 16384);
        if (MK_PROBE2 && bx == 0 && threadIdx.x == 0) TS[40] = __builtin_amdgcn_s_memrealtime();
        constexpr int I_G = 16 * 44, I_D = 44 * 16, I_QKV = 16 * 24, I_O = 16 * 16;
        constexpr int NITEMS = 4 * (2 * I_G + I_D) + 2 * (I_QKV + I_O);
        for (int it = gw; it < NITEMS; it += NGW) {
            int r = it;
            if (r < 4 * I_G) { const int l = r / I_G; transpose_item(args.in[9] + (size_t)l * DM * DFF, DM, DFF, Wgu + (size_t)l * 2 * DFF * DM, DM, args.in[3] + l * DM, RmGU{0}, scr, r % I_G, lane); continue; } r -= 4 * I_G;
            if (r < 4 * I_G) { const int l = r / I_G; transpose_item(args.in[10] + (size_t)l * DM * DFF, DM, DFF, Wgu + (size_t)l * 2 * DFF * DM, DM, args.in[3] + l * DM, RmGU{128}, scr, r % I_G, lane); continue; } r -= 4 * I_G;
            if (r < 4 * I_D) { const int l = r / I_D; transpose_item(args.in[11] + (size_t)l * DFF * DM, DFF, DM, Wd + (size_t)l * DM * DFF, DFF, (const float*)nullptr, RmId{}, scr, r % I_D, lane); continue; } r -= 4 * I_D;
            if (r < 2 * I_QKV) { const int j = r / I_QKV; transpose_item(args.in[5] + (size_t)j * DM * NQKV, DM, NQKV, Wqkv + (size_t)j * NQKV * DM, DM, args.in[2] + (2 * j + 1) * DM, RmId{}, scr, r % I_QKV, lane); continue; } r -= 2 * I_QKV;
            { const int j = r / I_O; transpose_item(args.in[8] + (size_t)j * DM * DM, DM, DM, Wo + (size_t)j * DM * DM, DM, (const float*)nullptr, RmId{}, scr, r % I_O, lane); }
        }
        if (MK_PROBE2) { __syncthreads(); if (bx == 0 && threadIdx.x == 0) TS[41] = __builtin_amdgcn_s_memrealtime(); }
        { LAS float* tab = scr;
          for (int i = lane; i < 128; i += 64) { tab[i] = cospif((float)i * (1.0f / 64.0f)); tab[128 + i] = sinpif((float)i * (1.0f / 64.0f)); }
          LDS_WAIT(); asm volatile("" ::: "memory");
          for (int task = gw; task < 2048; task += NGW) {
              const int nb = task & 15, cc = (task >> 4) & 3, g = (task >> 6) & 7, p = (task >> 9) & 1, j = task >> 10;
              const int n = nb * 64 + lane; const float* w = args.in[4] + (size_t)j * DM * DM + (size_t)(g * 128) * DM + n; const LAS float* tb = tab + p * 128;
              float acc[32];
#pragma unroll
              for (int ci = 0; ci < 32; ++ci) acc[ci] = 0.f;
              for (int jp0 = 0; jp0 < 128; jp0 += 8) { float wv[8];
#pragma unroll
                  for (int d = 0; d < 8; ++d) wv[d] = w[(size_t)(jp0 + d) * DM];
#pragma unroll
                  for (int d = 0; d < 8; ++d)
#pragma unroll
                      for (int ci = 0; ci < 32; ++ci) acc[ci] += tb[((cc * 32 + ci) * (jp0 + d)) & 127] * wv[d]; }
              const float* gain = args.in[2] + (2 * j) * DM + g * 128 + cc * 32;
              bf16_t* dst = W2 + (size_t)j * DM * 2048 + (size_t)n * 2048 + p * 1024 + g * 128 + cc * 32;
#pragma unroll
              for (int q4 = 0; q4 < 4; ++q4) { v4u o; const float sc = 0.08838834764831845f;
                  o.x = pk2(acc[8 * q4 + 0] * gain[8 * q4 + 0] * sc, acc[8 * q4 + 1] * gain[8 * q4 + 1] * sc); o.y = pk2(acc[8 * q4 + 2] * gain[8 * q4 + 2] * sc, acc[8 * q4 + 3] * gain[8 * q4 + 3] * sc);
                  o.z = pk2(acc[8 * q4 + 4] * gain[8 * q4 + 4] * sc, acc[8 * q4 + 5] * gain[8 * q4 + 5] * sc); o.w = pk2(acc[8 * q4 + 6] * gain[8 * q4 + 6] * sc, acc[8 * q4 + 7] * gain[8 * q4 + 7] * sc);
                  *(v4u*)(dst + 8 * q4) = o; }
          }
          LDS_WAIT(); asm volatile("" ::: "memory");
        }
        if (MK_PROBE2) { __syncthreads(); if (bx == 0 && threadIdx.x == 0) TS[42] = __builtin_amdgcn_s_memrealtime(); }
        { const int gt = gw * 64 + lane, NGT = NGW * 64;
          for (int e2 = gt; e2 < 64 * 256 * 64; e2 += NGT) {
              const int s1 = (e2 & 63) * 2, m = (e2 >> 6) & 255, s2 = e2 >> 14, k1 = m >> 1, pp = m & 1; float v[2];
#pragma unroll
              for (int d = 0; d < 2; ++d) { const int s = 64 * (s1 + d) + s2, r = (k1 * s) & 8191; const float x = (float)r * (1.0f / 4096.0f); v[d] = (pp ? -sinpif(x) : cospif(x)) * 0.08838834764831845f; }
              ((unsigned*)A1P)[e2] = pk2(v[0], v[1]); }
          for (int e2 = gt; e2 < 64 * 128 * 32; e2 += NGT) {
              const int s1 = (e2 & 31) * 2, m = (e2 >> 5) & 127, s2 = e2 >> 12, k1 = m >> 1, pp = m & 1; float v[2];
#pragma unroll
              for (int d = 0; d < 2; ++d) { const int s = 64 * (s1 + d) + s2, r = (k1 * s) & 4095; const float x = (float)r * (1.0f / 2048.0f); v[d] = (pp ? -sinpif(x) : cospif(x)) * 0.125f; }
              ((unsigned*)A1S)[e2] = pk2(v[0], v[1]); }
          for (int e2 = gt; e2 < 128 * 64; e2 += NGT) {
              const int k = (e2 & 63) * 2, m = e2 >> 6, k2 = m >> 1, pp = m & 1, p = k >> 6; float v[2];
#pragma unroll
              for (int d = 0; d < 2; ++d) { const int s2 = (k + d) & 63, r = (k2 * s2) & 63; const float x = (float)r * (1.0f / 32.0f); const float c = cospif(x), s = sinpif(x);
                  v[d] = (pp == 0 ? (p == 0 ? c : s) : (p == 0 ? -s : c)) * 0.125f; }
              ((unsigned*)A2)[e2] = pk2(v[0], v[1]); }
          if (gw == 0) {
#pragma unroll
              for (int j2 = 0; j2 < 2; ++j2) { float mq = fmaxf(fabsf(args.in[6][j2 * 128 + lane]), fabsf(args.in[6][j2 * 128 + 64 + lane])), mk = fmaxf(fabsf(args.in[7][j2 * 128 + lane]), fabsf(args.in[7][j2 * 128 + 64 + lane]));
#pragma unroll
                  for (int o = 1; o < 64; o <<= 1) { mq = fmaxf(mq, __shfl_xor(mq, o)); mk = fmaxf(mk, __shfl_xor(mk, o)); }
                  if (lane == 0) QKG[512 + j2] = -(128.0f * 1.02f * mq * mk) * (att::SCALE * 1.4426950408889634f); }
          }
          for (int e = gt; e < 512; e += NGT) { const int j = e >> 8, r = e & 255; QKG[e] = r < 128 ? args.in[6][j * 128 + r] : args.in[7][j * 128 + r - 128]; }
          for (int e = gt; e < 128 * 32; e += NGT) { const int i = e & 31, pos = e >> 5; const float inv = powf(10000.0f, -(float)i * (1.0f / 32.0f)); const float a = (float)pos * inv; ROPE[e] = make_float2(cosf(a), sinf(a)); }
        }
        if (MK_PROBE2) { __syncthreads(); if (bx == 0 && threadIdx.x == 0) TS[43] = __builtin_amdgcn_s_memrealtime(); }
        for (int m = 2 * gw; m < NTOK; m += 2 * NGW) { const float* src = m < NTOK_P ? args.in[0] + (size_t)m * DM : args.in[1] + (size_t)(m - NTOK_P) * DM; cvt_row2(src, src + DM, XB0 + (size_t)m * DM, XB0 + (size_t)(m + 1) * DM, RSS + (size_t)m * 4, RSS + (size_t)(m + 1) * 4, lane); }
    }
    PH_END

    for (int layer = 0; layer < 4; ++layer) {
        const int jj = layer >> 1;
        const float* rss_mix = RSS + (size_t)(2 * layer) * RSS_STRIDE;
        float* rss_ffn = RSS + (size_t)(2 * layer + 1) * RSS_STRIDE;
        float* rss_next = RSS + (size_t)(2 * layer + 2) * RSS_STRIDE;
        bf16_t* XBF = layer == 3 ? XBH : XB0;
        PG8_LAS float* Pscr = (PG8_LAS float*)(ldsl + 131072);
        if ((layer & 1) == 0) {
            PH_BEGIN
            if (EN_FFT) {
                char* wl = (char*)lds + wave * 16384;
                for (int u = gw; u < 2048; u += NGW) { const int cb = u & 15, s2 = (u >> 4) & 63, b = u >> 10; const size_t tok = (size_t)b * SEQ_P + s2;
                    fft_unit<128, 256, true>(A1P + (size_t)s2 * 256 * 128, XB0 + tok * DM + cb * 64, (size_t)64 * DM, TB + ((size_t)b * 2 * SEQ_P + s2) * DM + cb * 64, (size_t)2 * 64 * DM, (size_t)64 * DM, wl, lane, rss_mix + tok * 4, (size_t)64); }
                for (int u = gw; u < 8192; u += NGW) { const int cb = u & 15, s2 = (u >> 4) & 63, b = u >> 10; const size_t tok = (size_t)NTOK_P + (size_t)b * SEQ_S + s2;
                    fft_unit<64, 128, true>(A1S + (size_t)s2 * 128 * 64, XB0 + tok * DM + cb * 64, (size_t)64 * DM, TB + ((size_t)2 * NTOK_P + (size_t)b * 2 * SEQ_S + s2) * DM + cb * 64, (size_t)2 * 64 * DM, (size_t)64 * DM, wl, lane, rss_mix + tok * 4, (size_t)64); }
            }
            PH_END
            PH_BEGIN
            if (EN_FFT) {
                char* wl = (char*)lds + wave * 16384;
                for (int u = gw; u < 4096 + 8192; u += NGW) {
                    const bool P = u < 4096; const int v = P ? u : u - 4096; const int cb = v & 15; const int k1 = P ? ((v >> 4) & 127) : ((v >> 4) & 63); const int b = P ? (v >> 11) : (v >> 10);
                    const size_t trow = P ? ((size_t)b * 2 * SEQ_P + (size_t)k1 * 128) : ((size_t)2 * NTOK_P + (size_t)b * 2 * SEQ_S + (size_t)k1 * 128);
                    const size_t frow = P ? ((size_t)b * SEQ_P + k1) : ((size_t)NTOK_P + (size_t)b * SEQ_S + k1);
                    fft_unit<128, 128, false>(A2, TB + trow * DM + cb * 64, (size_t)DM, FB + frow * 2048 + cb * 64, P ? (size_t)128 * 2048 : (size_t)64 * 2048, (size_t)1024, wl, lane);
                }
            }
            PH_END
        } else {
            PH_BEGIN
            if (EN_QKV) {
                pg8::Gemm g{XB0, Wqkv + (size_t)jj * NQKV * DM, NTOK, NQKV, DM}; pg8::StaticOrder S; S.init(NTOK, NQKV, G, bx);
                pg8::EpiQKV E{QO, KB, VB, rss_mix};
                pg8::gemm_phase<pg8::EpiQKV, pg8::StaticOrder, GU_ALIGN, GEMM_SP2>(ldsl, g, S, E);
            }
            PH_END
            PH_BEGIN
            if (EN_MISC) {
                const float* kg = QKG + jj * 256 + 128;
                for (int rix = gw; rix < NTOK * 2; rix += NGW) {
                    const int tok = rix >> 1, kvh = rix & 1; const int t = tok < NTOK_P ? (tok & (SEQ_P - 1)) : ((tok - NTOK_P) & (SEQ_S - 1));
                    unsigned* kp = (unsigned*)(KB + (size_t)tok * 256 + kvh * 128) + lane; const unsigned raw = *kp;
                    float x0 = __uint_as_float(raw << 16), x1 = __uint_as_float(raw & 0xffff0000u);
                    const float rstd = 1.f / sqrtf(wave_sum(x0 * x0 + x1 * x1) * (1.0f / 128.0f) + EPS);
                    x0 *= rstd * kg[2 * lane]; x1 *= rstd * kg[2 * lane + 1];
                    const int pos = lane < 32 ? (t >> 6) : (t & 63); const float2 cs = ROPE[pos * 32 + (lane & 31)];
                    *kp = pk2(x0 * cs.x - x1 * cs.y, x0 * cs.y + x1 * cs.x);
                }
            }
            PH_END
            PH_BEGIN
            if (EN_ATT) {
                const float* qg = QKG + jj * 256; const float negmc = QKG[512 + jj];
                for (int j = vcu; j < 1536; j += G) {
                    int b, h, qb, tok0, seq;
                    if (j < 512) { const int bh = j >> 5; qb = j & 31; b = bh >> 3; h = bh & 7; tok0 = b * SEQ_P; seq = SEQ_P; }
                    else { const int v = j - 512, bh = v >> 4; qb = v & 15; b = bh >> 3; h = bh & 7; tok0 = NTOK_P + b * SEQ_S; seq = SEQ_S; }
                    const att::bf16* Qb = (const att::bf16*)QO + ((size_t)tok0 + qb * 256) * 1024 + h * 128;
                    const att::bf16* Kh = (const att::bf16*)KB + (size_t)tok0 * 256 + (h >> 2) * 128;
                    const att::bf16* Vh = (const att::bf16*)VB + (size_t)tok0 * 256 + (h >> 2) * 128;
                    att::attn_unit(Qb, Kh, Vh, (att::bf16*)Qb, seq, qb * 256, qg, ROPE, negmc, (char*)lds);
                }
            }
            PH_END
        }
        PH_BEGIN
        if (EN_RES) {
            pg8::Gemm g = (layer & 1) ? pg8::Gemm{QO, Wo + (size_t)jj * DM * DM, NTOK, DM, DM} : pg8::Gemm{FB, W2 + (size_t)jj * DM * 2048, NTOK, DM, 2048};
            pg8::StaticOrder S; S.init(NTOK, DM, G, bx); pg8::EpiResB E{XB0, XBF, (float*)nullptr, rss_ffn, Pscr};
            pg8::gemm_phase<pg8::EpiResB, pg8::StaticOrder, true, GEMM_SP2>(ldsl, g, S, E);
        }
        PH_END
        PH_BEGIN
        if (EN_GU) {
            if (MK_SLEEP_US) { const unsigned long long t0 = __builtin_amdgcn_s_memrealtime(); while (__builtin_amdgcn_s_memrealtime() - t0 < 100ull * MK_SLEEP_US) __builtin_amdgcn_s_sleep(64); }
            pg8::Gemm g{XBF, Wgu + (size_t)layer * 2 * DFF * DM, NTOK, 2 * DFF, DM}; pg8::StaticOrder S; S.init(NTOK, 2 * DFF, G, bx);
            pg8::EpiSwiGLU E{HID, DFF, rss_ffn};
            pg8::gemm_phase<pg8::EpiSwiGLU, pg8::StaticOrder, GU_ALIGN, GEMM_SP2>(ldsl, g, S, E);
        }
        PH_END
        PH_BEGIN
        if (EN_RES) {
            pg8::Gemm g{HID, Wd + (size_t)layer * DM * DFF, NTOK, DM, DFF}; pg8::StaticOrder S; S.init(NTOK, DM, G, bx); S.rev = MK_DREV;
            pg8::EpiResB E{XBF, XB0, layer == 3 ? X : (float*)nullptr, layer == 3 ? (float*)nullptr : rss_next, Pscr};
            pg8::gemm_phase<pg8::EpiResB, pg8::StaticOrder, true, GEMM_SP2>(ldsl, g, S, E);
        }
        PH_END
    }
#undef PH_BEGIN
#undef PH_END
    for (int i = 0; i < MK_EXTRA_SYNC; ++i) cg::this_grid().sync();
    if (MK_PROBE && bx == 0 && threadIdx.x == 0) {
        unsigned long long sa = 0, sb = 0; const unsigned long long tot = TS[NPH_C] - TS[0];
        for (int i = 0; i < NPH_C; ++i) { const unsigned long long d = TS[i + 1] - TS[i]; if ((MK_MASK_A >> i) & 1u) sa += d; if ((MK_MASK_B >> i) & 1u) sb += d; }
        if (MK_PROBE2) { unsigned long long q[5] = {TS[40], TS[41], TS[42], TS[43], TS[1]}; sa = q[MK_PA + 1] - q[MK_PA]; sb = q[MK_PB + 1] - q[MK_PB]; sa *= 10; sb *= 10; }
        const unsigned long long pa = (sa * 100 + tot / 2) / tot, pb = (sb * 100 + tot / 2) / tot;
        const unsigned long long D = 2000ull * (pa * 100 + pb);
        while (__builtin_amdgcn_s_memrealtime() - TS[NPH_C] < D) __builtin_amdgcn_s_sleep(32);
    }
}
constexpr int NPHASES = NPH_C;

extern "C" void kernel_launch(void* const* d_in, const int* in_sizes, int n_in, void* d_out, int out_size, void* d_ws, size_t ws_size, hipStream_t stream) {
    static int grid = 0;
    if (grid == 0) {
        if (n_in != 12 || out_size != NTOK * DM || ws_size < WS_END) { fprintf(stderr, "kernel_launch: unexpected shapes: n_in %d out %d ws %zu (need %zu)\n", n_in, out_size, ws_size, (size_t)WS_END); grid = -1; return; }
        int dev = 0, cus = 0, per_cu = 0;
        hipGetDevice(&dev); hipDeviceGetAttribute(&cus, hipDeviceAttributeMultiprocessorCount, dev);
        if (hipFuncSetAttribute((const void*)mk_fwd, hipFuncAttributeMaxDynamicSharedMemorySize, LDS_BYTES) != hipSuccess) { fprintf(stderr, "kernel_launch: hipFuncSetAttribute failed\n"); grid = -1; return; }
        if (hipOccupancyMaxActiveBlocksPerMultiprocessor(&per_cu, (const void*)mk_fwd, NTHREADS, LDS_BYTES) != hipSuccess || per_cu < 1) { fprintf(stderr, "kernel_launch: occupancy query gave %d\n", per_cu); per_cu = 1; }
        (void)hipGetLastError();
        grid = cus * per_cu;
        fprintf(stderr, "kernel_launch: grid %d (cus %d x %d)\n", grid, cus, per_cu);
    }
    if (grid < 0) return;
    if (hipMemsetAsync(d_ws, 0, 65536, stream) != hipSuccess) { fprintf(stderr, "kernel_launch: memset failed\n"); return; }
    Args a{};
    for (int i = 0; i < 12; ++i) a.in[i] = (const float*)d_in[i];
    a.out = (float*)d_out; a.ws = (unsigned char*)d_ws;
#if MK_ONE_LAUNCH
    a.ph_lo = 0; a.ph_hi = NPHASES;
    void* kargs[] = {&a};
    hipError_t e = hipLaunchCooperativeKernel((const void*)mk_fwd, dim3(grid), dim3(NTHREADS), kargs, LDS_BYTES, stream);
    if (e != hipSuccess) fprintf(stderr, "kernel_launch: cooperative launch failed: %s (grid %d)\n", hipGetErrorString(e), grid);
#else
    for (int p = 0; p < NPHASES; ++p) { a.ph_lo = p; a.ph_hi = p + 1; hipLaunchKernelGGL(mk_fwd, dim3(grid), dim3(NTHREADS), LDS_BYTES, stream, a); }
    hipError_t e = hipPeekAtLastError();
    if (e != hipSuccess) fprintf(stderr, "kernel_launch: launch failed: %s\n", hipGetErrorString(e));
#endif
}
```

```cpp
#include <hip/hip_runtime.h>
#define ATT_SDEPTH 1
#define ATT_NEGM 1
#include <hip/hip_bf16.h>
#include <hip/hip_cooperative_groups.h>
#include <cstdio>
#include <cstdint>
namespace cg = cooperative_groups;

#ifndef EN_P0
#define EN_P0 1
#endif
#ifndef EN_FFT
#define EN_FFT 1
#endif
#ifndef EN_QKV
#define EN_QKV 1
#endif
#ifndef EN_MISC
#define EN_MISC 1
#endif
#ifndef EN_ATT
#define EN_ATT 1
#endif
#ifndef EN_RES
#define EN_RES 1
#endif
#ifndef EN_GU
#define EN_GU 1
#endif
#ifndef MK_PROBE
#define MK_PROBE 0
#endif
#ifndef MK_MASK_A
#define MK_MASK_A 0u
#endif
#ifndef MK_MASK_B
#define MK_MASK_B 0u
#endif
#ifndef MK_SLEEP_US
#define MK_SLEEP_US 0
#endif
#ifndef MK_EXTRA_SYNC
#define MK_EXTRA_SYNC 0
#endif
#ifndef MK_CG_ONLY
#define MK_CG_ONLY 0
#endif
#ifndef ATT_SDEPTH
#define ATT_SDEPTH 2
#endif
#ifndef ATT_SB
#define ATT_SB 0
#endif
#ifndef ATT_NEGM
#define ATT_NEGM 0
#endif
#ifndef GU_ALIGN
#define GU_ALIGN true
#endif
#ifndef GEMM_SP2
#define GEMM_SP2 true
#endif
#ifndef MK_PROBE2
#define MK_PROBE2 0
#endif
#ifndef MK_PA
#define MK_PA 0
#endif
#ifndef MK_PB
#define MK_PB 1
#endif
#ifndef MK_DREV
#define MK_DREV 1
#endif
#ifndef MK_ONE_LAUNCH
#define MK_ONE_LAUNCH 1
#endif

__device__ __forceinline__ int mk_tid() { int t = threadIdx.x; asm volatile("" : "+v"(t)); return t; }
namespace pg8 {
#define PG8_LAS __attribute__((address_space(3)))
typedef unsigned short bf16_t;
typedef short bf16x8 __attribute__((ext_vector_type(8)));
typedef float f32x4 __attribute__((ext_vector_type(4)));
typedef unsigned u32x4 __attribute__((ext_vector_type(4)));
constexpr int BM = 256, BK = 64, HALF = 128, HTB = HALF * BK * 2  , STAGE_BYTES = 8 * HTB, NXCD = 8, WGM = 8;

__host__ __device__ __forceinline__ int lds_byte(int r, int c) { const int st = (r >> 4) * 2 + (c >> 5), rr = r & 15, cc = c & 31, ob = rr * 64 + cc * 2; return st * 1024 + (ob ^ (((ob >> 9) & 1) << 5)); }
__host__ __device__ __forceinline__ void stage_rc(int b, int& R, int& C) { const int st = b / 1024, sb = b % 1024, swz = sb ^ (((sb >> 9) & 1) << 5); R = (st >> 1) * 16 + swz / 64; C = (st & 1) * 32 + (swz % 64) / 2; }
__host__ __device__ __forceinline__ int perm32(int rho) { const int n = rho >> 4, i = rho & 15; return 8 * (i >> 2) + 4 * n + (i & 3); }

struct Unit { int pm, pn; };
struct Gemm { const bf16_t* A; const bf16_t* Bt; int M, N, K; };

struct StaticOrder {
    int nM, nN, nwg, G, c, rev;
    __host__ __device__ void init(int M, int N, int G_, int c_) { nM = M / BM; nN = N / BM; nwg = nM * nN; G = G_; c = c_; rev = 0; }
    __host__ __device__ bool next(int i, Unit& u) const {
        const long L = (long)i * G + c; if (L >= nwg) return false;
        int wgid = (int)L; { const int q = nwg / NXCD, r = nwg % NXCD, xcd = wgid % NXCD, off = wgid / NXCD; wgid = (xcd < r ? xcd * (q + 1) : r * (q + 1) + (xcd - r) * q) + off; }
        const int nig = WGM * nN, gid = wgid / nig, fm = gid * WGM, gsz = (nM - fm) < WGM ? (nM - fm) : WGM;
        u.pm = fm + ((wgid % nig) % gsz); u.pn = (wgid % nig) / gsz; if (rev) u.pm = nM - 1 - u.pm; return true;
    }
    __device__ __forceinline__ void a_ready(const Unit&) const {}
    __device__ __forceinline__ void done(const Unit&) const {}
};

__device__ __forceinline__ unsigned cvt_pk_bf16(float lo, float hi) { unsigned r; asm volatile("v_cvt_pk_bf16_f32 %0, %1, %2" : "=v"(r) : "v"(lo), "v"(hi)); return r; }
typedef float f32x2 __attribute__((ext_vector_type(2)));
typedef float f32x2 __attribute__((ext_vector_type(2)));

__device__ __forceinline__ float bflo(unsigned w) { return __uint_as_float(w << 16); }
__device__ __forceinline__ float bfhi(unsigned w) { return __uint_as_float(w & 0xffff0000u); }
__device__ __forceinline__ float rstd_of(const float* rssp, size_t row) { const f32x4 p = *(const f32x4*)(rssp + row * 4); return __builtin_amdgcn_rsqf(((p[0] + p[1]) + (p[2] + p[3])) * (1.0f / 1024.0f) + 1e-6f); }
struct EpiResB {
    static constexpr bool PERM = true, AFTER_DRAIN = false;
    const bf16_t* xin; bf16_t* xout; float* fout; float* rssp; PG8_LAS float* P;
    __device__ __forceinline__ void operator()(const f32x4 (&acc)[2][2][4][2], const Unit& u, int wr, int wc, int fr, int fq) const {
        const int row0 = u.pm * BM + wr * 64 + fr, col0 = u.pn * BM + wc * 32 + 8 * fq;
#pragma unroll
        for (int ai = 0; ai < 2; ++ai) {
            u32x4 xo[4][2];
#pragma unroll
            for (int m = 0; m < 4; ++m)
#pragma unroll
                for (int bj = 0; bj < 2; ++bj) xo[m][bj] = *(const u32x4*)(xin + (size_t)(row0 + ai * HALF + m * 16) * 1024 + col0 + bj * HALF);
#pragma unroll
            for (int m = 0; m < 4; ++m) {
                const size_t roff = (size_t)(row0 + ai * HALF + m * 16) * 1024 + col0; float ss = 0.f;
#pragma unroll
                for (int bj = 0; bj < 2; ++bj) {
                    const u32x4 w = xo[m][bj]; const f32x4 a0 = acc[ai][bj][m][0], a1 = acc[ai][bj][m][1]; f32x4 v0, v1;
                    v0[0] = bflo(w.x) + a0[0]; v0[1] = bfhi(w.x) + a0[1]; v0[2] = bflo(w.y) + a0[2]; v0[3] = bfhi(w.y) + a0[3];
                    v1[0] = bflo(w.z) + a1[0]; v1[1] = bfhi(w.z) + a1[1]; v1[2] = bflo(w.w) + a1[2]; v1[3] = bfhi(w.w) + a1[3];
                    ss += (v0[0] * v0[0] + v0[1] * v0[1]) + (v0[2] * v0[2] + v0[3] * v0[3]) + (v1[0] * v1[0] + v1[1] * v1[1]) + (v1[2] * v1[2] + v1[3] * v1[3]);
                    if (fout) { *(f32x4*)(fout + roff + bj * HALF) = v0; *(f32x4*)(fout + roff + bj * HALF + 4) = v1; }
                    else { u32x4 o; o.x = cvt_pk_bf16(v0[0], v0[1]); o.y = cvt_pk_bf16(v0[2], v0[3]); o.z = cvt_pk_bf16(v1[0], v1[1]); o.w = cvt_pk_bf16(v1[2], v1[3]); *(u32x4*)(xout + roff + bj * HALF) = o; }
                }
                if (rssp) { ss += __shfl_xor(ss, 16); ss += __shfl_xor(ss, 32); if (fq == 0) P[(ai * HALF + wr * 64 + m * 16 + fr) * 4 + wc] = ss; }
            }
        }
        if (rssp) {
            asm volatile("s_waitcnt lgkmcnt(0)" ::: "memory"); __builtin_amdgcn_s_barrier(); asm volatile("" ::: "memory");
            const int t = (wr * 4 + wc) * 64 + fq * 16 + fr;
            if (t < 256) { const f32x4 p = *((const PG8_LAS f32x4*)P + t); rssp[(size_t)(u.pm * BM + t) * 4 + u.pn] = (p[0] + p[1]) + (p[2] + p[3]); }
        }
    }
};
__device__ __forceinline__ float silu_mul(float g, float u) { return g * u * __builtin_amdgcn_rcpf(1.0f + __builtin_amdgcn_exp2f(-1.4426950408889634f * g)); }
struct EpiSwiGLU {
    static constexpr bool PERM = true, AFTER_DRAIN = false;
    bf16_t* H; int ldh; const float* rssp;
    __device__ __forceinline__ void operator()(const f32x4 (&acc)[2][2][4][2], const Unit& u, int wr, int wc, int fr, int fq) const {
        const int row0 = u.pm * BM + wr * 64 + fr, col0 = u.pn * HALF + wc * 32 + 8 * fq;
        f32x4 pp[2][4];
#pragma unroll
        for (int ai = 0; ai < 2; ++ai)
#pragma unroll
            for (int m = 0; m < 4; ++m) pp[ai][m] = *(const f32x4*)(rssp + (size_t)(row0 + ai * HALF + m * 16) * 4);
#pragma unroll
        for (int ai = 0; ai < 2; ++ai)
#pragma unroll
            for (int m = 0; m < 4; ++m) { const int row = row0 + ai * HALF + m * 16; bf16_t* rowp = H + (size_t)row * ldh + col0; const f32x4 p = pp[ai][m]; const float rs = __builtin_amdgcn_rsqf(((p[0] + p[1]) + (p[2] + p[3])) * (1.0f / 1024.0f) + 1e-6f);
                const f32x4 g0 = acc[ai][0][m][0] * rs, g1 = acc[ai][0][m][1] * rs, u0 = acc[ai][1][m][0] * rs, u1 = acc[ai][1][m][1] * rs;
                u32x4 w;
                w.x = cvt_pk_bf16(silu_mul(g0[0], u0[0]), silu_mul(g0[1], u0[1])); w.y = cvt_pk_bf16(silu_mul(g0[2], u0[2]), silu_mul(g0[3], u0[3]));
                w.z = cvt_pk_bf16(silu_mul(g1[0], u1[0]), silu_mul(g1[1], u1[1])); w.w = cvt_pk_bf16(silu_mul(g1[2], u1[2]), silu_mul(g1[3], u1[3]));
                *(u32x4*)rowp = w; }
    }
};
struct EpiQKV {
    static constexpr bool PERM = true, AFTER_DRAIN = false;
    bf16_t *Q, *K, *V; const float* rssp;
    const float* qkg;
    const float* rope;
    PG8_LAS float* P2;
    float qscale;
    __device__ __forceinline__ void operator()(const f32x4 (&acc)[2][2][4][2], const Unit& u, int wr, int wc, int fr, int fq) const {
        const int row0 = u.pm * BM + wr * 64 + fr;
        bf16_t* base = u.pn < 4 ? Q + u.pn * BM : (u.pn == 4 ? K : V); const int ldc = u.pn < 4 ? 1024 : 256;
        const int col0 = wc * 32 + 8 * fq;
        f32x4 pp[2][4]; float rs[2][4];
#pragma unroll
        for (int ai = 0; ai < 2; ++ai)
#pragma unroll
            for (int m = 0; m < 4; ++m) pp[ai][m] = *(const f32x4*)(rssp + (size_t)(row0 + ai * HALF + m * 16) * 4);
#pragma unroll
        for (int ai = 0; ai < 2; ++ai)
#pragma unroll
            for (int m = 0; m < 4; ++m) { const f32x4 p = pp[ai][m]; rs[ai][m] = __builtin_amdgcn_rsqf(((p[0] + p[1]) + (p[2] + p[3])) * (1.0f / 1024.0f) + 1e-6f); }
        if (u.pn == 5) {
#pragma unroll
            for (int ai = 0; ai < 2; ++ai)
#pragma unroll
                for (int m = 0; m < 4; ++m) { bf16_t* rowp = base + (size_t)(row0 + ai * HALF + m * 16) * ldc + col0;
#pragma unroll
                    for (int bj = 0; bj < 2; ++bj) { const f32x4 v0 = acc[ai][bj][m][0] * rs[ai][m], v1 = acc[ai][bj][m][1] * rs[ai][m]; u32x4 w;
                        w.x = cvt_pk_bf16(v0[0], v0[1]); w.y = cvt_pk_bf16(v0[2], v0[3]); w.z = cvt_pk_bf16(v1[0], v1[1]); w.w = cvt_pk_bf16(v1[2], v1[3]);
                        *(u32x4*)(rowp + bj * HALF) = w; } }
            return;
        }
#pragma unroll
        for (int ai = 0; ai < 2; ++ai)
#pragma unroll
            for (int m = 0; m < 4; ++m)
#pragma unroll
                for (int bj = 0; bj < 2; ++bj) { const f32x4 v0 = acc[ai][bj][m][0] * rs[ai][m], v1 = acc[ai][bj][m][1] * rs[ai][m];
                    float ss = (v0[0] * v0[0] + v0[1] * v0[1]) + (v0[2] * v0[2] + v0[3] * v0[3]) + (v1[0] * v1[0] + v1[1] * v1[1]) + (v1[2] * v1[2] + v1[3] * v1[3]);
                    ss += __shfl_xor(ss, 16); ss += __shfl_xor(ss, 32);
                    if (fq == 0) P2[((ai * HALF + wr * 64 + m * 16 + fr) * 2 + bj) * 4 + wc] = ss; }
        asm volatile("s_waitcnt lgkmcnt(0)" ::: "memory"); __builtin_amdgcn_s_barrier(); asm volatile("" ::: "memory");
        const float* gp = qkg + (u.pn == 4 ? 128 : 0) + col0; const float hs = u.pn == 4 ? 1.0f : qscale;
        const f32x4 g0 = *(const f32x4*)gp * hs, g1 = *(const f32x4*)(gp + 4) * hs;
        const int ib = 16 * (wc & 1) + 4 * fq;
#pragma unroll
        for (int ai = 0; ai < 2; ++ai)
#pragma unroll
            for (int m = 0; m < 4; ++m) { const int row = row0 + ai * HALF + m * 16; bf16_t* rowp = base + (size_t)row * ldc + col0;
                const int t = row < 16384 ? (row & 8191) : ((row - 16384) & 4095); const int pos = wc < 2 ? (t >> 6) : (t & 63);
                const f32x4 cs0 = *(const f32x4*)(rope + (size_t)(pos * 32 + ib) * 2), cs1 = *(const f32x4*)(rope + (size_t)(pos * 32 + ib + 2) * 2);
#pragma unroll
                for (int bj = 0; bj < 2; ++bj) { const f32x4 pr = *((const PG8_LAS f32x4*)P2 + ((ai * HALF + wr * 64 + m * 16 + fr) * 2 + bj));
                    const float rk = rs[ai][m] * __builtin_amdgcn_rsqf(((pr[0] + pr[1]) + (pr[2] + pr[3])) * (1.0f / 128.0f) + 1e-6f);
                    const f32x4 y0 = acc[ai][bj][m][0] * rk * g0, y1 = acc[ai][bj][m][1] * rk * g1; u32x4 w;
                    w.x = cvt_pk_bf16(y0[0] * cs0[0] - y0[1] * cs0[1], y0[0] * cs0[1] + y0[1] * cs0[0]); w.y = cvt_pk_bf16(y0[2] * cs0[2] - y0[3] * cs0[3], y0[2] * cs0[3] + y0[3] * cs0[2]);
                    w.z = cvt_pk_bf16(y1[0] * cs1[0] - y1[1] * cs1[1], y1[0] * cs1[1] + y1[1] * cs1[0]); w.w = cvt_pk_bf16(y1[2] * cs1[2] - y1[3] * cs1[3], y1[2] * cs1[3] + y1[3] * cs1[2]);
                    *(u32x4*)(rowp + bj * HALF) = w; } }
    }
};
template <class Epi, class Sched, bool ALIGN_EPI = false, bool SP2 = false>
__device__ __forceinline__ void gemm_phase(PG8_LAS unsigned char* lds, const Gemm g, const Sched& S, const Epi& E) {
    const int tid = mk_tid(), wid = __builtin_amdgcn_readfirstlane(tid >> 6), lane = tid & 63, wr = wid >> 2, wc = wid & 3, fr = lane & 15, fq = lane >> 4;
    const int K = g.K, nt = K / BK;
    unsigned voffA[2], voffB[2];
#pragma unroll
    for (int i = 0; i < 2; ++i) { int R, C; stage_rc(tid * 16 + i * 8192, R, C); const int Rb = Epi::PERM ? ((R & ~31) + perm32(R & 31)) : R;
        voffA[i] = (unsigned)(R * K + C) * 2u; voffB[i] = (unsigned)(Rb * K + C) * 2u; }
    const size_t kstep = (size_t)(BK * 2);
    const size_t hstep = (size_t)HALF * K * 2;
    const size_t tstep = 2 * hstep;
    const unsigned ldsw = (unsigned)wid * 1024u;
    const int aoff = lds_byte(wr * 64 + fr, fq * 8), boff = lds_byte(wc * 32 + fr, fq * 8);
#define PG8_SA(b, h) (((b) * 2 + (h)) * HTB)
#define PG8_SB(b, h) ((4 + (b) * 2 + (h)) * HTB)
#define PG8_STAGE(bufoff, gbase, voff) do { _Pragma("unroll") for (int _i = 0; _i < 2; ++_i) \
        __builtin_amdgcn_global_load_lds((const unsigned*)((const char*)(gbase) + (voff)[_i]), (PG8_LAS unsigned*)(lds + (bufoff) + ldsw + _i * 8192), 16, 0, 0); } while (0)
#define PG8_LDA(dst, b, h) do { _Pragma("unroll") for (int m = 0; m < 4; ++m) _Pragma("unroll") for (int k = 0; k < 2; ++k) dst[m][k] = *(const PG8_LAS bf16x8*)(lds + PG8_SA(b, h) + aoff + m * 2048 + k * 1024); } while (0)
#define PG8_LDB(dst, b, h) do { _Pragma("unroll") for (int n = 0; n < 2; ++n) _Pragma("unroll") for (int k = 0; k < 2; ++k) dst[n][k] = *(const PG8_LAS bf16x8*)(lds + PG8_SB(b, h) + boff + n * 2048 + k * 1024); } while (0)
#define PG8_MMA(ai, bj, At, Bt) do { __builtin_amdgcn_s_setprio(1); _Pragma("unroll") for (int m = 0; m < 4; ++m) _Pragma("unroll") for (int n = 0; n < 2; ++n) _Pragma("unroll") for (int k = 0; k < 2; ++k) \
        acc[ai][bj][m][n] = __builtin_amdgcn_mfma_f32_16x16x32_bf16(Bt[n][k], At[m][k], acc[ai][bj][m][n], 0, 0, 0); __builtin_amdgcn_s_setprio(0); } while (0)
#define PG8_WAIT_V(n) asm volatile("s_waitcnt vmcnt(" #n ")" ::: "memory")
#define PG8_WAIT_L(n) asm volatile("s_waitcnt lgkmcnt(" #n ")" ::: "memory")
#define PG8_BAR __builtin_amdgcn_s_barrier()
#define PG8_SCHED __builtin_amdgcn_sched_barrier(0)
    Unit cur, nxt; int ui = 0;
    if (!S.next(0, cur)) return;
    f32x4 acc[2][2][4][2];
#pragma unroll
    for (int a = 0; a < 2; ++a)
#pragma unroll
        for (int b = 0; b < 2; ++b)
#pragma unroll
            for (int m = 0; m < 4; ++m)
#pragma unroll
                for (int n = 0; n < 2; ++n) acc[a][b][m][n] = (f32x4){0.f, 0.f, 0.f, 0.f};
    bf16x8 At[4][2], B0[2][2], B1[2][2];
    const char* cA = (const char*)g.A + (size_t)cur.pm * tstep; const char* cB = (const char*)g.Bt + (size_t)cur.pn * tstep;
    S.a_ready(cur);
    if constexpr (SP2) {
        PG8_STAGE(PG8_SB(0, 0), cB, voffB); PG8_STAGE(PG8_SB(0, 1), cB + hstep, voffB); PG8_STAGE(PG8_SA(0, 0), cA, voffA); PG8_STAGE(PG8_SA(0, 1), cA + hstep, voffA);
        if (wr == 1) PG8_BAR;
        PG8_WAIT_V(2); PG8_BAR;
        PG8_STAGE(PG8_SB(1, 0), cB + kstep, voffB); PG8_STAGE(PG8_SA(1, 0), cA + kstep, voffA); PG8_STAGE(PG8_SB(1, 1), cB + hstep + kstep, voffB);
        PG8_WAIT_V(6); PG8_BAR;
    } else {
        PG8_STAGE(PG8_SB(0, 0), cB, voffB); PG8_STAGE(PG8_SA(0, 0), cA, voffA); PG8_STAGE(PG8_SB(0, 1), cB + hstep, voffB); PG8_STAGE(PG8_SA(0, 1), cA + hstep, voffA);
        if (wr == 1) PG8_BAR;
        PG8_WAIT_V(4); PG8_BAR;
        PG8_STAGE(PG8_SB(1, 0), cB + kstep, voffB); PG8_STAGE(PG8_SA(1, 0), cA + kstep, voffA); PG8_STAGE(PG8_SB(1, 1), cB + hstep + kstep, voffB);
        PG8_WAIT_V(6); PG8_BAR;
    }
    for (;;) {
        const bool has_next = S.next(ui + 1, nxt);
        const char* nA = has_next ? (const char*)g.A + (size_t)nxt.pm * tstep : cA; const char* nB = has_next ? (const char*)g.Bt + (size_t)nxt.pn * tstep : cB;
        for (int t = 0; t < nt; t += 2) {
            const bool last = (t == nt - 2);
            const char* a1 = cA + (size_t)(t + 1) * kstep;
            const char* a2 = last ? nA : cA + (size_t)(t + 2) * kstep; const char* b2 = last ? nB : cB + (size_t)(t + 2) * kstep;
            const char* a3 = a2 + kstep; const char* b3 = b2 + kstep;
            if (last && has_next) S.a_ready(nxt);
            if constexpr (SP2) {
            PG8_LDB(B0, 0, 0); PG8_LDB(B1, 0, 1); PG8_SCHED; PG8_LDA(At, 0, 0); PG8_STAGE(PG8_SA(1, 1), a1 + hstep, voffA);
            PG8_WAIT_V(8); PG8_WAIT_L(0); PG8_BAR; PG8_MMA(0, 0, At, B0); PG8_MMA(0, 1, At, B1); PG8_BAR; PG8_SCHED;
            PG8_LDA(At, 0, 1); PG8_STAGE(PG8_SB(0, 0), b2, voffB); PG8_STAGE(PG8_SB(0, 1), b2 + hstep, voffB); PG8_STAGE(PG8_SA(0, 0), a2, voffA);
            PG8_WAIT_V(8); PG8_WAIT_L(0); PG8_BAR; PG8_MMA(1, 0, At, B0); PG8_MMA(1, 1, At, B1); PG8_BAR; PG8_SCHED;
            PG8_LDB(B0, 1, 0); PG8_LDB(B1, 1, 1); PG8_SCHED; PG8_LDA(At, 1, 0); PG8_STAGE(PG8_SA(0, 1), a2 + hstep, voffA);
            PG8_WAIT_V(8); PG8_WAIT_L(0); PG8_BAR; PG8_MMA(0, 0, At, B0); PG8_MMA(0, 1, At, B1); PG8_BAR; PG8_SCHED;
            PG8_LDA(At, 1, 1); PG8_STAGE(PG8_SB(1, 0), b3, voffB); PG8_STAGE(PG8_SB(1, 1), b3 + hstep, voffB); PG8_STAGE(PG8_SA(1, 0), a3, voffA);
            PG8_WAIT_V(8); PG8_WAIT_L(0); PG8_BAR; PG8_MMA(1, 0, At, B0); PG8_MMA(1, 1, At, B1); PG8_BAR; PG8_SCHED;
            } else {
            PG8_LDB(B0, 0, 0); PG8_SCHED; PG8_LDA(At, 0, 0); PG8_STAGE(PG8_SA(1, 1), a1 + hstep, voffA);
            PG8_WAIT_L(8); PG8_BAR; PG8_WAIT_L(0); PG8_MMA(0, 0, At, B0); PG8_BAR; PG8_SCHED;
            PG8_LDB(B1, 0, 1); PG8_STAGE(PG8_SB(0, 0), b2, voffB);
            PG8_BAR; PG8_WAIT_L(0); PG8_MMA(0, 1, At, B1); PG8_BAR;
            PG8_LDA(At, 0, 1); PG8_STAGE(PG8_SA(0, 0), a2, voffA);
            PG8_BAR; PG8_WAIT_L(0); PG8_MMA(1, 0, At, B0); PG8_BAR; PG8_SCHED;
            PG8_STAGE(PG8_SB(0, 1), b2 + hstep, voffB);
            PG8_WAIT_V(6); PG8_BAR; PG8_MMA(1, 1, At, B1); PG8_BAR;
            PG8_LDB(B0, 1, 0); PG8_SCHED; PG8_LDA(At, 1, 0); PG8_STAGE(PG8_SA(0, 1), a2 + hstep, voffA);
            PG8_WAIT_L(8); PG8_BAR; PG8_WAIT_L(0); PG8_MMA(0, 0, At, B0); PG8_BAR; PG8_SCHED;
            PG8_LDB(B1, 1, 1); PG8_STAGE(PG8_SB(1, 0), b3, voffB);
            PG8_BAR; PG8_WAIT_L(0); PG8_MMA(0, 1, At, B1); PG8_BAR;
            PG8_LDA(At, 1, 1); PG8_STAGE(PG8_SA(1, 0), a3, voffA);
            PG8_BAR; PG8_WAIT_L(0); PG8_MMA(1, 0, At, B0); PG8_BAR; PG8_SCHED;
            PG8_STAGE(PG8_SB(1, 1), b3 + hstep, voffB);
            PG8_WAIT_V(6); PG8_BAR; PG8_MMA(1, 1, At, B1); PG8_BAR;
            }
        }
        if constexpr (ALIGN_EPI) { if (wr == 0) PG8_BAR; }
        if constexpr (!Epi::AFTER_DRAIN) { E(acc, cur, wr, wc, fr, fq); S.done(cur); }
        if (!has_next) break;
#pragma unroll
        for (int a = 0; a < 2; ++a)
#pragma unroll
            for (int b = 0; b < 2; ++b)
#pragma unroll
                for (int m = 0; m < 4; ++m)
#pragma unroll
                    for (int n = 0; n < 2; ++n) acc[a][b][m][n] = (f32x4){0.f, 0.f, 0.f, 0.f};
        cur = nxt; cA = nA; cB = nB; ++ui;
        if constexpr (ALIGN_EPI) { if (wr == 1) PG8_BAR; }
    }
    PG8_WAIT_V(0);
    if constexpr (!ALIGN_EPI) { if (wr == 0) PG8_BAR; }
    PG8_BAR;
    if constexpr (Epi::AFTER_DRAIN) { E.fused(acc, cur, wr, wc, fr, fq, lds, wid, lane); S.done(cur); }
#undef PG8_SA
#undef PG8_SB
#undef PG8_STAGE
#undef PG8_LDA
#undef PG8_LDB
#undef PG8_MMA
#undef PG8_WAIT_V
#undef PG8_WAIT_L
#undef PG8_BAR
#undef PG8_SCHED
}
}

namespace att {
using bf16 = __hip_bfloat16;
constexpr int   D = 128, NW = 8, QBLK = 32, KVBLK = 64;
constexpr float SCALE = 0.088388347648318440f;
constexpr float THR = 8.f;
constexpr int SDEPTH = ATT_SDEPTH;
constexpr int LDQ = 1024, LDK = 256, LDO = 1024;
constexpr size_t SHM_V = KVBLK * D * 2, SHM_K = KVBLK * D * 2, SHM_ATTN = 2 * SHM_V + 2 * SHM_K + NW * 64 * 4;
constexpr size_t OST_OFF = 69632;
using bf16x8 = __attribute__((ext_vector_type(8))) short;
using s16x4  = __attribute__((ext_vector_type(4))) short;
using f32x16 = __attribute__((ext_vector_type(16))) float;
using f32x8  = __attribute__((ext_vector_type(8))) float;
using u32x4  = __attribute__((ext_vector_type(4))) unsigned;
#define KSWZ(row, colB) ((row) * 256 + ((colB) ^ (((row) & 7) << 4)))
#define SBAR() __builtin_amdgcn_sched_barrier(0)
__device__ __forceinline__ int crow(int r, int hi) { return (r & 3) + 8 * (r >> 2) + 4 * hi; }
__device__ __forceinline__ unsigned cvtpk(float lo, float hi) {
  unsigned r; asm volatile("v_cvt_pk_bf16_f32 %0, %1, %2" : "=v"(r) : "v"(lo), "v"(hi)); return r;
}
template <typename TIn> struct Stage;
template <> struct Stage<bf16>  { using T = bf16x8;
  __device__ static __forceinline__ T ld8(const bf16* p) { return *reinterpret_cast<const bf16x8*>(p); }
  __device__ static __forceinline__ bf16x8 tobf(T x) { return x; } };
template <> struct Stage<float> { using T = f32x8;
  __device__ static __forceinline__ T ld8(const float* p) { return *reinterpret_cast<const f32x8*>(p); }
  __device__ static __forceinline__ bf16x8 tobf(T x) {
    u32x4 w = {cvtpk(x[0], x[1]), cvtpk(x[2], x[3]), cvtpk(x[4], x[5]), cvtpk(x[6], x[7])}; return *reinterpret_cast<bf16x8*>(&w); } };

__device__ __forceinline__ void partialSM(f32x16& p0, f32x16& p1, float& m_reg, float& mn, float& alpha) {
  constexpr float C = SCALE * 1.4426950408889634f;
  float pmax = p0[0]; for (int r = 1; r < 16; ++r) pmax = fmaxf(pmax, p0[r]); for (int r = 0; r < 16; ++r) pmax = fmaxf(pmax, p1[r]);
  { auto rr = __builtin_amdgcn_permlane32_swap(__float_as_uint(pmax), __float_as_uint(pmax), false, false);
    pmax = fmaxf(__uint_as_float(rr[0]), __uint_as_float(rr[1])); }
  if (__builtin_expect(__all(pmax - m_reg <= THR / SCALE), 1)) { mn = m_reg; alpha = 1.f; }
  else { mn = fmaxf(m_reg, pmax); alpha = __builtin_amdgcn_exp2f((m_reg - mn) * C); m_reg = mn; }
  float mnC = -mn * C;
  for (int r = 0; r < 16; ++r) p0[r] = fmaf(p0[r], C, mnC); for (int r = 0; r < 16; ++r) p1[r] = fmaf(p1[r], C, mnC);
  for (int r = 0; r < 16; ++r) p0[r] = __builtin_amdgcn_exp2f(p0[r]);
}
__device__ __forceinline__ void finishSM(f32x16& p0, f32x16& p1, float alpha, float& l_reg, bf16x8& pa0, bf16x8& pa1, bf16x8& pa2, bf16x8& pa3) {
  for (int r = 0; r < 16; ++r) p1[r] = __builtin_amdgcn_exp2f(p1[r]);
  float ps = 0; for (int r = 0; r < 16; ++r) ps += p0[r]; for (int r = 0; r < 16; ++r) ps += p1[r];
  { auto rr = __builtin_amdgcn_permlane32_swap(__float_as_uint(ps), __float_as_uint(ps), false, false);
    ps = __uint_as_float(rr[0]) + __uint_as_float(rr[1]); }
  l_reg = l_reg * alpha + ps;
#define PK4(P, BASE, OUT) do { unsigned a0 = cvtpk(P[BASE + 0], P[BASE + 1]), a1 = cvtpk(P[BASE + 2], P[BASE + 3]);   \
    unsigned b0 = cvtpk(P[BASE + 4], P[BASE + 5]), b1 = cvtpk(P[BASE + 6], P[BASE + 7]);                              \
    auto r0 = __builtin_amdgcn_permlane32_swap(a0, b0, false, false); auto r1 = __builtin_amdgcn_permlane32_swap(a1, b1, false, false); \
    u32x4 w = {r0[0], r1[0], r0[1], r1[1]}; OUT = *reinterpret_cast<bf16x8*>(&w); } while (0)
  PK4(p0, 0, pa0); PK4(p0, 8, pa1); PK4(p1, 0, pa2); PK4(p1, 8, pa3);
#undef PK4
}
__device__ __forceinline__ void qkt(f32x16& p0, f32x16& p1, const bf16* Ks, const bf16x8* qr, int r32, int hi) {
  p0 = f32x16{}; p1 = f32x16{};
  for (int d0 = 0; d0 < 8; ++d0) { int cb = (d0 * 16 + hi * 8) * 2;
    bf16x8 b0 = *reinterpret_cast<const bf16x8*>((const char*)Ks + KSWZ(r32, cb));
    bf16x8 b1 = *reinterpret_cast<const bf16x8*>((const char*)Ks + KSWZ(32 + r32, cb));
    p0 = __builtin_amdgcn_mfma_f32_32x32x16_bf16(b0, qr[d0], p0, 0, 0, 0);
    p1 = __builtin_amdgcn_mfma_f32_32x32x16_bf16(b1, qr[d0], p1, 0, 0, 0); }
}
__device__ __forceinline__ int v_st(int k, int c) { const int kk = (k & ~0xC) | ((k & 4) << 1) | ((k & 8) >> 1); return ((kk >> 3) * 4 + (c >> 5)) * 512 + ((kk & 7) * 32 + (c & 31)) * 2; }
__device__ __forceinline__ int v_rd_base(int lane) { return ((lane & 3) << 3) | (((lane >> 2) & 3) << 6) | (((lane >> 4) & 1) << 5) | (((lane >> 5) & 1) << 8); }
constexpr int v_rd_off(int d0, int ks, int half) { return d0 * 512 + ks * 4096 + half * 2048; }
template <int OFF> __device__ __forceinline__ s16x4 tr_read(int vb) {
  s16x4 r; asm volatile("ds_read_b64_tr_b16 %0, %1 offset:%2" : "=&v"(r) : "v"(vb), "i"(OFF) : "memory"); return r;
}
template <int D0> __device__ __forceinline__ void pv_one(f32x16& od, int vb, bf16x8 pa0, bf16x8 pa1, bf16x8 pa2, bf16x8 pa3) {
  const s16x4 l0 = tr_read<v_rd_off(D0, 0, 0)>(vb), h0 = tr_read<v_rd_off(D0, 0, 1)>(vb), l1 = tr_read<v_rd_off(D0, 1, 0)>(vb), h1 = tr_read<v_rd_off(D0, 1, 1)>(vb);
  const s16x4 l2 = tr_read<v_rd_off(D0, 2, 0)>(vb), h2 = tr_read<v_rd_off(D0, 2, 1)>(vb), l3 = tr_read<v_rd_off(D0, 3, 0)>(vb), h3 = tr_read<v_rd_off(D0, 3, 1)>(vb);
  asm volatile("s_waitcnt lgkmcnt(0)" ::: "memory"); SBAR();
#define PK(L, H) (bf16x8){L[0], L[1], L[2], L[3], H[0], H[1], H[2], H[3]}
  od = __builtin_amdgcn_mfma_f32_32x32x16_bf16(pa0, PK(l0, h0), od, 0, 0, 0);
  od = __builtin_amdgcn_mfma_f32_32x32x16_bf16(pa1, PK(l1, h1), od, 0, 0, 0);
  od = __builtin_amdgcn_mfma_f32_32x32x16_bf16(pa2, PK(l2, h2), od, 0, 0, 0);
  od = __builtin_amdgcn_mfma_f32_32x32x16_bf16(pa3, PK(l3, h3), od, 0, 0, 0);
#undef PK
}
__device__ __forceinline__ void pv_d0(f32x16* o, int vb, bf16x8 pa0, bf16x8 pa1, bf16x8 pa2, bf16x8 pa3) {
  pv_one<0>(o[0], vb, pa0, pa1, pa2, pa3); pv_one<1>(o[1], vb, pa0, pa1, pa2, pa3); pv_one<2>(o[2], vb, pa0, pa1, pa2, pa3); pv_one<3>(o[3], vb, pa0, pa1, pa2, pa3);
}

__device__ __forceinline__ float bf2f(short s) { return __uint_as_float(((unsigned)(unsigned short)s) << 16); }

__device__ __forceinline__ void qkt2(f32x16& p0, f32x16& p1, const bf16* Ks, const bf16x8* qr, const f32x16& negm, int r32, int hi) {
  p0 = negm; p1 = negm;
#pragma unroll
  for (int d0 = 0; d0 < 8; ++d0) { int cb = (d0 * 16 + hi * 8) * 2;
    bf16x8 b0 = *reinterpret_cast<const bf16x8*>((const char*)Ks + KSWZ(r32, cb));
    bf16x8 b1 = *reinterpret_cast<const bf16x8*>((const char*)Ks + KSWZ(32 + r32, cb));
    p0 = __builtin_amdgcn_mfma_f32_32x32x16_bf16(b0, qr[d0], p0, 0, 0, 0); p1 = __builtin_amdgcn_mfma_f32_32x32x16_bf16(b1, qr[d0], p1, 0, 0, 0); }
}
__device__ __forceinline__ void expA(f32x16& p0, float negmc) {
#pragma unroll
  for (int r = 0; r < 16; ++r) p0[r] = __builtin_amdgcn_exp2f(ATT_NEGM ? p0[r] : p0[r] + negmc);
}
__device__ __forceinline__ void finishSM2(f32x16& p0, f32x16& p1, float negmc, float& l_reg, bf16x8& pa0, bf16x8& pa1, bf16x8& pa2, bf16x8& pa3) {
#pragma unroll
  for (int r = 0; r < 16; ++r) p1[r] = __builtin_amdgcn_exp2f(ATT_NEGM ? p1[r] : p1[r] + negmc);
  float ps = 0;
#pragma unroll
  for (int r = 0; r < 16; ++r) ps += p0[r];
#pragma unroll
  for (int r = 0; r < 16; ++r) ps += p1[r];
  l_reg += ps;
#define PK4(P, BASE, OUT) do { unsigned a0 = cvtpk(P[BASE + 0], P[BASE + 1]), a1 = cvtpk(P[BASE + 2], P[BASE + 3]);   \
    unsigned b0 = cvtpk(P[BASE + 4], P[BASE + 5]), b1 = cvtpk(P[BASE + 6], P[BASE + 7]);                              \
    auto r0 = __builtin_amdgcn_permlane32_swap(a0, b0, false, false); auto r1 = __builtin_amdgcn_permlane32_swap(a1, b1, false, false); \
    u32x4 w = {r0[0], r1[0], r0[1], r1[1]}; OUT = *reinterpret_cast<bf16x8*>(&w); } while (0)
  PK4(p0, 0, pa0); PK4(p0, 8, pa1); PK4(p1, 0, pa2); PK4(p1, 8, pa3);
#undef PK4
}

__device__ __forceinline__ void attn_unit(const bf16* Qb, const bf16* __restrict__ Kh, const bf16* __restrict__ Vh,
                                          bf16* Ob, int seq, int t0, const float* __restrict__ qgain, const float2* __restrict__ rope, float negmc, char* lds) {
  using St = Stage<bf16>;
  const int tid = mk_tid(), wid = tid >> 6, lane = tid & 63, r32 = lane & 31, hi = lane >> 5;
  bf16* V_lds = (bf16*)lds; bf16* K_lds = (bf16*)(lds + 2 * SHM_V);
  float* ws = (float*)(lds + 2 * SHM_V + 2 * SHM_K) + wid * 64; float* li_l = ws;
  float l_reg = 0; f32x16 o[4] = {}; bf16x8 qr[8]; f32x16 negm; for (int r = 0; r < 16; ++r) negm[r] = ATT_NEGM ? negmc : 0.f; if (ATT_NEGM) asm volatile("" : "+v"(negm));
  const bf16* Qw = Qb + (long)(wid * QBLK + r32) * LDQ + hi * 8;
#pragma unroll
  for (int d0 = 0; d0 < 8; ++d0) qr[d0] = St::ld8(Qw + d0 * 16);
  (void)t0; (void)qgain; (void)rope;
  const int sr = tid >> 4, sc = (tid & 15) * 8, vst0 = v_st(sr, sc), vst1 = v_st(32 + sr, sc);
  const int vb0 = (int)(uintptr_t)V_lds + v_rd_base(lane);
  struct { typename St::T vs0, vs1, ks0, ks1; } sr_[SDEPTH];
#define SLOAD(i, k0) do { sr_[i].vs0 = St::ld8(&Vh[(long)((k0) + sr) * LDK + sc]); sr_[i].vs1 = St::ld8(&Vh[(long)((k0) + 32 + sr) * LDK + sc]); \
    sr_[i].ks0 = St::ld8(&Kh[(long)((k0) + sr) * LDK + sc]); sr_[i].ks1 = St::ld8(&Kh[(long)((k0) + 32 + sr) * LDK + sc]); } while (0)
#define SWRITE(b, i) do { *(bf16x8*)((char*)V_lds + (b) * SHM_V + vst0) = St::tobf(sr_[i].vs0);          \
    *(bf16x8*)((char*)V_lds + (b) * SHM_V + vst1) = St::tobf(sr_[i].vs1); int kc = sc * 2;               \
    *(bf16x8*)((char*)K_lds + (b) * SHM_K + KSWZ(sr, kc)) = St::tobf(sr_[i].ks0);                       \
    *(bf16x8*)((char*)K_lds + (b) * SHM_K + KSWZ(32 + sr, kc)) = St::tobf(sr_[i].ks1); } while (0)
#define SWAIT() do { if constexpr (SDEPTH == 2) asm volatile("s_waitcnt vmcnt(4)" ::: "memory"); else asm volatile("s_waitcnt vmcnt(0)" ::: "memory"); } while (0)
  f32x16 pA0, pA1, pB0, pB1; bf16x8 pa0, pa1, pa2, pa3; const int NT = seq / KVBLK;
  constexpr int SE = 0, SO = SDEPTH - 1;
  SLOAD(SE, 0); asm volatile("s_waitcnt vmcnt(0)" ::: "memory"); SWRITE(0, SE); __syncthreads();
  qkt2(pA0, pA1, K_lds, qr, negm, r32, hi); expA(pA0, negmc);
  SLOAD(SO, KVBLK); if constexpr (SDEPTH == 2) { if (2 < NT) SLOAD(SE, 2 * KVBLK); }
  SWAIT(); SWRITE(1, SO); __syncthreads();
  for (int j = 1; j + 1 < NT; j += 2) {
    SBAR(); qkt2(pB0, pB1, (bf16*)((char*)K_lds + SHM_K), qr, negm, r32, hi); if (ATT_SB) SBAR();
    finishSM2(pA0, pA1, negmc, l_reg, pa0, pa1, pa2, pa3); SBAR();
    SLOAD(SO, (j + SDEPTH) * KVBLK); SBAR();
    pv_d0(o, vb0, pa0, pa1, pa2, pa3); SBAR(); expA(pB0, negmc); SBAR();
    __syncthreads(); SWAIT(); SWRITE(0, SE);
    __syncthreads();
    SBAR(); qkt2(pA0, pA1, K_lds, qr, negm, r32, hi); if (ATT_SB) SBAR();
    finishSM2(pB0, pB1, negmc, l_reg, pa0, pa1, pa2, pa3); SBAR();
    if (SDEPTH == 1 || j + 3 < NT) SLOAD(SE, (j + 1 + SDEPTH) * KVBLK); SBAR();
    pv_d0(o, vb0 + (int)SHM_V, pa0, pa1, pa2, pa3); SBAR(); expA(pA0, negmc); SBAR();
    __syncthreads(); SWAIT(); SWRITE(1, SO);
    __syncthreads();
  }
  SBAR(); qkt2(pB0, pB1, (bf16*)((char*)K_lds + SHM_K), qr, negm, r32, hi);
  finishSM2(pA0, pA1, negmc, l_reg, pa0, pa1, pa2, pa3); SBAR();
  pv_d0(o, vb0, pa0, pa1, pa2, pa3); expA(pB0, negmc);
  __syncthreads();
  finishSM2(pB0, pB1, negmc, l_reg, pa0, pa1, pa2, pa3); SBAR();
  pv_d0(o, vb0 + (int)SHM_V, pa0, pa1, pa2, pa3);
  { auto rr = __builtin_amdgcn_permlane32_swap(__float_as_uint(l_reg), __float_as_uint(l_reg), false, false); l_reg = __uint_as_float(rr[0]) + __uint_as_float(rr[1]); }
  if (hi == 0) li_l[r32] = l_reg; asm volatile("s_waitcnt lgkmcnt(0)" ::: "memory");
  float rli[16];
#pragma unroll
  for (int r = 0; r < 16; ++r) rli[r] = __builtin_amdgcn_rcpf(li_l[crow(r, hi)]);
  { bf16* stg = (bf16*)(lds + OST_OFF) + wid * (32 * 128);
#pragma unroll
    for (int r = 0; r < 16; ++r) { const int orow = crow(r, hi);
#pragma unroll
      for (int d0 = 0; d0 < 4; ++d0) stg[orow * 128 + d0 * 32 + r32] = __float2bfloat16(o[d0][r] * rli[r]); }
    asm volatile("s_waitcnt lgkmcnt(0)" ::: "memory");
    bf16* Ow = Ob + (long)(wid * QBLK) * LDO;
#pragma unroll
    for (int i = 0; i < 8; ++i) { const int row = i * 4 + (lane >> 4), ch = lane & 15; const u32x4 v = *(const u32x4*)(stg + row * 128 + ch * 8); *(u32x4*)(Ow + (long)row * LDO + ch * 8) = v; }
    asm volatile("s_waitcnt lgkmcnt(0)" ::: "memory"); }
  __syncthreads();
#undef SLOAD
#undef SWRITE
#undef SWAIT
}
}

#define LAS __attribute__((address_space(3)))
typedef unsigned short bf16_t;
typedef unsigned v4u __attribute__((ext_vector_type(4)));
typedef float f32x4 __attribute__((ext_vector_type(4)));
typedef float f32x16 __attribute__((ext_vector_type(16)));
typedef short bf16x8 __attribute__((ext_vector_type(8)));
typedef short s16x4 __attribute__((ext_vector_type(4)));
#define LDS_WAIT() asm volatile("s_waitcnt lgkmcnt(0)" ::: "memory")

constexpr int NWAVES = 8, NTHREADS = 512;
constexpr int DM = 1024, DFF = 2816, NQKV = 1536;
constexpr int NTOK_P = 16384, NTOK_S = 32768, NTOK = 49152, SEQ_P = 8192, SEQ_S = 4096, NB_P = 2, NB_S = 8;
constexpr float EPS = 1e-6f;
constexpr size_t MiB = 1u << 20;
constexpr size_t WS_WGU = 1 * MiB, WS_WD = 45 * MiB, WS_WQKV = 67 * MiB, WS_WO = 73 * MiB, WS_W2 = 77 * MiB, WS_A1P = 85 * MiB, WS_A1S = 89 * MiB, WS_A2 = 90 * MiB, WS_ROPE = 90 * MiB + 65536, WS_QKG = 90 * MiB + 131072;
constexpr size_t WS_POOL = 92 * MiB, WS_RSS = 476 * MiB, WS_END = 482 * MiB, WS_TS = 90 * MiB + 196608;
constexpr size_t WS_F = WS_POOL, WS_T = WS_POOL + 192 * MiB, WS_HID = WS_POOL, WS_QO = WS_POOL, WS_K = WS_POOL + 96 * MiB, WS_V = WS_POOL + 120 * MiB, WS_XH = WS_POOL + 288 * MiB;
constexpr size_t RSS_STRIDE = (size_t)49152 * 4;
constexpr int LDS_BYTES = 147456;

__device__ __forceinline__ unsigned f2bf(float f) { unsigned u = __builtin_bit_cast(unsigned, f); return (u + 0x7fffu + ((u >> 16) & 1u)) >> 16; }
__device__ __forceinline__ unsigned pk2(float lo, float hi) { return f2bf(lo) | (f2bf(hi) << 16); }
__device__ __forceinline__ float wave_sum(float v) {
#pragma unroll
    for (int o = 1; o < 64; o <<= 1) v += __shfl_xor(v, o);
    return v;
}

template <class RowMap>
__device__ __forceinline__ void transpose_item(const float* __restrict__ W, int K, int N, bf16_t* WT, int ldk, const float* __restrict__ gain, RowMap rm, LAS float* scr, int item, int lane) {
    const int nblk = N / 64, kb = item / nblk, nb = item % nblk, k0 = 64 * kb, n0 = 64 * nb;
#pragma unroll
    for (int h = 0; h < 2; ++h) {
        float v[32];
#pragma unroll
        for (int i = 0; i < 32; ++i) v[i] = W[(size_t)(k0 + 32 * h + i) * N + n0 + lane];
#pragma unroll
        for (int i = 0; i < 32; ++i) { const int kk = 32 * h + i; float x = v[i]; if (gain) x *= gain[k0 + kk]; scr[kk * 64 + (lane ^ (kk & 0x38))] = x; }
    }
    LDS_WAIT(); asm volatile("" ::: "memory");
    const int c = lane & 7;
#pragma unroll
    for (int j = 0; j < 8; ++j) { const int n = (lane >> 3) + 8 * j; const LAS float* s = scr + (8 * c) * 64 + (n ^ (8 * c));
        v4u o; o.x = pk2(s[0 * 64], s[1 * 64]); o.y = pk2(s[2 * 64], s[3 * 64]); o.z = pk2(s[4 * 64], s[5 * 64]); o.w = pk2(s[6 * 64], s[7 * 64]);
        *(v4u*)(WT + (size_t)rm(n0 + n) * ldk + k0 + 8 * c) = o; }
    LDS_WAIT(); asm volatile("" ::: "memory");
}
struct RmId { __device__ __forceinline__ int operator()(int n) const { return n; } };
struct RmGU { int off; __device__ __forceinline__ int operator()(int n) const { return ((n >> 7) << 8) + (n & 127) + off; } };

__device__ __forceinline__ void cvt_row2(const float* xa, const float* xb, bf16_t* oa, bf16_t* ob, float* ra, float* rb, int lane) {
    const f32x4* pa = (const f32x4*)xa + lane; const f32x4* pb = (const f32x4*)xb + lane;
    f32x4 va[4], vb[4]; float sa = 0.f, sb = 0.f;
#pragma unroll
    for (int j = 0; j < 4; ++j) { va[j] = pa[64 * j]; vb[j] = pb[64 * j]; }
#pragma unroll
    for (int j = 0; j < 4; ++j) { sa += (va[j].x * va[j].x + va[j].y * va[j].y) + (va[j].z * va[j].z + va[j].w * va[j].w); sb += (vb[j].x * vb[j].x + vb[j].y * vb[j].y) + (vb[j].z * vb[j].z + vb[j].w * vb[j].w); }
    unsigned long long* qa = (unsigned long long*)oa + lane; unsigned long long* qb = (unsigned long long*)ob + lane;
#pragma unroll
    for (int j = 0; j < 4; ++j) { qa[64 * j] = (unsigned long long)pk2(va[j].x, va[j].y) | ((unsigned long long)pk2(va[j].z, va[j].w) << 32); qb[64 * j] = (unsigned long long)pk2(vb[j].x, vb[j].y) | ((unsigned long long)pk2(vb[j].z, vb[j].w) << 32); }
    sa = wave_sum(sa); sb = wave_sum(sb);
    if (lane == 0) { *(f32x4*)ra = (f32x4){sa, 0.f, 0.f, 0.f}; *(f32x4*)rb = (f32x4){sb, 0.f, 0.f, 0.f}; }
}

template <int OFF> __device__ __forceinline__ s16x4 tr_read_off(unsigned vb) {
    s16x4 r; asm volatile("ds_read_b64_tr_b16 %0, %1 offset:%2" : "=&v"(r) : "v"(vb), "i"(OFF) : "memory"); return r;
}
template <int KS, int NKS> struct BLoad {
    static __device__ __forceinline__ void run(bf16x8 (&b0)[NKS], bf16x8 (&b1)[NKS], unsigned base0, unsigned base1) {
        const s16x4 l0 = tr_read_off<(16 * KS) * 128>(base0), h0 = tr_read_off<(16 * KS + 4) * 128>(base0);
        const s16x4 l1 = tr_read_off<(16 * KS) * 128>(base1), h1 = tr_read_off<(16 * KS + 4) * 128>(base1);
        asm volatile("s_waitcnt lgkmcnt(0)" ::: "memory");
        b0[KS] = (bf16x8){l0[0], l0[1], l0[2], l0[3], h0[0], h0[1], h0[2], h0[3]};
        b1[KS] = (bf16x8){l1[0], l1[1], l1[2], l1[3], h1[0], h1[1], h1[2], h1[3]};
        if constexpr (KS + 1 < NKS) BLoad<KS + 1, NKS>::run(b0, b1, base0, base1);
    }
};
template <int KT, int MT, bool SC>
__device__ __forceinline__ void fft_unit(const bf16_t* __restrict__ A, const bf16_t* __restrict__ in, size_t in_stride, bf16_t* out, size_t so1, size_t so0, char* wl, int lane, const float* rs = nullptr, size_t rs_stride = 0) {
    constexpr int NKS = KT / 16;
    const int r32 = lane & 31, hi = lane >> 5;
    { const int lr = lane >> 3, ch = lane & 7;
      v4u dv[KT / 8]; f32x4 pq[SC ? KT / 8 : 1];
#pragma unroll
      for (int i = 0; i < KT / 8; ++i) dv[i] = *(const v4u*)(in + (size_t)(i * 8 + lr) * in_stride + ch * 8);
      if constexpr (SC) {
#pragma unroll
          for (int i = 0; i < KT / 8; ++i) pq[i] = *(const f32x4*)(rs + (size_t)(i * 8 + lr) * rs_stride * 4);
      }
#pragma unroll
      for (int i = 0; i < KT / 8; ++i) { const int row = i * 8 + lr; v4u v = dv[i];
          if constexpr (SC) { const float r = __builtin_amdgcn_rsqf(((pq[i][0] + pq[i][1]) + (pq[i][2] + pq[i][3])) * (1.0f / 1024.0f) + 1e-6f);
              v.x = pg8::cvt_pk_bf16(pg8::bflo(v.x) * r, pg8::bfhi(v.x) * r); v.y = pg8::cvt_pk_bf16(pg8::bflo(v.y) * r, pg8::bfhi(v.y) * r); v.z = pg8::cvt_pk_bf16(pg8::bflo(v.z) * r, pg8::bfhi(v.z) * r); v.w = pg8::cvt_pk_bf16(pg8::bflo(v.w) * r, pg8::bfhi(v.w) * r); }
          *(v4u*)(wl + row * 128 + 16 * (ch ^ (((row >> 1) & 1) << 2))) = v; } }
    LDS_WAIT(); asm volatile("" ::: "memory");
    bf16x8 b0[NKS], b1[NKS];
    { const int blk = (lane >> 4) & 1, q = (lane & 15) >> 2, p = lane & 3, qb = (q >> 1) & 1;
      const unsigned basel = (unsigned)(uintptr_t)wl + (unsigned)((8 * hi + q) * 128 + 16 * (2 * blk + (p >> 1)) + 8 * (p & 1));
      BLoad<0, NKS>::run(b0, b1, basel + 64u * (unsigned)qb, basel + 64u * (unsigned)(1 - qb)); }
    asm volatile("" ::: "memory");
    bf16_t* stg = (bf16_t*)wl;
    bf16x8 af[NKS], an[NKS];
#pragma unroll
    for (int ks = 0; ks < NKS; ++ks) an[ks] = *(const bf16x8*)(A + (size_t)r32 * KT + 16 * ks + 8 * hi);
#pragma unroll 1
    for (int mb = 0; mb < MT / 32; ++mb) {
#pragma unroll
        for (int ks = 0; ks < NKS; ++ks) af[ks] = an[ks];
        { const int mbn = mb + 1 < MT / 32 ? mb + 1 : mb;
#pragma unroll
          for (int ks = 0; ks < NKS; ++ks) an[ks] = *(const bf16x8*)(A + (size_t)(32 * mbn + r32) * KT + 16 * ks + 8 * hi); }
        f32x16 c0 = {}, c1 = {};
#pragma unroll
        for (int ks = 0; ks < NKS; ++ks) { c0 = __builtin_amdgcn_mfma_f32_32x32x16_bf16(af[ks], b0[ks], c0, 0, 0, 0); c1 = __builtin_amdgcn_mfma_f32_32x32x16_bf16(af[ks], b1[ks], c1, 0, 0, 0); }
#pragma unroll
        for (int r = 0; r < 16; ++r) { const int orow = (r & 3) + 8 * (r >> 2) + 4 * hi; stg[orow * 64 + r32] = (bf16_t)f2bf(c0[r]); stg[orow * 64 + 32 + r32] = (bf16_t)f2bf(c1[r]); }
        LDS_WAIT(); asm volatile("" ::: "memory");
#pragma unroll
        for (int i = 0; i < 4; ++i) { const int row = i * 8 + (lane >> 3), ch = lane & 7, m = 32 * mb + row; const v4u v = *(const v4u*)(stg + row * 64 + ch * 8);
            *(v4u*)(out + (size_t)(m >> 1) * so1 + (size_t)(m & 1) * so0 + ch * 8) = v; }
        LDS_WAIT(); asm volatile("" ::: "memory");
    }
}

typedef __attribute__((address_space(1))) unsigned gu32;
#define XB_TMO      128
#define XB_XCNT(j)  (256  + 64 * (j))
#define XB_XSUB(j)  (1280 + 64 * (j))
#define XB_XGEN(j)  (2304 + 64 * (j))
#define XB_TOP      3328
#define XB_TOPGEN   3392
#define XCD_BAR_WORDS 3456
#define XB_SPIN_CAP (1u << 22)

__device__ __forceinline__ unsigned xb_ld(unsigned* p)              { return __hip_atomic_load(p, __ATOMIC_RELAXED, __HIP_MEMORY_SCOPE_AGENT); }
__device__ __forceinline__ unsigned xb_add(unsigned* p, unsigned v) { return __hip_atomic_fetch_add(p, v, __ATOMIC_RELAXED, __HIP_MEMORY_SCOPE_AGENT); }
__device__ __forceinline__ unsigned xb_xcc_id() { return (unsigned)__builtin_amdgcn_s_getreg((3 << 11) | 20) & 0xFu; }
#define XB_SPIN(cond, bar) do { unsigned _sp = 0; while (cond) { __builtin_amdgcn_s_sleep(1); \
    if ((++_sp & 255u) == 0u) { if (xb_ld(&(bar)[XB_TMO])) break; if (_sp > XB_SPIN_CAP) { atomicAdd(&(bar)[XB_TMO], 1u); break; } } } } while (0)

struct XcdBarrier {
    unsigned* bar; unsigned x;
    volatile LAS unsigned* st;
};

__device__ __forceinline__ XcdBarrier xcd_barrier_post(unsigned* bar, volatile LAS unsigned* st) {
    XcdBarrier b; b.bar = bar; b.x = xb_xcc_id(); b.st = st;
    if (threadIdx.x == 0) (void)xb_add(&bar[XB_XCNT(b.x)], 1u);
    return b;
}
__device__ __forceinline__ void xcd_barrier_complete(unsigned* bar, unsigned x, unsigned& nloc, unsigned& nx) {
    const unsigned G = gridDim.x * gridDim.y * gridDim.z;
    unsigned sum, cnt, mine, sp = 0u;
    for (;;) {
        sum = 0u; cnt = 0u; mine = 0u;
#pragma unroll
        for (unsigned j = 0; j < 16; ++j) { const unsigned c = xb_ld(&bar[XB_XCNT(j)]); sum += c; cnt += (c > 0u) ? 1u : 0u; mine = (j == x) ? c : mine; }
        if (sum == G) break;
        __builtin_amdgcn_s_sleep(1);
        if ((++sp & 255u) == 0u) { if (xb_ld(&bar[XB_TMO])) break; if (sp > XB_SPIN_CAP) { atomicAdd(&bar[XB_TMO], 1u); break; } }
    }
    nloc = mine > 0u ? mine : 1u; nx = cnt > 0u ? cnt : 1u;
}

__device__ __forceinline__ void xcd_barrier(const XcdBarrier& b) {
    asm volatile("s_waitcnt vmcnt(0)" ::: "memory");
    __syncthreads();
    if (threadIdx.x == 0) {
        unsigned* bar = b.bar;
        __builtin_amdgcn_s_waitcnt(0);
        unsigned nloc = b.st[0], nx = b.st[1];
        if (nloc == 0u) { xcd_barrier_complete(bar, b.x, nloc, nx); b.st[0] = nloc; b.st[1] = nx; }
        const unsigned old = xb_add(&bar[XB_XSUB(b.x)], 1u);
        const unsigned gen = old / nloc;
        if (old + 1u == (gen + 1u) * nloc) {
            __builtin_amdgcn_fence(__ATOMIC_RELEASE, "agent");
            asm volatile("s_waitcnt vmcnt(0)" ::: "memory");
            const unsigned og = xb_add(&bar[XB_TOP], 1u);
            const unsigned tg = og / nx;
            if (og + 1u == (tg + 1u) * nx) xb_add(&bar[XB_TOPGEN], 1u);
            else XB_SPIN(xb_ld(&bar[XB_TOPGEN]) == tg, bar);
            __builtin_amdgcn_fence(__ATOMIC_ACQUIRE, "agent");
            xb_add(&bar[XB_XGEN(b.x)], 1u);
            asm volatile("s_waitcnt vmcnt(0)" ::: "memory");
        } else {
            XB_SPIN(xb_ld(&bar[XB_XGEN(b.x)]) == gen, bar);
            __builtin_amdgcn_fence(__ATOMIC_ACQUIRE, "agent");
            asm volatile("s_waitcnt vmcnt(0)" ::: "memory");
        }
    }
    __syncthreads();
}
constexpr int NPH_C = 21;
struct Args { const float* in[12]; float* out; unsigned char* ws; int ph_lo, ph_hi; };

__global__ void __launch_bounds__(NTHREADS, 2) mk_fwd(Args args) {
    extern __shared__ __attribute__((aligned(16))) unsigned char lds[];
    const int G = gridDim.x; const int bx = blockIdx.x; const int vcu = (G % 8 == 0) ? (bx % 8) * (G / 8) + bx / 8 : bx;
    const int NGW = G * NWAVES;
    unsigned char* ws = args.ws; float* X = args.out;
    bf16_t* Wgu = (bf16_t*)(ws + WS_WGU); bf16_t* Wd = (bf16_t*)(ws + WS_WD); bf16_t* Wqkv = (bf16_t*)(ws + WS_WQKV); bf16_t* Wo = (bf16_t*)(ws + WS_WO); bf16_t* W2 = (bf16_t*)(ws + WS_W2);
    bf16_t* A1P = (bf16_t*)(ws + WS_A1P); bf16_t* A1S = (bf16_t*)(ws + WS_A1S); bf16_t* A2 = (bf16_t*)(ws + WS_A2); float2* ROPE = (float2*)(ws + WS_ROPE); float* QKG = (float*)(ws + WS_QKG);
    bf16_t* XB0 = (bf16_t*)args.out; bf16_t* XBH = (bf16_t*)(ws + WS_XH); float* RSS = (float*)(ws + WS_RSS); bf16_t* FB = (bf16_t*)(ws + WS_F); bf16_t* TB = (bf16_t*)(ws + WS_T); bf16_t* HID = (bf16_t*)(ws + WS_HID);
    bf16_t* QO = (bf16_t*)(ws + WS_QO); bf16_t* KB = (bf16_t*)(ws + WS_K); bf16_t* VB = (bf16_t*)(ws + WS_V);
    LAS unsigned char* ldsl = (LAS unsigned char*)lds;
    const int lo = args.ph_lo, hi = args.ph_hi;
    int ph = 0;
    volatile LAS unsigned* MISC = (volatile LAS unsigned*)(ldsl + 131072 + 8192);
    if (threadIdx.x < 64) MISC[threadIdx.x] = 0u;
    __syncthreads();
    XcdBarrier xbar = xcd_barrier_post((unsigned*)(ws + 16384), MISC + 8);
    unsigned long long* TS = (unsigned long long*)(ws + WS_TS);
    if (MK_PROBE && bx == 0 && threadIdx.x == 0) TS[0] = __builtin_amdgcn_s_memrealtime();
#define PH_BEGIN if (ph >= lo && ph < hi) { const int tid = mk_tid(), lane = tid & 63, wave = __builtin_amdgcn_readfirstlane(tid >> 6), gw = vcu * NWAVES + wave; (void)lane; (void)gw;
#define PH_END } ++ph; if (ph > lo && ph < hi) { if (ph == 1 || MK_CG_ONLY) cg::this_grid().sync(); else xcd_barrier(xbar); } if (MK_PROBE && bx == 0 && threadIdx.x == 0) TS[ph] = __builtin_amdgcn_s_memrealtime();

    PH_BEGIN
    if (EN_P0) {
        LAS float* scr = (LAS float*)(ldsl + wave * 16384);
        if (MK_PROBE2 && bx == 0 && threadIdx.x == 0) TS[40] = __builtin_amdgcn_s_memrealtime();
        constexpr int I_G = 16 * 44, I_D = 44 * 16, I_QKV = 16 * 24, I_O = 16 * 16;
        constexpr int NITEMS = 4 * (2 * I_G + I_D) + 2 * (I_QKV + I_O);
        for (int it = gw; it < NITEMS; it += NGW) {
            int r = it;
            if (r < 4 * I_G) { const int l = r / I_G; transpose_item(args.in[9] + (size_t)l * DM * DFF, DM, DFF, Wgu + (size_t)l * 2 * DFF * DM, DM, args.in[3] + l * DM, RmGU{0}, scr, r % I_G, lane); continue; } r -= 4 * I_G;
            if (r < 4 * I_G) { const int l = r / I_G; transpose_item(args.in[10] + (size_t)l * DM * DFF, DM, DFF, Wgu + (size_t)l * 2 * DFF * DM, DM, args.in[3] + l * DM, RmGU{128}, scr, r % I_G, lane); continue; } r -= 4 * I_G;
            if (r < 4 * I_D) { const int l = r / I_D; transpose_item(args.in[11] + (size_t)l * DFF * DM, DFF, DM, Wd + (size_t)l * DM * DFF, DFF, (const float*)nullptr, RmId{}, scr, r % I_D, lane); continue; } r -= 4 * I_D;
            if (r < 2 * I_QKV) { const int j = r / I_QKV; transpose_item(args.in[5] + (size_t)j * DM * NQKV, DM, NQKV, Wqkv + (size_t)j * NQKV * DM, DM, args.in[2] + (2 * j + 1) * DM, RmId{}, scr, r % I_QKV, lane); continue; } r -= 2 * I_QKV;
            { const int j = r / I_O; transpose_item(args.in[8] + (size_t)j * DM * DM, DM, DM, Wo + (size_t)j * DM * DM, DM, (const float*)nullptr, RmId{}, scr, r % I_O, lane); }
        }
        if (MK_PROBE2) { __syncthreads(); if (bx == 0 && threadIdx.x == 0) TS[41] = __builtin_amdgcn_s_memrealtime(); }
        { LAS float* tab = scr;
          for (int i = lane; i < 128; i += 64) { tab[i] = cospif((float)i * (1.0f / 64.0f)); tab[128 + i] = sinpif((float)i * (1.0f / 64.0f)); }
          LDS_WAIT(); asm volatile("" ::: "memory");
          for (int task = gw; task < 2048; task += NGW) {
              const int nb = task & 15, cc = (task >> 4) & 3, g = (task >> 6) & 7, p = (task >> 9) & 1, j = task >> 10;
              const int n = nb * 64 + lane; const float* w = args.in[4] + (size_t)j * DM * DM + (size_t)(g * 128) * DM + n; const LAS float* tb = tab + p * 128;
              float acc[32];
#pragma unroll
              for (int ci = 0; ci < 32; ++ci) acc[ci] = 0.f;
              for (int jp0 = 0; jp0 < 128; jp0 += 8) { float wv[8];
#pragma unroll
                  for (int d = 0; d < 8; ++d) wv[d] = w[(size_t)(jp0 + d) * DM];
#pragma unroll
                  for (int d = 0; d < 8; ++d)
#pragma unroll
                      for (int ci = 0; ci < 32; ++ci) acc[ci] += tb[((cc * 32 + ci) * (jp0 + d)) & 127] * wv[d]; }
              const float* gain = args.in[2] + (2 * j) * DM + g * 128 + cc * 32;
              bf16_t* dst = W2 + (size_t)j * DM * 2048 + (size_t)n * 2048 + p * 1024 + g * 128 + cc * 32;
#pragma unroll
              for (int q4 = 0; q4 < 4; ++q4) { v4u o; const float sc = 0.08838834764831845f;
                  o.x = pk2(acc[8 * q4 + 0] * gain[8 * q4 + 0] * sc, acc[8 * q4 + 1] * gain[8 * q4 + 1] * sc); o.y = pk2(acc[8 * q4 + 2] * gain[8 * q4 + 2] * sc, acc[8 * q4 + 3] * gain[8 * q4 + 3] * sc);
                  o.z = pk2(acc[8 * q4 + 4] * gain[8 * q4 + 4] * sc, acc[8 * q4 + 5] * gain[8 * q4 + 5] * sc); o.w = pk2(acc[8 * q4 + 6] * gain[8 * q4 + 6] * sc, acc[8 * q4 + 7] * gain[8 * q4 + 7] * sc);
                  *(v4u*)(dst + 8 * q4) = o; }
          }
          LDS_WAIT(); asm volatile("" ::: "memory");
        }
        if (MK_PROBE2) { __syncthreads(); if (bx == 0 && threadIdx.x == 0) TS[42] = __builtin_amdgcn_s_memrealtime(); }
        { const int gt = gw * 64 + lane, NGT = NGW * 64;
          for (int e2 = gt; e2 < 64 * 256 * 64; e2 += NGT) {
              const int s1 = (e2 & 63) * 2, m = (e2 >> 6) & 255, s2 = e2 >> 14, k1 = m >> 1, pp = m & 1; float v[2];
#pragma unroll
              for (int d = 0; d < 2; ++d) { const int s = 64 * (s1 + d) + s2, r = (k1 * s) & 8191; const float x = (float)r * (1.0f / 4096.0f); v[d] = (pp ? -sinpif(x) : cospif(x)) * 0.08838834764831845f; }
              ((unsigned*)A1P)[e2] = pk2(v[0], v[1]); }
          for (int e2 = gt; e2 < 64 * 128 * 32; e2 += NGT) {
              const int s1 = (e2 & 31) * 2, m = (e2 >> 5) & 127, s2 = e2 >> 12, k1 = m >> 1, pp = m & 1; float v[2];
#pragma unroll
              for (int d = 0; d < 2; ++d) { const int s = 64 * (s1 + d) + s2, r = (k1 * s) & 4095; const float x = (float)r * (1.0f / 2048.0f); v[d] = (pp ? -sinpif(x) : cospif(x)) * 0.125f; }
              ((unsigned*)A1S)[e2] = pk2(v[0], v[1]); }
          for (int e2 = gt; e2 < 128 * 64; e2 += NGT) {
              const int k = (e2 & 63) * 2, m = e2 >> 6, k2 = m >> 1, pp = m & 1, p = k >> 6; float v[2];
#pragma unroll
              for (int d = 0; d < 2; ++d) { const int s2 = (k + d) & 63, r = (k2 * s2) & 63; const float x = (float)r * (1.0f / 32.0f); const float c = cospif(x), s = sinpif(x);
                  v[d] = (pp == 0 ? (p == 0 ? c : s) : (p == 0 ? -s : c)) * 0.125f; }
              ((unsigned*)A2)[e2] = pk2(v[0], v[1]); }
          if (gw == 0) {
#pragma unroll
              for (int j2 = 0; j2 < 2; ++j2) { float mq = fmaxf(fabsf(args.in[6][j2 * 128 + lane]), fabsf(args.in[6][j2 * 128 + 64 + lane])), mk = fmaxf(fabsf(args.in[7][j2 * 128 + lane]), fabsf(args.in[7][j2 * 128 + 64 + lane]));
#pragma unroll
                  for (int o = 1; o < 64; o <<= 1) { mq = fmaxf(mq, __shfl_xor(mq, o)); mk = fmaxf(mk, __shfl_xor(mk, o)); }
                  if (lane == 0) QKG[512 + j2] = -(128.0f * 1.02f * mq * mk) * (att::SCALE * 1.4426950408889634f); }
          }
          for (int e = gt; e < 512; e += NGT) { const int j = e >> 8, r = e & 255; QKG[e] = r < 128 ? args.in[6][j * 128 + r] : args.in[7][j * 128 + r - 128]; }
          for (int e = gt; e < 128 * 32; e += NGT) { const int i = e & 31, pos = e >> 5; const float inv = powf(10000.0f, -(float)i * (1.0f / 32.0f)); const float a = (float)pos * inv; ROPE[e] = make_float2(cosf(a), sinf(a)); }
        }
        if (MK_PROBE2) { __syncthreads(); if (bx == 0 && threadIdx.x == 0) TS[43] = __builtin_amdgcn_s_memrealtime(); }
        for (int m = 2 * gw; m < NTOK; m += 2 * NGW) { const float* src = m < NTOK_P ? args.in[0] + (size_t)m * DM : args.in[1] + (size_t)(m - NTOK_P) * DM; cvt_row2(src, src + DM, XB0 + (size_t)m * DM, XB0 + (size_t)(m + 1) * DM, RSS + (size_t)m * 4, RSS + (size_t)(m + 1) * 4, lane); }
    }
    PH_END

    for (int layer = 0; layer < 4; ++layer) {
        const int jj = layer >> 1;
        const float* rss_mix = RSS + (size_t)(2 * layer) * RSS_STRIDE;
        float* rss_ffn = RSS + (size_t)(2 * layer + 1) * RSS_STRIDE;
        float* rss_next = RSS + (size_t)(2 * layer + 2) * RSS_STRIDE;
        bf16_t* XBF = layer == 3 ? XBH : XB0;
        PG8_LAS float* Pscr = (PG8_LAS float*)(ldsl + 131072);
        if ((layer & 1) == 0) {
            PH_BEGIN
            if (EN_FFT) {
                char* wl = (char*)lds + wave * 16384;
                for (int u = gw; u < 2048; u += NGW) { const int cb = u & 15, s2 = (u >> 4) & 63, b = u >> 10; const size_t tok = (size_t)b * SEQ_P + s2;
                    fft_unit<128, 256, true>(A1P + (size_t)s2 * 256 * 128, XB0 + tok * DM + cb * 64, (size_t)64 * DM, TB + ((size_t)b * 2 * SEQ_P + s2) * DM + cb * 64, (size_t)2 * 64 * DM, (size_t)64 * DM, wl, lane, rss_mix + tok * 4, (size_t)64); }
                for (int u = gw; u < 8192; u += NGW) { const int cb = u & 15, s2 = (u >> 4) & 63, b = u >> 10; const size_t tok = (size_t)NTOK_P + (size_t)b * SEQ_S + s2;
                    fft_unit<64, 128, true>(A1S + (size_t)s2 * 128 * 64, XB0 + tok * DM + cb * 64, (size_t)64 * DM, TB + ((size_t)2 * NTOK_P + (size_t)b * 2 * SEQ_S + s2) * DM + cb * 64, (size_t)2 * 64 * DM, (size_t)64 * DM, wl, lane, rss_mix + tok * 4, (size_t)64); }
            }
            PH_END
            PH_BEGIN
            if (EN_FFT) {
                char* wl = (char*)lds + wave * 16384;
                for (int u = gw; u < 4096 + 8192; u += NGW) {
                    const bool P = u < 4096; const int v = P ? u : u - 4096; const int cb = v & 15; const int k1 = P ? ((v >> 4) & 127) : ((v >> 4) & 63); const int b = P ? (v >> 11) : (v >> 10);
                    const size_t trow = P ? ((size_t)b * 2 * SEQ_P + (size_t)k1 * 128) : ((size_t)2 * NTOK_P + (size_t)b * 2 * SEQ_S + (size_t)k1 * 128);
                    const size_t frow = P ? ((size_t)b * SEQ_P + k1) : ((size_t)NTOK_P + (size_t)b * SEQ_S + k1);
                    fft_unit<128, 128, false>(A2, TB + trow * DM + cb * 64, (size_t)DM, FB + frow * 2048 + cb * 64, P ? (size_t)128 * 2048 : (size_t)64 * 2048, (size_t)1024, wl, lane);
                }
            }
            PH_END
        } else {
            PH_BEGIN
            if (EN_QKV) {
                pg8::Gemm g{XB0, Wqkv + (size_t)jj * NQKV * DM, NTOK, NQKV, DM}; pg8::StaticOrder S; S.init(NTOK, NQKV, G, bx);
                pg8::EpiQKV E{QO, KB, VB, rss_mix, QKG + jj * 256, (const float*)ROPE, (PG8_LAS float*)(ldsl + 131072), att::SCALE * 1.4426950408889634f};
                pg8::gemm_phase<pg8::EpiQKV, pg8::StaticOrder, GU_ALIGN, GEMM_SP2>(ldsl, g, S, E);
            }
            PH_END
            PH_BEGIN
            if (EN_ATT) {
                const float* qg = QKG + jj * 256; const float negmc = QKG[512 + jj];
                for (int j = vcu; j < 1536; j += G) {
                    int b, h, qb, tok0, seq;
                    if (j < 512) { const int bh = j >> 5; qb = j & 31; b = bh >> 3; h = bh & 7; tok0 = b * SEQ_P; seq = SEQ_P; }
                    else { const int v = j - 512, bh = v >> 4; qb = v & 15; b = bh >> 3; h = bh & 7; tok0 = NTOK_P + b * SEQ_S; seq = SEQ_S; }
                    const att::bf16* Qb = (const att::bf16*)QO + ((size_t)tok0 + qb * 256) * 1024 + h * 128;
                    const att::bf16* Kh = (const att::bf16*)KB + (size_t)tok0 * 256 + (h >> 2) * 128;
                    const att::bf16* Vh = (const att::bf16*)VB + (size_t)tok0 * 256 + (h >> 2) * 128;
                    att::attn_unit(Qb, Kh, Vh, (att::bf16*)Qb, seq, qb * 256, qg, ROPE, negmc, (char*)lds);
                }
            }
            PH_END
        }
        PH_BEGIN
        if (EN_RES) {
            pg8::Gemm g = (layer & 1) ? pg8::Gemm{QO, Wo + (size_t)jj * DM * DM, NTOK, DM, DM} : pg8::Gemm{FB, W2 + (size_t)jj * DM * 2048, NTOK, DM, 2048};
            pg8::StaticOrder S; S.init(NTOK, DM, G, bx); pg8::EpiResB E{XB0, XBF, (float*)nullptr, rss_ffn, Pscr};
            pg8::gemm_phase<pg8::EpiResB, pg8::StaticOrder, true, GEMM_SP2>(ldsl, g, S, E);
        }
        PH_END
        PH_BEGIN
        if (EN_GU) {
            if (MK_SLEEP_US) { const unsigned long long t0 = __builtin_amdgcn_s_memrealtime(); while (__builtin_amdgcn_s_memrealtime() - t0 < 100ull * MK_SLEEP_US) __builtin_amdgcn_s_sleep(64); }
            pg8::Gemm g{XBF, Wgu + (size_t)layer * 2 * DFF * DM, NTOK, 2 * DFF, DM}; pg8::StaticOrder S; S.init(NTOK, 2 * DFF, G, bx);
            pg8::EpiSwiGLU E{HID, DFF, rss_ffn};
            pg8::gemm_phase<pg8::EpiSwiGLU, pg8::StaticOrder, GU_ALIGN, GEMM_SP2>(ldsl, g, S, E);
        }
        PH_END
        PH_BEGIN
        if (EN_RES) {
            pg8::Gemm g{HID, Wd + (size_t)layer * DM * DFF, NTOK, DM, DFF}; pg8::StaticOrder S; S.init(NTOK, DM, G, bx); S.rev = MK_DREV;
            pg8::EpiResB E{XBF, XB0, layer == 3 ? X : (float*)nullptr, layer == 3 ? (float*)nullptr : rss_next, Pscr};
            pg8::gemm_phase<pg8::EpiResB, pg8::StaticOrder, true, GEMM_SP2>(ldsl, g, S, E);
        }
        PH_END
    }
#undef PH_BEGIN
#undef PH_END
    for (int i = 0; i < MK_EXTRA_SYNC; ++i) cg::this_grid().sync();
    if (MK_PROBE && bx == 0 && threadIdx.x == 0) {
        unsigned long long sa = 0, sb = 0; const unsigned long long tot = TS[NPH_C] - TS[0];
        for (int i = 0; i < NPH_C; ++i) { const unsigned long long d = TS[i + 1] - TS[i]; if ((MK_MASK_A >> i) & 1u) sa += d; if ((MK_MASK_B >> i) & 1u) sb += d; }
        if (MK_PROBE2) { unsigned long long q[5] = {TS[40], TS[41], TS[42], TS[43], TS[1]}; sa = q[MK_PA + 1] - q[MK_PA]; sb = q[MK_PB + 1] - q[MK_PB]; sa *= 10; sb *= 10; }
        const unsigned long long pa = (sa * 100 + tot / 2) / tot, pb = (sb * 100 + tot / 2) / tot;
        const unsigned long long D = 2000ull * (pa * 100 + pb);
        while (__builtin_amdgcn_s_memrealtime() - TS[NPH_C] < D) __builtin_amdgcn_s_sleep(32);
    }
}
constexpr int NPHASES = NPH_C;

extern "C" void kernel_launch(void* const* d_in, const int* in_sizes, int n_in, void* d_out, int out_size, void* d_ws, size_t ws_size, hipStream_t stream) {
    static int grid = 0;
    if (grid == 0) {
        if (n_in != 12 || out_size != NTOK * DM || ws_size < WS_END) { fprintf(stderr, "kernel_launch: unexpected shapes: n_in %d out %d ws %zu (need %zu)\n", n_in, out_size, ws_size, (size_t)WS_END); grid = -1; return; }
        int dev = 0, cus = 0, per_cu = 0;
        hipGetDevice(&dev); hipDeviceGetAttribute(&cus, hipDeviceAttributeMultiprocessorCount, dev);
        if (hipFuncSetAttribute((const void*)mk_fwd, hipFuncAttributeMaxDynamicSharedMemorySize, LDS_BYTES) != hipSuccess) { fprintf(stderr, "kernel_launch: hipFuncSetAttribute failed\n"); grid = -1; return; }
        if (hipOccupancyMaxActiveBlocksPerMultiprocessor(&per_cu, (const void*)mk_fwd, NTHREADS, LDS_BYTES) != hipSuccess || per_cu < 1) { fprintf(stderr, "kernel_launch: occupancy query gave %d\n", per_cu); per_cu = 1; }
        (void)hipGetLastError();
        grid = cus * per_cu;
        fprintf(stderr, "kernel_launch: grid %d (cus %d x %d)\n", grid, cus, per_cu);
    }
    if (grid < 0) return;
    if (hipMemsetAsync(d_ws, 0, 65536, stream) != hipSuccess) { fprintf(stderr, "kernel_launch: memset failed\n"); return; }
    Args a{};
    for (int i = 0; i < 12; ++i) a.in[i] = (const float*)d_in[i];
    a.out = (float*)d_out; a.ws = (unsigned char*)d_ws;
#if MK_ONE_LAUNCH
    a.ph_lo = 0; a.ph_hi = NPHASES;
    void* kargs[] = {&a};
    hipError_t e = hipLaunchCooperativeKernel((const void*)mk_fwd, dim3(grid), dim3(NTHREADS), kargs, LDS_BYTES, stream);
    if (e != hipSuccess) fprintf(stderr, "kernel_launch: cooperative launch failed: %s (grid %d)\n", hipGetErrorString(e), grid);
#else
    for (int p = 0; p < NPHASES; ++p) { a.ph_lo = p; a.ph_hi = p + 1; hipLaunchKernelGGL(mk_fwd, dim3(grid), dim3(NTHREADS), LDS_BYTES, stream, a); }
    hipError_t e = hipPeekAtLastError();
    if (e != hipSuccess) fprintf(stderr, "kernel_launch: launch failed: %s\n", hipGetErrorString(e));
#endif
}
```

```cpp
#include <hip/hip_runtime.h>
#define ATT_SDEPTH 1
#define ATT_NEGM 1
#include <hip/hip_bf16.h>
#include <hip/hip_cooperative_groups.h>
#include <cstdio>
#include <cstdint>
namespace cg = cooperative_groups;

#ifndef EN_P0
#define EN_P0 1
#endif
#ifndef EN_FFT
#define EN_FFT 1
#endif
#ifndef EN_QKV
#define EN_QKV 1
#endif
#ifndef EN_MISC
#define EN_MISC 1
#endif
#ifndef EN_ATT
#define EN_ATT 1
#endif
#ifndef EN_RES
#define EN_RES 1
#endif
#ifndef EN_GU
#define EN_GU 1
#endif
#ifndef MK_PROBE
#define MK_PROBE 0
#endif
#ifndef MK_MASK_A
#define MK_MASK_A 0u
#endif
#ifndef MK_MASK_B
#define MK_MASK_B 0u
#endif
#ifndef MK_SLEEP_US
#define MK_SLEEP_US 0
#endif
#ifndef MK_EXTRA_SYNC
#define MK_EXTRA_SYNC 0
#endif
#ifndef MK_CG_ONLY
#define MK_CG_ONLY 0
#endif
#ifndef ATT_SDEPTH
#define ATT_SDEPTH 2
#endif
#ifndef ATT_SB
#define ATT_SB 0
#endif
#ifndef ATT_NEGM
#define ATT_NEGM 0
#endif
#ifndef GU_ALIGN
#define GU_ALIGN true
#endif
#ifndef GEMM_SP2
#define GEMM_SP2 true
#endif
#ifndef MK_PROBE2
#define MK_PROBE2 0
#endif
#ifndef MK_PA
#define MK_PA 0
#endif
#ifndef MK_PB
#define MK_PB 1
#endif
#ifndef MK_DREV
#define MK_DREV 1
#endif
#ifndef MK_ONE_LAUNCH
#define MK_ONE_LAUNCH 1
#endif

__device__ __forceinline__ int mk_tid() { int t = threadIdx.x; asm volatile("" : "+v"(t)); return t; }
namespace pg8 {
#define PG8_LAS __attribute__((address_space(3)))
typedef unsigned short bf16_t;
typedef short bf16x8 __attribute__((ext_vector_type(8)));
typedef float f32x4 __attribute__((ext_vector_type(4)));
typedef unsigned u32x4 __attribute__((ext_vector_type(4)));
constexpr int BM = 256, BK = 64, HALF = 128, HTB = HALF * BK * 2  , STAGE_BYTES = 8 * HTB, NXCD = 8, WGM = 8;

__host__ __device__ __forceinline__ int lds_byte(int r, int c) { const int st = (r >> 4) * 2 + (c >> 5), rr = r & 15, cc = c & 31, ob = rr * 64 + cc * 2; return st * 1024 + (ob ^ (((ob >> 9) & 1) << 5)); }
__host__ __device__ __forceinline__ void stage_rc(int b, int& R, int& C) { const int st = b / 1024, sb = b % 1024, swz = sb ^ (((sb >> 9) & 1) << 5); R = (st >> 1) * 16 + swz / 64; C = (st & 1) * 32 + (swz % 64) / 2; }
__host__ __device__ __forceinline__ int perm32(int rho) { const int n = rho >> 4, i = rho & 15; return 8 * (i >> 2) + 4 * n + (i & 3); }

struct Unit { int pm, pn; };
struct Gemm { const bf16_t* A; const bf16_t* Bt; int M, N, K; };

struct StaticOrder {
    int nM, nN, nwg, G, c, rev;
    __host__ __device__ void init(int M, int N, int G_, int c_) { nM = M / BM; nN = N / BM; nwg = nM * nN; G = G_; c = c_; rev = 0; }
    __host__ __device__ bool next(int i, Unit& u) const {
        const long L = (long)i * G + c; if (L >= nwg) return false;
        int wgid = (int)L; { const int q = nwg / NXCD, r = nwg % NXCD, xcd = wgid % NXCD, off = wgid / NXCD; wgid = (xcd < r ? xcd * (q + 1) : r * (q + 1) + (xcd - r) * q) + off; }
        const int nig = WGM * nN, gid = wgid / nig, fm = gid * WGM, gsz = (nM - fm) < WGM ? (nM - fm) : WGM;
        u.pm = fm + ((wgid % nig) % gsz); u.pn = (wgid % nig) / gsz; if (rev) u.pm = nM - 1 - u.pm; return true;
    }
    __device__ __forceinline__ void a_ready(const Unit&) const {}
    __device__ __forceinline__ void done(const Unit&) const {}
};

__device__ __forceinline__ unsigned cvt_pk_bf16(float lo, float hi) { unsigned r; asm volatile("v_cvt_pk_bf16_f32 %0, %1, %2" : "=v"(r) : "v"(lo), "v"(hi)); return r; }
typedef float f32x2 __attribute__((ext_vector_type(2)));
typedef float f32x2 __attribute__((ext_vector_type(2)));

__device__ __forceinline__ float bflo(unsigned w) { return __uint_as_float(w << 16); }
__device__ __forceinline__ float bfhi(unsigned w) { return __uint_as_float(w & 0xffff0000u); }
__device__ __forceinline__ float rstd_of(const float* rssp, size_t row) { const f32x4 p = *(const f32x4*)(rssp + row * 4); return __builtin_amdgcn_rsqf(((p[0] + p[1]) + (p[2] + p[3])) * (1.0f / 1024.0f) + 1e-6f); }
struct EpiResB {
    static constexpr bool PERM = true, AFTER_DRAIN = false;
    const bf16_t* xin; bf16_t* xout; float* fout; float* rssp; PG8_LAS float* P;
    __device__ __forceinline__ void operator()(const f32x4 (&acc)[2][2][4][2], const Unit& u, int wr, int wc, int fr, int fq) const {
        const int row0 = u.pm * BM + wr * 64 + fr, col0 = u.pn * BM + wc * 32 + 8 * fq;
#pragma unroll
        for (int ai = 0; ai < 2; ++ai) {
            u32x4 xo[4][2];
#pragma unroll
            for (int m = 0; m < 4; ++m)
#pragma unroll
                for (int bj = 0; bj < 2; ++bj) xo[m][bj] = *(const u32x4*)(xin + (size_t)(row0 + ai * HALF + m * 16) * 1024 + col0 + bj * HALF);
#pragma unroll
            for (int m = 0; m < 4; ++m) {
                const size_t roff = (size_t)(row0 + ai * HALF + m * 16) * 1024 + col0; float ss = 0.f;
#pragma unroll
                for (int bj = 0; bj < 2; ++bj) {
                    const u32x4 w = xo[m][bj]; const f32x4 a0 = acc[ai][bj][m][0], a1 = acc[ai][bj][m][1]; f32x4 v0, v1;
                    v0[0] = bflo(w.x) + a0[0]; v0[1] = bfhi(w.x) + a0[1]; v0[2] = bflo(w.y) + a0[2]; v0[3] = bfhi(w.y) + a0[3];
                    v1[0] = bflo(w.z) + a1[0]; v1[1] = bfhi(w.z) + a1[1]; v1[2] = bflo(w.w) + a1[2]; v1[3] = bfhi(w.w) + a1[3];
                    ss += (v0[0] * v0[0] + v0[1] * v0[1]) + (v0[2] * v0[2] + v0[3] * v0[3]) + (v1[0] * v1[0] + v1[1] * v1[1]) + (v1[2] * v1[2] + v1[3] * v1[3]);
                    if (fout) { *(f32x4*)(fout + roff + bj * HALF) = v0; *(f32x4*)(fout + roff + bj * HALF + 4) = v1; }
                    else { u32x4 o; o.x = cvt_pk_bf16(v0[0], v0[1]); o.y = cvt_pk_bf16(v0[2], v0[3]); o.z = cvt_pk_bf16(v1[0], v1[1]); o.w = cvt_pk_bf16(v1[2], v1[3]); *(u32x4*)(xout + roff + bj * HALF) = o; }
                }
                if (rssp) { ss += __shfl_xor(ss, 16); ss += __shfl_xor(ss, 32); if (fq == 0) P[(ai * HALF + wr * 64 + m * 16 + fr) * 4 + wc] = ss; }
            }
        }
        if (rssp) {
            asm volatile("s_waitcnt lgkmcnt(0)" ::: "memory"); __builtin_amdgcn_s_barrier(); asm volatile("" ::: "memory");
            const int t = (wr * 4 + wc) * 64 + fq * 16 + fr;
            if (t < 256) { const f32x4 p = *((const PG8_LAS f32x4*)P + t); rssp[(size_t)(u.pm * BM + t) * 4 + u.pn] = (p[0] + p[1]) + (p[2] + p[3]); }
        }
    }
};
__device__ __forceinline__ float silu_mul(float g, float u) { return g * u * __builtin_amdgcn_rcpf(1.0f + __builtin_amdgcn_exp2f(-1.4426950408889634f * g)); }
struct EpiSwiGLU {
    static constexpr bool PERM = true, AFTER_DRAIN = false;
    bf16_t* H; int ldh; const float* rssp;
    __device__ __forceinline__ void operator()(const f32x4 (&acc)[2][2][4][2], const Unit& u, int wr, int wc, int fr, int fq) const {
        const int row0 = u.pm * BM + wr * 64 + fr, col0 = u.pn * HALF + wc * 32 + 8 * fq;
        f32x4 pp[2][4];
#pragma unroll
        for (int ai = 0; ai < 2; ++ai)
#pragma unroll
            for (int m = 0; m < 4; ++m) pp[ai][m] = *(const f32x4*)(rssp + (size_t)(row0 + ai * HALF + m * 16) * 4);
#pragma unroll
        for (int ai = 0; ai < 2; ++ai)
#pragma unroll
            for (int m = 0; m < 4; ++m) { const int row = row0 + ai * HALF + m * 16; bf16_t* rowp = H + (size_t)row * ldh + col0; const f32x4 p = pp[ai][m]; const float rs = __builtin_amdgcn_rsqf(((p[0] + p[1]) + (p[2] + p[3])) * (1.0f / 1024.0f) + 1e-6f);
                const f32x4 g0 = acc[ai][0][m][0] * rs, g1 = acc[ai][0][m][1] * rs, u0 = acc[ai][1][m][0] * rs, u1 = acc[ai][1][m][1] * rs;
                u32x4 w;
                w.x = cvt_pk_bf16(silu_mul(g0[0], u0[0]), silu_mul(g0[1], u0[1])); w.y = cvt_pk_bf16(silu_mul(g0[2], u0[2]), silu_mul(g0[3], u0[3]));
                w.z = cvt_pk_bf16(silu_mul(g1[0], u1[0]), silu_mul(g1[1], u1[1])); w.w = cvt_pk_bf16(silu_mul(g1[2], u1[2]), silu_mul(g1[3], u1[3]));
                *(u32x4*)rowp = w; }
    }
};
struct EpiQKV {
    static constexpr bool PERM = true, AFTER_DRAIN = false;
    bf16_t *Q, *K, *V; const float* rssp;
    const float* qkg;
    const float* rope;
    PG8_LAS float* P2;
    float qscale;
    __device__ __forceinline__ void operator()(const f32x4 (&acc)[2][2][4][2], const Unit& u, int wr, int wc, int fr, int fq) const {
        const int row0 = u.pm * BM + wr * 64 + fr;
        bf16_t* base = u.pn < 4 ? Q + u.pn * BM : (u.pn == 4 ? K : V); const int ldc = u.pn < 4 ? 1024 : 256;
        const int col0 = wc * 32 + 8 * fq;
        f32x4 pp[2][4]; float rs[2][4];
#pragma unroll
        for (int ai = 0; ai < 2; ++ai)
#pragma unroll
            for (int m = 0; m < 4; ++m) pp[ai][m] = *(const f32x4*)(rssp + (size_t)(row0 + ai * HALF + m * 16) * 4);
#pragma unroll
        for (int ai = 0; ai < 2; ++ai)
#pragma unroll
            for (int m = 0; m < 4; ++m) { const f32x4 p = pp[ai][m]; rs[ai][m] = __builtin_amdgcn_rsqf(((p[0] + p[1]) + (p[2] + p[3])) * (1.0f / 1024.0f) + 1e-6f); }
        if (u.pn == 5) {
#pragma unroll
            for (int ai = 0; ai < 2; ++ai)
#pragma unroll
                for (int m = 0; m < 4; ++m) { bf16_t* rowp = base + (size_t)(row0 + ai * HALF + m * 16) * ldc + col0;
#pragma unroll
                    for (int bj = 0; bj < 2; ++bj) { const f32x4 v0 = acc[ai][bj][m][0] * rs[ai][m], v1 = acc[ai][bj][m][1] * rs[ai][m]; u32x4 w;
                        w.x = cvt_pk_bf16(v0[0], v0[1]); w.y = cvt_pk_bf16(v0[2], v0[3]); w.z = cvt_pk_bf16(v1[0], v1[1]); w.w = cvt_pk_bf16(v1[2], v1[3]);
                        *(u32x4*)(rowp + bj * HALF) = w; } }
            return;
        }
#pragma unroll
        for (int ai = 0; ai < 2; ++ai)
#pragma unroll
            for (int m = 0; m < 4; ++m)
#pragma unroll
                for (int bj = 0; bj < 2; ++bj) { const f32x4 v0 = acc[ai][bj][m][0] * rs[ai][m], v1 = acc[ai][bj][m][1] * rs[ai][m];
                    float ss = (v0[0] * v0[0] + v0[1] * v0[1]) + (v0[2] * v0[2] + v0[3] * v0[3]) + (v1[0] * v1[0] + v1[1] * v1[1]) + (v1[2] * v1[2] + v1[3] * v1[3]);
                    ss += __shfl_xor(ss, 16); ss += __shfl_xor(ss, 32);
                    if (fq == 0) P2[((ai * HALF + wr * 64 + m * 16 + fr) * 2 + bj) * 4 + wc] = ss; }
        asm volatile("s_waitcnt lgkmcnt(0)" ::: "memory"); __builtin_amdgcn_s_barrier(); asm volatile("" ::: "memory");
        const float* gp = qkg + (u.pn == 4 ? 128 : 0) + col0; const float hs = u.pn == 4 ? 1.0f : qscale;
        const f32x4 g0 = *(const f32x4*)gp * hs, g1 = *(const f32x4*)(gp + 4) * hs;
        const int ib = 16 * (wc & 1) + 4 * fq;
#pragma unroll
        for (int ai = 0; ai < 2; ++ai)
#pragma unroll
            for (int m = 0; m < 4; ++m) { const int row = row0 + ai * HALF + m * 16; bf16_t* rowp = base + (size_t)row * ldc + col0;
                const int t = row < 16384 ? (row & 8191) : ((row - 16384) & 4095); const int pos = wc < 2 ? (t >> 6) : (t & 63);
                const f32x4 cs0 = *(const f32x4*)(rope + (size_t)(pos * 32 + ib) * 2), cs1 = *(const f32x4*)(rope + (size_t)(pos * 32 + ib + 2) * 2);
#pragma unroll
                for (int bj = 0; bj < 2; ++bj) { const f32x4 pr = *((const PG8_LAS f32x4*)P2 + ((ai * HALF + wr * 64 + m * 16 + fr) * 2 + bj));
                    const float rk = rs[ai][m] * __builtin_amdgcn_rsqf(((pr[0] + pr[1]) + (pr[2] + pr[3])) * (1.0f / 128.0f) + 1e-6f);
                    const f32x4 y0 = acc[ai][bj][m][0] * rk * g0, y1 = acc[ai][bj][m][1] * rk * g1; u32x4 w;
                    w.x = cvt_pk_bf16(y0[0] * cs0[0] - y0[1] * cs0[1], y0[0] * cs0[1] + y0[1] * cs0[0]); w.y = cvt_pk_bf16(y0[2] * cs0[2] - y0[3] * cs0[3], y0[2] * cs0[3] + y0[3] * cs0[2]);
                    w.z = cvt_pk_bf16(y1[0] * cs1[0] - y1[1] * cs1[1], y1[0] * cs1[1] + y1[1] * cs1[0]); w.w = cvt_pk_bf16(y1[2] * cs1[2] - y1[3] * cs1[3], y1[2] * cs1[3] + y1[3] * cs1[2]);
                    *(u32x4*)(rowp + bj * HALF) = w; } }
    }
};
template <class Epi, class Sched, bool ALIGN_EPI = false, bool SP2 = false>
__device__ __forceinline__ void gemm_phase(PG8_LAS unsigned char* lds, const Gemm g, const Sched& S, const Epi& E) {
    const int tid = mk_tid(), wid = __builtin_amdgcn_readfirstlane(tid >> 6), lane = tid & 63, wr = wid >> 2, wc = wid & 3, fr = lane & 15, fq = lane >> 4;
    const int K = g.K, nt = K / BK;
    unsigned voffA[2], voffB[2];
#pragma unroll
    for (int i = 0; i < 2; ++i) { int R, C; stage_rc(tid * 16 + i * 8192, R, C); const int Rb = Epi::PERM ? ((R & ~31) + perm32(R & 31)) : R;
        voffA[i] = (unsigned)(R * K + C) * 2u; voffB[i] = (unsigned)(Rb * K + C) * 2u; }
    const size_t kstep = (size_t)(BK * 2);
    const size_t hstep = (size_t)HALF * K * 2;
    const size_t tstep = 2 * hstep;
    const unsigned ldsw = (unsigned)wid * 1024u;
    const int aoff = lds_byte(wr * 64 + fr, fq * 8), boff = lds_byte(wc * 32 + fr, fq * 8);
#define PG8_SA(b, h) (((b) * 2 + (h)) * HTB)
#define PG8_SB(b, h) ((4 + (b) * 2 + (h)) * HTB)
#define PG8_STAGE(bufoff, gbase, voff) do { _Pragma("unroll") for (int _i = 0; _i < 2; ++_i) \
        __builtin_amdgcn_global_load_lds((const unsigned*)((const char*)(gbase) + (voff)[_i]), (PG8_LAS unsigned*)(lds + (bufoff) + ldsw + _i * 8192), 16, 0, 0); } while (0)
#define PG8_LDA(dst, b, h) do { _Pragma("unroll") for (int m = 0; m < 4; ++m) _Pragma("unroll") for (int k = 0; k < 2; ++k) dst[m][k] = *(const PG8_LAS bf16x8*)(lds + PG8_SA(b, h) + aoff + m * 2048 + k * 1024); } while (0)
#define PG8_LDB(dst, b, h) do { _Pragma("unroll") for (int n = 0; n < 2; ++n) _Pragma("unroll") for (int k = 0; k < 2; ++k) dst[n][k] = *(const PG8_LAS bf16x8*)(lds + PG8_SB(b, h) + boff + n * 2048 + k * 1024); } while (0)
#define PG8_MMA(ai, bj, At, Bt) do { __builtin_amdgcn_s_setprio(1); _Pragma("unroll") for (int m = 0; m < 4; ++m) _Pragma("unroll") for (int n = 0; n < 2; ++n) _Pragma("unroll") for (int k = 0; k < 2; ++k) \
        acc[ai][bj][m][n] = __builtin_amdgcn_mfma_f32_16x16x32_bf16(Bt[n][k], At[m][k], acc[ai][bj][m][n], 0, 0, 0); __builtin_amdgcn_s_setprio(0); } while (0)
#define PG8_WAIT_V(n) asm volatile("s_waitcnt vmcnt(" #n ")" ::: "memory")
#define PG8_WAIT_L(n) asm volatile("s_waitcnt lgkmcnt(" #n ")" ::: "memory")
#define PG8_BAR __builtin_amdgcn_s_barrier()
#define PG8_SCHED __builtin_amdgcn_sched_barrier(0)
    Unit cur, nxt; int ui = 0;
    if (!S.next(0, cur)) return;
    f32x4 acc[2][2][4][2];
#pragma unroll
    for (int a = 0; a < 2; ++a)
#pragma unroll
        for (int b = 0; b < 2; ++b)
#pragma unroll
            for (int m = 0; m < 4; ++m)
#pragma unroll
                for (int n = 0; n < 2; ++n) acc[a][b][m][n] = (f32x4){0.f, 0.f, 0.f, 0.f};
    bf16x8 At[4][2], B0[2][2], B1[2][2];
    const char* cA = (const char*)g.A + (size_t)cur.pm * tstep; const char* cB = (const char*)g.Bt + (size_t)cur.pn * tstep;
    S.a_ready(cur);
    if constexpr (SP2) {
        PG8_STAGE(PG8_SB(0, 0), cB, voffB); PG8_STAGE(PG8_SB(0, 1), cB + hstep, voffB); PG8_STAGE(PG8_SA(0, 0), cA, voffA); PG8_STAGE(PG8_SA(0, 1), cA + hstep, voffA);
        if (wr == 1) PG8_BAR;
        PG8_WAIT_V(2); PG8_BAR;
        PG8_STAGE(PG8_SB(1, 0), cB + kstep, voffB); PG8_STAGE(PG8_SA(1, 0), cA + kstep, voffA); PG8_STAGE(PG8_SB(1, 1), cB + hstep + kstep, voffB);
        PG8_WAIT_V(6); PG8_BAR;
    } else {
        PG8_STAGE(PG8_SB(0, 0), cB, voffB); PG8_STAGE(PG8_SA(0, 0), cA, voffA); PG8_STAGE(PG8_SB(0, 1), cB + hstep, voffB); PG8_STAGE(PG8_SA(0, 1), cA + hstep, voffA);
        if (wr == 1) PG8_BAR;
        PG8_WAIT_V(4); PG8_BAR;
        PG8_STAGE(PG8_SB(1, 0), cB + kstep, voffB); PG8_STAGE(PG8_SA(1, 0), cA + kstep, voffA); PG8_STAGE(PG8_SB(1, 1), cB + hstep + kstep, voffB);
        PG8_WAIT_V(6); PG8_BAR;
    }
    for (;;) {
        const bool has_next = S.next(ui + 1, nxt);
        const char* nA = has_next ? (const char*)g.A + (size_t)nxt.pm * tstep : cA; const char* nB = has_next ? (const char*)g.Bt + (size_t)nxt.pn * tstep : cB;
        for (int t = 0; t < nt; t += 2) {
            const bool last = (t == nt - 2);
            const char* a1 = cA + (size_t)(t + 1) * kstep;
            const char* a2 = last ? nA : cA + (size_t)(t + 2) * kstep; const char* b2 = last ? nB : cB + (size_t)(t + 2) * kstep;
            const char* a3 = a2 + kstep; const char* b3 = b2 + kstep;
            if (last && has_next) S.a_ready(nxt);
            if constexpr (SP2) {
            PG8_LDB(B0, 0, 0); PG8_LDB(B1, 0, 1); PG8_SCHED; PG8_LDA(At, 0, 0); PG8_STAGE(PG8_SA(1, 1), a1 + hstep, voffA);
            PG8_WAIT_V(8); PG8_WAIT_L(0); PG8_BAR; PG8_MMA(0, 0, At, B0); PG8_MMA(0, 1, At, B1); PG8_BAR; PG8_SCHED;
            PG8_LDA(At, 0, 1); PG8_STAGE(PG8_SB(0, 0), b2, voffB); PG8_STAGE(PG8_SB(0, 1), b2 + hstep, voffB); PG8_STAGE(PG8_SA(0, 0), a2, voffA);
            PG8_WAIT_V(8); PG8_WAIT_L(0); PG8_BAR; PG8_MMA(1, 0, At, B0); PG8_MMA(1, 1, At, B1); PG8_BAR; PG8_SCHED;
            PG8_LDB(B0, 1, 0); PG8_LDB(B1, 1, 1); PG8_SCHED; PG8_LDA(At, 1, 0); PG8_STAGE(PG8_SA(0, 1), a2 + hstep, voffA);
            PG8_WAIT_V(8); PG8_WAIT_L(0); PG8_BAR; PG8_MMA(0, 0, At, B0); PG8_MMA(0, 1, At, B1); PG8_BAR; PG8_SCHED;
            PG8_LDA(At, 1, 1); PG8_STAGE(PG8_SB(1, 0), b3, voffB); PG8_STAGE(PG8_SB(1, 1), b3 + hstep, voffB); PG8_STAGE(PG8_SA(1, 0), a3, voffA);
            PG8_WAIT_V(8); PG8_WAIT_L(0); PG8_BAR; PG8_MMA(1, 0, At, B0); PG8_MMA(1, 1, At, B1); PG8_BAR; PG8_SCHED;
            } else {
            PG8_LDB(B0, 0, 0); PG8_SCHED; PG8_LDA(At, 0, 0); PG8_STAGE(PG8_SA(1, 1), a1 + hstep, voffA);
            PG8_WAIT_L(8); PG8_BAR; PG8_WAIT_L(0); PG8_MMA(0, 0, At, B0); PG8_BAR; PG8_SCHED;
            PG8_LDB(B1, 0, 1); PG8_STAGE(PG8_SB(0, 0), b2, voffB);
            PG8_BAR; PG8_WAIT_L(0); PG8_MMA(0, 1, At, B1); PG8_BAR;
            PG8_LDA(At, 0, 1); PG8_STAGE(PG8_SA(0, 0), a2, voffA);
            PG8_BAR; PG8_WAIT_L(0); PG8_MMA(1, 0, At, B0); PG8_BAR; PG8_SCHED;
            PG8_STAGE(PG8_SB(0, 1), b2 + hstep, voffB);
            PG8_WAIT_V(6); PG8_BAR; PG8_MMA(1, 1, At, B1); PG8_BAR;
            PG8_LDB(B0, 1, 0); PG8_SCHED; PG8_LDA(At, 1, 0); PG8_STAGE(PG8_SA(0, 1), a2 + hstep, voffA);
            PG8_WAIT_L(8); PG8_BAR; PG8_WAIT_L(0); PG8_MMA(0, 0, At, B0); PG8_BAR; PG8_SCHED;
            PG8_LDB(B1, 1, 1); PG8_STAGE(PG8_SB(1, 0), b3, voffB);
            PG8_BAR; PG8_WAIT_L(0); PG8_MMA(0, 1, At, B1); PG8_BAR;
            PG8_LDA(At, 1, 1); PG8_STAGE(PG8_SA(1, 0), a3, voffA);
            PG8_BAR; PG8_WAIT_L(0); PG8_MMA(1, 0, At, B0); PG8_BAR; PG8_SCHED;
            PG8_STAGE(PG8_SB(1, 1), b3 + hstep, voffB);
            PG8_WAIT_V(6); PG8_BAR; PG8_MMA(1, 1, At, B1); PG8_BAR;
            }
        }
        if constexpr (ALIGN_EPI) { if (wr == 0) PG8_BAR; }
        if constexpr (!Epi::AFTER_DRAIN) { E(acc, cur, wr, wc, fr, fq); S.done(cur); }
        if (!has_next) break;
#pragma unroll
        for (int a = 0; a < 2; ++a)
#pragma unroll
            for (int b = 0; b < 2; ++b)
#pragma unroll
                for (int m = 0; m < 4; ++m)
#pragma unroll
                    for (int n = 0; n < 2; ++n) acc[a][b][m][n] = (f32x4){0.f, 0.f, 0.f, 0.f};
        cur = nxt; cA = nA; cB = nB; ++ui;
        if constexpr (ALIGN_EPI) { if (wr == 1) PG8_BAR; }
    }
    PG8_WAIT_V(0);
    if constexpr (!ALIGN_EPI) { if (wr == 0) PG8_BAR; }
    PG8_BAR;
    if constexpr (Epi::AFTER_DRAIN) { E.fused(acc, cur, wr, wc, fr, fq, lds, wid, lane); S.done(cur); }
#undef PG8_SA
#undef PG8_SB
#undef PG8_STAGE
#undef PG8_LDA
#undef PG8_LDB
#undef PG8_MMA
#undef PG8_WAIT_V
#undef PG8_WAIT_L
#undef PG8_BAR
#undef PG8_SCHED
}
}

namespace att {
using bf16 = __hip_bfloat16;
constexpr int   D = 128, NW = 8, QBLK = 32, KVBLK = 64;
constexpr float SCALE = 0.088388347648318440f;
constexpr float THR = 8.f;
constexpr int SDEPTH = ATT_SDEPTH;
constexpr int LDQ = 1024, LDK = 256, LDO = 1024;
constexpr size_t SHM_V = KVBLK * D * 2, SHM_K = KVBLK * D * 2, SHM_ATTN = 2 * SHM_V + 2 * SHM_K + NW * 64 * 4;
constexpr size_t OST_OFF = 69632;
using bf16x8 = __attribute__((ext_vector_type(8))) short;
using s16x4  = __attribute__((ext_vector_type(4))) short;
using f32x16 = __attribute__((ext_vector_type(16))) float;
using f32x8  = __attribute__((ext_vector_type(8))) float;
using u32x4  = __attribute__((ext_vector_type(4))) unsigned;
#define KSWZ(row, colB) ((row) * 256 + ((colB) ^ (((row) & 7) << 4)))
#define SBAR() __builtin_amdgcn_sched_barrier(0)
__device__ __forceinline__ int crow(int r, int hi) { return (r & 3) + 8 * (r >> 2) + 4 * hi; }
__device__ __forceinline__ unsigned cvtpk(float lo, float hi) {
  unsigned r; asm volatile("v_cvt_pk_bf16_f32 %0, %1, %2" : "=v"(r) : "v"(lo), "v"(hi)); return r;
}
template <typename TIn> struct Stage;
template <> struct Stage<bf16>  { using T = bf16x8;
  __device__ static __forceinline__ T ld8(const bf16* p) { return *reinterpret_cast<const bf16x8*>(p); }
  __device__ static __forceinline__ bf16x8 tobf(T x) { return x; } };
template <> struct Stage<float> { using T = f32x8;
  __device__ static __forceinline__ T ld8(const float* p) { return *reinterpret_cast<const f32x8*>(p); }
  __device__ static __forceinline__ bf16x8 tobf(T x) {
    u32x4 w = {cvtpk(x[0], x[1]), cvtpk(x[2], x[3]), cvtpk(x[4], x[5]), cvtpk(x[6], x[7])}; return *reinterpret_cast<bf16x8*>(&w); } };

__device__ __forceinline__ void partialSM(f32x16& p0, f32x16& p1, float& m_reg, float& mn, float& alpha) {
  constexpr float C = SCALE * 1.4426950408889634f;
  float pmax = p0[0]; for (int r = 1; r < 16; ++r) pmax = fmaxf(pmax, p0[r]); for (int r = 0; r < 16; ++r) pmax = fmaxf(pmax, p1[r]);
  { auto rr = __builtin_amdgcn_permlane32_swap(__float_as_uint(pmax), __float_as_uint(pmax), false, false);
    pmax = fmaxf(__uint_as_float(rr[0]), __uint_as_float(rr[1])); }
  if (__builtin_expect(__all(pmax - m_reg <= THR / SCALE), 1)) { mn = m_reg; alpha = 1.f; }
  else { mn = fmaxf(m_reg, pmax); alpha = __builtin_amdgcn_exp2f((m_reg - mn) * C); m_reg = mn; }
  float mnC = -mn * C;
  for (int r = 0; r < 16; ++r) p0[r] = fmaf(p0[r], C, mnC); for (int r = 0; r < 16; ++r) p1[r] = fmaf(p1[r], C, mnC);
  for (int r = 0; r < 16; ++r) p0[r] = __builtin_amdgcn_exp2f(p0[r]);
}
__device__ __forceinline__ void finishSM(f32x16& p0, f32x16& p1, float alpha, float& l_reg, bf16x8& pa0, bf16x8& pa1, bf16x8& pa2, bf16x8& pa3) {
  for (int r = 0; r < 16; ++r) p1[r] = __builtin_amdgcn_exp2f(p1[r]);
  float ps = 0; for (int r = 0; r < 16; ++r) ps += p0[r]; for (int r = 0; r < 16; ++r) ps += p1[r];
  { auto rr = __builtin_amdgcn_permlane32_swap(__float_as_uint(ps), __float_as_uint(ps), false, false);
    ps = __uint_as_float(rr[0]) + __uint_as_float(rr[1]); }
  l_reg = l_reg * alpha + ps;
#define PK4(P, BASE, OUT) do { unsigned a0 = cvtpk(P[BASE + 0], P[BASE + 1]), a1 = cvtpk(P[BASE + 2], P[BASE + 3]);   \
    unsigned b0 = cvtpk(P[BASE + 4], P[BASE + 5]), b1 = cvtpk(P[BASE + 6], P[BASE + 7]);                              \
    auto r0 = __builtin_amdgcn_permlane32_swap(a0, b0, false, false); auto r1 = __builtin_amdgcn_permlane32_swap(a1, b1, false, false); \
    u32x4 w = {r0[0], r1[0], r0[1], r1[1]}; OUT = *reinterpret_cast<bf16x8*>(&w); } while (0)
  PK4(p0, 0, pa0); PK4(p0, 8, pa1); PK4(p1, 0, pa2); PK4(p1, 8, pa3);
#undef PK4
}
__device__ __forceinline__ void qkt(f32x16& p0, f32x16& p1, const bf16* Ks, const bf16x8* qr, int r32, int hi) {
  p0 = f32x16{}; p1 = f32x16{};
  for (int d0 = 0; d0 < 8; ++d0) { int cb = (d0 * 16 + hi * 8) * 2;
    bf16x8 b0 = *reinterpret_cast<const bf16x8*>((const char*)Ks + KSWZ(r32, cb));
    bf16x8 b1 = *reinterpret_cast<const bf16x8*>((const char*)Ks + KSWZ(32 + r32, cb));
    p0 = __builtin_amdgcn_mfma_f32_32x32x16_bf16(b0, qr[d0], p0, 0, 0, 0);
    p1 = __builtin_amdgcn_mfma_f32_32x32x16_bf16(b1, qr[d0], p1, 0, 0, 0); }
}
__device__ __forceinline__ int v_st(int k, int c) { const int kk = (k & ~0xC) | ((k & 4) << 1) | ((k & 8) >> 1); return ((kk >> 3) * 4 + (c >> 5)) * 512 + ((kk & 7) * 32 + (c & 31)) * 2; }
__device__ __forceinline__ int v_rd_base(int lane) { return ((lane & 3) << 3) | (((lane >> 2) & 3) << 6) | (((lane >> 4) & 1) << 5) | (((lane >> 5) & 1) << 8); }
constexpr int v_rd_off(int d0, int ks, int half) { return d0 * 512 + ks * 4096 + half * 2048; }
template <int OFF> __device__ __forceinline__ s16x4 tr_read(int vb) {
  s16x4 r; asm volatile("ds_read_b64_tr_b16 %0, %1 offset:%2" : "=&v"(r) : "v"(vb), "i"(OFF) : "memory"); return r;
}
template <int D0> __device__ __forceinline__ void pv_one(f32x16& od, int vb, bf16x8 pa0, bf16x8 pa1, bf16x8 pa2, bf16x8 pa3) {
  const s16x4 l0 = tr_read<v_rd_off(D0, 0, 0)>(vb), h0 = tr_read<v_rd_off(D0, 0, 1)>(vb), l1 = tr_read<v_rd_off(D0, 1, 0)>(vb), h1 = tr_read<v_rd_off(D0, 1, 1)>(vb);
  const s16x4 l2 = tr_read<v_rd_off(D0, 2, 0)>(vb), h2 = tr_read<v_rd_off(D0, 2, 1)>(vb), l3 = tr_read<v_rd_off(D0, 3, 0)>(vb), h3 = tr_read<v_rd_off(D0, 3, 1)>(vb);
  asm volatile("s_waitcnt lgkmcnt(0)" ::: "memory"); SBAR();
#define PK(L, H) (bf16x8){L[0], L[1], L[2], L[3], H[0], H[1], H[2], H[3]}
  od = __builtin_amdgcn_mfma_f32_32x32x16_bf16(pa0, PK(l0, h0), od, 0, 0, 0);
  od = __builtin_amdgcn_mfma_f32_32x32x16_bf16(pa1, PK(l1, h1), od, 0, 0, 0);
  od = __builtin_amdgcn_mfma_f32_32x32x16_bf16(pa2, PK(l2, h2), od, 0, 0, 0);
  od = __builtin_amdgcn_mfma_f32_32x32x16_bf16(pa3, PK(l3, h3), od, 0, 0, 0);
#undef PK
}
__device__ __forceinline__ void pv_d0(f32x16* o, int vb, bf16x8 pa0, bf16x8 pa1, bf16x8 pa2, bf16x8 pa3) {
  pv_one<0>(o[0], vb, pa0, pa1, pa2, pa3); pv_one<1>(o[1], vb, pa0, pa1, pa2, pa3); pv_one<2>(o[2], vb, pa0, pa1, pa2, pa3); pv_one<3>(o[3], vb, pa0, pa1, pa2, pa3);
}

__device__ __forceinline__ float bf2f(short s) { return __uint_as_float(((unsigned)(unsigned short)s) << 16); }

__device__ __forceinline__ void qkt2(f32x16& p0, f32x16& p1, const bf16* Ks, const bf16x8* qr, const f32x16& negm, int r32, int hi) {
  p0 = negm; p1 = negm;
#pragma unroll
  for (int d0 = 0; d0 < 8; ++d0) { int cb = (d0 * 16 + hi * 8) * 2;
    bf16x8 b0 = *reinterpret_cast<const bf16x8*>((const char*)Ks + KSWZ(r32, cb));
    bf16x8 b1 = *reinterpret_cast<const bf16x8*>((const char*)Ks + KSWZ(32 + r32, cb));
    p0 = __builtin_amdgcn_mfma_f32_32x32x16_bf16(b0, qr[d0], p0, 0, 0, 0); p1 = __builtin_amdgcn_mfma_f32_32x32x16_bf16(b1, qr[d0], p1, 0, 0, 0); }
}
__device__ __forceinline__ void expA(f32x16& p0, float negmc) {
#pragma unroll
  for (int r = 0; r < 16; ++r) p0[r] = __builtin_amdgcn_exp2f(ATT_NEGM ? p0[r] : p0[r] + negmc);
}
__device__ __forceinline__ void finishSM2(f32x16& p0, f32x16& p1, float negmc, float& l_reg, bf16x8& pa0, bf16x8& pa1, bf16x8& pa2, bf16x8& pa3) {
#pragma unroll
  for (int r = 0; r < 16; ++r) p1[r] = __builtin_amdgcn_exp2f(ATT_NEGM ? p1[r] : p1[r] + negmc);
  float ps = 0;
#pragma unroll
  for (int r = 0; r < 16; ++r) ps += p0[r];
#pragma unroll
  for (int r = 0; r < 16; ++r) ps += p1[r];
  l_reg += ps;
#define PK4(P, BASE, OUT) do { unsigned a0 = cvtpk(P[BASE + 0], P[BASE + 1]), a1 = cvtpk(P[BASE + 2], P[BASE + 3]);   \
    unsigned b0 = cvtpk(P[BASE + 4], P[BASE + 5]), b1 = cvtpk(P[BASE + 6], P[BASE + 7]);                              \
    auto r0 = __builtin_amdgcn_permlane32_swap(a0, b0, false, false); auto r1 = __builtin_amdgcn_permlane32_swap(a1, b1, false, false); \
    u32x4 w = {r0[0], r1[0], r0[1], r1[1]}; OUT = *reinterpret_cast<bf16x8*>(&w); } while (0)
  PK4(p0, 0, pa0); PK4(p0, 8, pa1); PK4(p1, 0, pa2); PK4(p1, 8, pa3);
#undef PK4
}

__device__ __forceinline__ void attn_unit(const bf16* Qb, const bf16* __restrict__ Kh, const bf16* __restrict__ Vh,
                                          bf16* Ob, int seq, int t0, const float* __restrict__ qgain, const float2* __restrict__ rope, float negmc, char* lds) {
  using St = Stage<bf16>;
  const int tid = mk_tid(), wid = tid >> 6, lane = tid & 63, r32 = lane & 31, hi = lane >> 5;
  bf16* V_lds = (bf16*)lds; bf16* K_lds = (bf16*)(lds + 2 * SHM_V);
  float* ws = (float*)(lds + 2 * SHM_V + 2 * SHM_K) + wid * 64; float* li_l = ws;
  float l_reg = 0; f32x16 o[4] = {}; bf16x8 qr[8]; f32x16 negm; for (int r = 0; r < 16; ++r) negm[r] = ATT_NEGM ? negmc : 0.f; if (ATT_NEGM) asm volatile("" : "+v"(negm));
  const bf16* Qw = Qb + (long)(wid * QBLK + r32) * LDQ + hi * 8;
#pragma unroll
  for (int d0 = 0; d0 < 8; ++d0) qr[d0] = St::ld8(Qw + d0 * 16);
  (void)t0; (void)qgain; (void)rope;
  const int sr = tid >> 4, sc = (tid & 15) * 8, vst0 = v_st(sr, sc), vst1 = v_st(32 + sr, sc);
  const int vb0 = (int)(uintptr_t)V_lds + v_rd_base(lane);
  struct { typename St::T vs0, vs1, ks0, ks1; } sr_[SDEPTH];
#define SLOAD(i, k0) do { sr_[i].vs0 = St::ld8(&Vh[(long)((k0) + sr) * LDK + sc]); sr_[i].vs1 = St::ld8(&Vh[(long)((k0) + 32 + sr) * LDK + sc]); \
    sr_[i].ks0 = St::ld8(&Kh[(long)((k0) + sr) * LDK + sc]); sr_[i].ks1 = St::ld8(&Kh[(long)((k0) + 32 + sr) * LDK + sc]); } while (0)
#define SWRITE(b, i) do { *(bf16x8*)((char*)V_lds + (b) * SHM_V + vst0) = St::tobf(sr_[i].vs0);          \
    *(bf16x8*)((char*)V_lds + (b) * SHM_V + vst1) = St::tobf(sr_[i].vs1); int kc = sc * 2;               \
    *(bf16x8*)((char*)K_lds + (b) * SHM_K + KSWZ(sr, kc)) = St::tobf(sr_[i].ks0);                       \
    *(bf16x8*)((char*)K_lds + (b) * SHM_K + KSWZ(32 + sr, kc)) = St::tobf(sr_[i].ks1); } while (0)
#define SWAIT() do { if constexpr (SDEPTH == 2) asm volatile("s_waitcnt vmcnt(4)" ::: "memory"); else asm volatile("s_waitcnt vmcnt(0)" ::: "memory"); } while (0)
  f32x16 pA0, pA1, pB0, pB1; bf16x8 pa0, pa1, pa2, pa3; const int NT = seq / KVBLK;
  constexpr int SE = 0, SO = SDEPTH - 1;
  SLOAD(SE, 0); asm volatile("s_waitcnt vmcnt(0)" ::: "memory"); SWRITE(0, SE); __syncthreads();
  qkt2(pA0, pA1, K_lds, qr, negm, r32, hi); expA(pA0, negmc);
  SLOAD(SO, KVBLK); if constexpr (SDEPTH == 2) { if (2 < NT) SLOAD(SE, 2 * KVBLK); }
  SWAIT(); SWRITE(1, SO); __syncthreads();
  for (int j = 1; j + 1 < NT; j += 2) {
    SBAR(); qkt2(pB0, pB1, (bf16*)((char*)K_lds + SHM_K), qr, negm, r32, hi); if (ATT_SB) SBAR();
    finishSM2(pA0, pA1, negmc, l_reg, pa0, pa1, pa2, pa3); SBAR();
    SLOAD(SO, (j + SDEPTH) * KVBLK); SBAR();
    pv_d0(o, vb0, pa0, pa1, pa2, pa3); SBAR(); expA(pB0, negmc); SBAR();
    __syncthreads(); SWAIT(); SWRITE(0, SE);
    __syncthreads();
    SBAR(); qkt2(pA0, pA1, K_lds, qr, negm, r32, hi); if (ATT_SB) SBAR();
    finishSM2(pB0, pB1, negmc, l_reg, pa0, pa1, pa2, pa3); SBAR();
    if (SDEPTH == 1 || j + 3 < NT) SLOAD(SE, (j + 1 + SDEPTH) * KVBLK); SBAR();
    pv_d0(o, vb0 + (int)SHM_V, pa0, pa1, pa2, pa3); SBAR(); expA(pA0, negmc); SBAR();
    __syncthreads(); SWAIT(); SWRITE(1, SO);
    __syncthreads();
  }
  SBAR(); qkt2(pB0, pB1, (bf16*)((char*)K_lds + SHM_K), qr, negm, r32, hi);
  finishSM2(pA0, pA1, negmc, l_reg, pa0, pa1, pa2, pa3); SBAR();
  pv_d0(o, vb0, pa0, pa1, pa2, pa3); expA(pB0, negmc);
  __syncthreads();
  finishSM2(pB0, pB1, negmc, l_reg, pa0, pa1, pa2, pa3); SBAR();
  pv_d0(o, vb0 + (int)SHM_V, pa0, pa1, pa2, pa3);
  { auto rr = __builtin_amdgcn_permlane32_swap(__float_as_uint(l_reg), __float_as_uint(l_reg), false, false); l_reg = __uint_as_float(rr[0]) + __uint_as_float(rr[1]); }
  if (hi == 0) li_l[r32] = l_reg; asm volatile("s_waitcnt lgkmcnt(0)" ::: "memory");
  float rli[16];
#pragma unroll
  for (int r = 0; r < 16; ++r) rli[r] = __builtin_amdgcn_rcpf(li_l[crow(r, hi)]);
  { bf16* stg = (bf16*)(lds + OST_OFF) + wid * (32 * 128);
#pragma unroll
    for (int r = 0; r < 16; ++r) { const int orow = crow(r, hi);
#pragma unroll
      for (int d0 = 0; d0 < 4; ++d0) stg[orow * 128 + d0 * 32 + r32] = __float2bfloat16(o[d0][r] * rli[r]); }
    asm volatile("s_waitcnt lgkmcnt(0)" ::: "memory");
    bf16* Ow = Ob + (long)(wid * QBLK) * LDO;
#pragma unroll
    for (int i = 0; i < 8; ++i) { const int row = i * 4 + (lane >> 4), ch = lane & 15; const u32x4 v = *(const u32x4*)(stg + row * 128 + ch * 8); *(u32x4*)(Ow + (long)row * LDO + ch * 8) = v; }
    asm volatile("s_waitcnt lgkmcnt(0)" ::: "memory"); }
  __syncthreads();
#undef SLOAD
#undef SWRITE
#undef SWAIT
}
}

#define LAS __attribute__((address_space(3)))
typedef unsigned short bf16_t;
typedef unsigned v4u __attribute__((ext_vector_type(4)));
typedef float f32x4 __attribute__((ext_vector_type(4)));
typedef float f32x16 __attribute__((ext_vector_type(16)));
typedef short bf16x8 __attribute__((ext_vector_type(8)));
typedef short s16x4 __attribute__((ext_vector_type(4)));
#define LDS_WAIT() asm volatile("s_waitcnt lgkmcnt(0)" ::: "memory")

constexpr int NWAVES = 8, NTHREADS = 512;
constexpr int DM = 1024, DFF = 2816, NQKV = 1536;
constexpr int NTOK_P = 16384, NTOK_S = 32768, NTOK = 49152, SEQ_P = 8192, SEQ_S = 4096, NB_P = 2, NB_S = 8;
constexpr float EPS = 1e-6f;
constexpr size_t MiB = 1u << 20;
constexpr size_t WS_WGU = 1 * MiB, WS_WD = 45 * MiB, WS_WQKV = 67 * MiB, WS_WO = 73 * MiB, WS_W2 = 77 * MiB, WS_A1P = 85 * MiB, WS_A1S = 89 * MiB, WS_A2 = 90 * MiB, WS_ROPE = 90 * MiB + 65536, WS_QKG = 90 * MiB + 131072;
constexpr size_t WS_POOL = 92 * MiB, WS_RSS = 476 * MiB, WS_END = 482 * MiB, WS_TS = 90 * MiB + 196608;
constexpr size_t WS_F = WS_POOL, WS_T = WS_POOL + 192 * MiB, WS_HID = WS_POOL, WS_QO = WS_POOL, WS_K = WS_POOL + 96 * MiB, WS_V = WS_POOL + 120 * MiB, WS_XH = WS_POOL + 288 * MiB;
constexpr size_t RSS_STRIDE = (size_t)49152 * 4;
constexpr int LDS_BYTES = 147456;

__device__ __forceinline__ unsigned f2bf(float f) { unsigned u = __builtin_bit_cast(unsigned, f); return (u + 0x7fffu + ((u >> 16) & 1u)) >> 16; }
__device__ __forceinline__ unsigned pk2(float lo, float hi) { return f2bf(lo) | (f2bf(hi) << 16); }
__device__ __forceinline__ float wave_sum(float v) {
#pragma unroll
    for (int o = 1; o < 64; o <<= 1) v += __shfl_xor(v, o);
    return v;
}

template <class RowMap>
__device__ __forceinline__ void transpose_item(const float* __restrict__ W, int K, int N, bf16_t* WT, int ldk, const float* __restrict__ gain, RowMap rm, LAS float* scr, int item, int lane) {
    const int nblk = N / 64, kb = item / nblk, nb = item % nblk, k0 = 64 * kb, n0 = 64 * nb;
#pragma unroll
    for (int h = 0; h < 2; ++h) {
        float v[32];
#pragma unroll
        for (int i = 0; i < 32; ++i) v[i] = W[(size_t)(k0 + 32 * h + i) * N + n0 + lane];
#pragma unroll
        for (int i = 0; i < 32; ++i) { const int kk = 32 * h + i; float x = v[i]; if (gain) x *= gain[k0 + kk]; scr[kk * 64 + (lane ^ (kk & 0x38))] = x; }
    }
    LDS_WAIT(); asm volatile("" ::: "memory");
    const int c = lane & 7;
#pragma unroll
    for (int j = 0; j < 8; ++j) { const int n = (lane >> 3) + 8 * j; const LAS float* s = scr + (8 * c) * 64 + (n ^ (8 * c));
        v4u o; o.x = pk2(s[0 * 64], s[1 * 64]); o.y = pk2(s[2 * 64], s[3 * 64]); o.z = pk2(s[4 * 64], s[5 * 64]); o.w = pk2(s[6 * 64], s[7 * 64]);
        *(v4u*)(WT + (size_t)rm(n0 + n) * ldk + k0 + 8 * c) = o; }
    LDS_WAIT(); asm volatile("" ::: "memory");
}
struct RmId { __device__ __forceinline__ int operator()(int n) const { return n; } };
struct RmGU { int off; __device__ __forceinline__ int operator()(int n) const { return ((n >> 7) << 8) + (n & 127) + off; } };

__device__ __forceinline__ void cvt_row2(const float* xa, const float* xb, bf16_t* oa, bf16_t* ob, float* ra, float* rb, int lane) {
    const f32x4* pa = (const f32x4*)xa + lane; const f32x4* pb = (const f32x4*)xb + lane;
    f32x4 va[4], vb[4]; float sa = 0.f, sb = 0.f;
#pragma unroll
    for (int j = 0; j < 4; ++j) { va[j] = pa[64 * j]; vb[j] = pb[64 * j]; }
#pragma unroll
    for (int j = 0; j < 4; ++j) { sa += (va[j].x * va[j].x + va[j].y * va[j].y) + (va[j].z * va[j].z + va[j].w * va[j].w); sb += (vb[j].x * vb[j].x + vb[j].y * vb[j].y) + (vb[j].z * vb[j].z + vb[j].w * vb[j].w); }
    unsigned long long* qa = (unsigned long long*)oa + lane; unsigned long long* qb = (unsigned long long*)ob + lane;
#pragma unroll
    for (int j = 0; j < 4; ++j) { qa[64 * j] = (unsigned long long)pk2(va[j].x, va[j].y) | ((unsigned long long)pk2(va[j].z, va[j].w) << 32); qb[64 * j] = (unsigned long long)pk2(vb[j].x, vb[j].y) | ((unsigned long long)pk2(vb[j].z, vb[j].w) << 32); }
    sa = wave_sum(sa); sb = wave_sum(sb);
    if (lane == 0) { *(f32x4*)ra = (f32x4){sa, 0.f, 0.f, 0.f}; *(f32x4*)rb = (f32x4){sb, 0.f, 0.f, 0.f}; }
}

template <int OFF> __device__ __forceinline__ s16x4 tr_read_off(unsigned vb) {
    s16x4 r; asm volatile("ds_read_b64_tr_b16 %0, %1 offset:%2" : "=&v"(r) : "v"(vb), "i"(OFF) : "memory"); return r;
}
template <int KS, int NKS> struct BLoad {
    static __device__ __forceinline__ void run(bf16x8 (&b0)[NKS], bf16x8 (&b1)[NKS], unsigned base0, unsigned base1) {
        const s16x4 l0 = tr_read_off<(16 * KS) * 128>(base0), h0 = tr_read_off<(16 * KS + 4) * 128>(base0);
        const s16x4 l1 = tr_read_off<(16 * KS) * 128>(base1), h1 = tr_read_off<(16 * KS + 4) * 128>(base1);
        asm volatile("s_waitcnt lgkmcnt(0)" ::: "memory");
        b0[KS] = (bf16x8){l0[0], l0[1], l0[2], l0[3], h0[0], h0[1], h0[2], h0[3]};
        b1[KS] = (bf16x8){l1[0], l1[1], l1[2], l1[3], h1[0], h1[1], h1[2], h1[3]};
        if constexpr (KS + 1 < NKS) BLoad<KS + 1, NKS>::run(b0, b1, base0, base1);
    }
};
template <int KT, int MT, bool SC>
__device__ __forceinline__ void fft_unit(const bf16_t* __restrict__ A, const bf16_t* __restrict__ in, size_t in_stride, bf16_t* out, size_t so1, size_t so0, char* wl, int lane, const float* rs = nullptr, size_t rs_stride = 0) {
    constexpr int NKS = KT / 16;
    const int r32 = lane & 31, hi = lane >> 5;
    { const int lr = lane >> 3, ch = lane & 7;
      v4u dv[KT / 8]; f32x4 pq[SC ? KT / 8 : 1];
#pragma unroll
      for (int i = 0; i < KT / 8; ++i) dv[i] = *(const v4u*)(in + (size_t)(i * 8 + lr) * in_stride + ch * 8);
      if constexpr (SC) {
#pragma unroll
          for (int i = 0; i < KT / 8; ++i) pq[i] = *(const f32x4*)(rs + (size_t)(i * 8 + lr) * rs_stride * 4);
      }
#pragma unroll
      for (int i = 0; i < KT / 8; ++i) { const int row = i * 8 + lr; v4u v = dv[i];
          if constexpr (SC) { const float r = __builtin_amdgcn_rsqf(((pq[i][0] + pq[i][1]) + (pq[i][2] + pq[i][3])) * (1.0f / 1024.0f) + 1e-6f);
              v.x = pg8::cvt_pk_bf16(pg8::bflo(v.x) * r, pg8::bfhi(v.x) * r); v.y = pg8::cvt_pk_bf16(pg8::bflo(v.y) * r, pg8::bfhi(v.y) * r); v.z = pg8::cvt_pk_bf16(pg8::bflo(v.z) * r, pg8::bfhi(v.z) * r); v.w = pg8::cvt_pk_bf16(pg8::bflo(v.w) * r, pg8::bfhi(v.w) * r); }
          *(v4u*)(wl + row * 128 + 16 * (ch ^ (((row >> 1) & 1) << 2))) = v; } }
    LDS_WAIT(); asm volatile("" ::: "memory");
    bf16x8 b0[NKS], b1[NKS];
    { const int blk = (lane >> 4) & 1, q = (lane & 15) >> 2, p = lane & 3, qb = (q >> 1) & 1;
      const unsigned basel = (unsigned)(uintptr_t)wl + (unsigned)((8 * hi + q) * 128 + 16 * (2 * blk + (p >> 1)) + 8 * (p & 1));
      BLoad<0, NKS>::run(b0, b1, basel + 64u * (unsigned)qb, basel + 64u * (unsigned)(1 - qb)); }
    asm volatile("" ::: "memory");
    bf16_t* stg = (bf16_t*)wl;
    bf16x8 af[NKS], an[NKS];
#pragma unroll
    for (int ks = 0; ks < NKS; ++ks) an[ks] = *(const bf16x8*)(A + (size_t)r32 * KT + 16 * ks + 8 * hi);
#pragma unroll 1
    for (int mb = 0; mb < MT / 32; ++mb) {
#pragma unroll
        for (int ks = 0; ks < NKS; ++ks) af[ks] = an[ks];
        { const int mbn = mb + 1 < MT / 32 ? mb + 1 : mb;
#pragma unroll
          for (int ks = 0; ks < NKS; ++ks) an[ks] = *(const bf16x8*)(A + (size_t)(32 * mbn + r32) * KT + 16 * ks + 8 * hi); }
        f32x16 c0 = {}, c1 = {};
#pragma unroll
        for (int ks = 0; ks < NKS; ++ks) { c0 = __builtin_amdgcn_mfma_f32_32x32x16_bf16(af[ks], b0[ks], c0, 0, 0, 0); c1 = __builtin_amdgcn_mfma_f32_32x32x16_bf16(af[ks], b1[ks], c1, 0, 0, 0); }
#pragma unroll
        for (int r = 0; r < 16; ++r) { const int orow = (r & 3) + 8 * (r >> 2) + 4 * hi; stg[orow * 64 + r32] = (bf16_t)f2bf(c0[r]); stg[orow * 64 + 32 + r32] = (bf16_t)f2bf(c1[r]); }
        LDS_WAIT(); asm volatile("" ::: "memory");
#pragma unroll
        for (int i = 0; i < 4; ++i) { const int row = i * 8 + (lane >> 3), ch = lane & 7, m = 32 * mb + row; const v4u v = *(const v4u*)(stg + row * 64 + ch * 8);
            *(v4u*)(out + (size_t)(m >> 1) * so1 + (size_t)(m & 1) * so0 + ch * 8) = v; }
        LDS_WAIT(); asm volatile("" ::: "memory");
    }
}

typedef __attribute__((address_space(1))) unsigned gu32;
#define XB_TMO      128
#define XB_XCNT(j)  (256  + 64 * (j))
#define XB_XSUB(j)  (1280 + 64 * (j))
#define XB_XGEN(j)  (2304 + 64 * (j))
#define XB_TOP      3328
#define XB_TOPGEN   3392
#define XCD_BAR_WORDS 3456
#define XB_SPIN_CAP (1u << 22)

__device__ __forceinline__ unsigned xb_ld(unsigned* p)              { return __hip_atomic_load(p, __ATOMIC_RELAXED, __HIP_MEMORY_SCOPE_AGENT); }
__device__ __forceinline__ unsigned xb_add(unsigned* p, unsigned v) { return __hip_atomic_fetch_add(p, v, __ATOMIC_RELAXED, __HIP_MEMORY_SCOPE_AGENT); }
__device__ __forceinline__ unsigned xb_xcc_id() { return (unsigned)__builtin_amdgcn_s_getreg((3 << 11) | 20) & 0xFu; }
#define XB_SPIN(cond, bar) do { unsigned _sp = 0; while (cond) { __builtin_amdgcn_s_sleep(1); \
    if ((++_sp & 255u) == 0u) { if (xb_ld(&(bar)[XB_TMO])) break; if (_sp > XB_SPIN_CAP) { atomicAdd(&(bar)[XB_TMO], 1u); break; } } } } while (0)

struct XcdBarrier {
    unsigned* bar; unsigned x;
    volatile LAS unsigned* st;
};

__device__ __forceinline__ XcdBarrier xcd_barrier_post(unsigned* bar, volatile LAS unsigned* st) {
    XcdBarrier b; b.bar = bar; b.x = xb_xcc_id(); b.st = st;
    if (threadIdx.x == 0) (void)xb_add(&bar[XB_XCNT(b.x)], 1u);
    return b;
}
__device__ __forceinline__ void xcd_barrier_complete(unsigned* bar, unsigned x, unsigned& nloc, unsigned& nx) {
    const unsigned G = gridDim.x * gridDim.y * gridDim.z;
    unsigned sum, cnt, mine, sp = 0u;
    for (;;) {
        sum = 0u; cnt = 0u; mine = 0u;
#pragma unroll
        for (unsigned j = 0; j < 16; ++j) { const unsigned c = xb_ld(&bar[XB_XCNT(j)]); sum += c; cnt += (c > 0u) ? 1u : 0u; mine = (j == x) ? c : mine; }
        if (sum == G) break;
        __builtin_amdgcn_s_sleep(1);
        if ((++sp & 255u) == 0u) { if (xb_ld(&bar[XB_TMO])) break; if (sp > XB_SPIN_CAP) { atomicAdd(&bar[XB_TMO], 1u); break; } }
    }
    nloc = mine > 0u ? mine : 1u; nx = cnt > 0u ? cnt : 1u;
}

__device__ __forceinline__ void xcd_barrier(const XcdBarrier& b) {
    asm volatile("s_waitcnt vmcnt(0)" ::: "memory");
    __syncthreads();
    if (threadIdx.x == 0) {
        unsigned* bar = b.bar;
        __builtin_amdgcn_s_waitcnt(0);
        unsigned nloc = b.st[0], nx = b.st[1];
        if (nloc == 0u) { xcd_barrier_complete(bar, b.x, nloc, nx); b.st[0] = nloc; b.st[1] = nx; }
        const unsigned old = xb_add(&bar[XB_XSUB(b.x)], 1u);
        const unsigned gen = old / nloc;
        if (old + 1u == (gen + 1u) * nloc) {
            __builtin_amdgcn_fence(__ATOMIC_RELEASE, "agent");
            asm volatile("s_waitcnt vmcnt(0)" ::: "memory");
            const unsigned og = xb_add(&bar[XB_TOP], 1u);
            const unsigned tg = og / nx;
            if (og + 1u == (tg + 1u) * nx) xb_add(&bar[XB_TOPGEN], 1u);
            else XB_SPIN(xb_ld(&bar[XB_TOPGEN]) == tg, bar);
            __builtin_amdgcn_fence(__ATOMIC_ACQUIRE, "agent");
            xb_add(&bar[XB_XGEN(b.x)], 1u);
            asm volatile("s_waitcnt vmcnt(0)" ::: "memory");
        } else {
            XB_SPIN(xb_ld(&bar[XB_XGEN(b.x)]) == gen, bar);
            __builtin_amdgcn_fence(__ATOMIC_ACQUIRE, "agent");
            asm volatile("s_waitcnt vmcnt(0)" ::: "memory");
        }
    }
    __syncthreads();
}
constexpr int NPH_C = 21;
__device__ const float CS128[256] = {1.000000000e+00f, 9.987954562e-01f, 9.951847267e-01f, 9.891765100e-01f, 9.807852804e-01f, 9.700312532e-01f, 9.569403357e-01f, 9.415440652e-01f, 9.238795325e-01f, 9.039892931e-01f, 8.819212643e-01f, 8.577286100e-01f, 8.314696123e-01f, 8.032075315e-01f, 7.730104534e-01f, 7.409511254e-01f, 7.071067812e-01f, 6.715589548e-01f, 6.343932842e-01f, 5.956993045e-01f, 5.555702330e-01f, 5.141027442e-01f, 4.713967368e-01f, 4.275550934e-01f, 3.826834324e-01f, 3.368898534e-01f, 2.902846773e-01f, 2.429801799e-01f, 1.950903220e-01f, 1.467304745e-01f, 9.801714033e-02f, 4.906767433e-02f, 6.123233996e-17f, -4.906767433e-02f, -9.801714033e-02f, -1.467304745e-01f, -1.950903220e-01f, -2.429801799e-01f, -2.902846773e-01f, -3.368898534e-01f, -3.826834324e-01f, -4.275550934e-01f, -4.713967368e-01f, -5.141027442e-01f, -5.555702330e-01f, -5.956993045e-01f, -6.343932842e-01f, -6.715589548e-01f, -7.071067812e-01f, -7.409511254e-01f, -7.730104534e-01f, -8.032075315e-01f, -8.314696123e-01f, -8.577286100e-01f, -8.819212643e-01f, -9.039892931e-01f, -9.238795325e-01f, -9.415440652e-01f, -9.569403357e-01f, -9.700312532e-01f, -9.807852804e-01f, -9.891765100e-01f, -9.951847267e-01f, -9.987954562e-01f, -1.000000000e+00f, -9.987954562e-01f, -9.951847267e-01f, -9.891765100e-01f, -9.807852804e-01f, -9.700312532e-01f, -9.569403357e-01f, -9.415440652e-01f, -9.238795325e-01f, -9.039892931e-01f, -8.819212643e-01f, -8.577286100e-01f, -8.314696123e-01f, -8.032075315e-01f, -7.730104534e-01f, -7.409511254e-01f, -7.071067812e-01f, -6.715589548e-01f, -6.343932842e-01f, -5.956993045e-01f, -5.555702330e-01f, -5.141027442e-01f, -4.713967368e-01f, -4.275550934e-01f, -3.826834324e-01f, -3.368898534e-01f, -2.902846773e-01f, -2.429801799e-01f, -1.950903220e-01f, -1.467304745e-01f, -9.801714033e-02f, -4.906767433e-02f, -1.836970199e-16f, 4.906767433e-02f, 9.801714033e-02f, 1.467304745e-01f, 1.950903220e-01f, 2.429801799e-01f, 2.902846773e-01f, 3.368898534e-01f, 3.826834324e-01f, 4.275550934e-01f, 4.713967368e-01f, 5.141027442e-01f, 5.555702330e-01f, 5.956993045e-01f, 6.343932842e-01f, 6.715589548e-01f, 7.071067812e-01f, 7.409511254e-01f, 7.730104534e-01f, 8.032075315e-01f, 8.314696123e-01f, 8.577286100e-01f, 8.819212643e-01f, 9.039892931e-01f, 9.238795325e-01f, 9.415440652e-01f, 9.569403357e-01f, 9.700312532e-01f, 9.807852804e-01f, 9.891765100e-01f, 9.951847267e-01f, 9.987954562e-01f, 0.000000000e+00f, 4.906767433e-02f, 9.801714033e-02f, 1.467304745e-01f, 1.950903220e-01f, 2.429801799e-01f, 2.902846773e-01f, 3.368898534e-01f, 3.826834324e-01f, 4.275550934e-01f, 4.713967368e-01f, 5.141027442e-01f, 5.555702330e-01f, 5.956993045e-01f, 6.343932842e-01f, 6.715589548e-01f, 7.071067812e-01f, 7.409511254e-01f, 7.730104534e-01f, 8.032075315e-01f, 8.314696123e-01f, 8.577286100e-01f, 8.819212643e-01f, 9.039892931e-01f, 9.238795325e-01f, 9.415440652e-01f, 9.569403357e-01f, 9.700312532e-01f, 9.807852804e-01f, 9.891765100e-01f, 9.951847267e-01f, 9.987954562e-01f, 1.000000000e+00f, 9.987954562e-01f, 9.951847267e-01f, 9.891765100e-01f, 9.807852804e-01f, 9.700312532e-01f, 9.569403357e-01f, 9.415440652e-01f, 9.238795325e-01f, 9.039892931e-01f, 8.819212643e-01f, 8.577286100e-01f, 8.314696123e-01f, 8.032075315e-01f, 7.730104534e-01f, 7.409511254e-01f, 7.071067812e-01f, 6.715589548e-01f, 6.343932842e-01f, 5.956993045e-01f, 5.555702330e-01f, 5.141027442e-01f, 4.713967368e-01f, 4.275550934e-01f, 3.826834324e-01f, 3.368898534e-01f, 2.902846773e-01f, 2.429801799e-01f, 1.950903220e-01f, 1.467304745e-01f, 9.801714033e-02f, 4.906767433e-02f, 1.224646799e-16f, -4.906767433e-02f, -9.801714033e-02f, -1.467304745e-01f, -1.950903220e-01f, -2.429801799e-01f, -2.902846773e-01f, -3.368898534e-01f, -3.826834324e-01f, -4.275550934e-01f, -4.713967368e-01f, -5.141027442e-01f, -5.555702330e-01f, -5.956993045e-01f, -6.343932842e-01f, -6.715589548e-01f, -7.071067812e-01f, -7.409511254e-01f, -7.730104534e-01f, -8.032075315e-01f, -8.314696123e-01f, -8.577286100e-01f, -8.819212643e-01f, -9.039892931e-01f, -9.238795325e-01f, -9.415440652e-01f, -9.569403357e-01f, -9.700312532e-01f, -9.807852804e-01f, -9.891765100e-01f, -9.951847267e-01f, -9.987954562e-01f, -1.000000000e+00f, -9.987954562e-01f, -9.951847267e-01f, -9.891765100e-01f, -9.807852804e-01f, -9.700312532e-01f, -9.569403357e-01f, -9.415440652e-01f, -9.238795325e-01f, -9.039892931e-01f, -8.819212643e-01f, -8.577286100e-01f, -8.314696123e-01f, -8.032075315e-01f, -7.730104534e-01f, -7.409511254e-01f, -7.071067812e-01f, -6.715589548e-01f, -6.343932842e-01f, -5.956993045e-01f, -5.555702330e-01f, -5.141027442e-01f, -4.713967368e-01f, -4.275550934e-01f, -3.826834324e-01f, -3.368898534e-01f, -2.902846773e-01f, -2.429801799e-01f, -1.950903220e-01f, -1.467304745e-01f, -9.801714033e-02f, -4.906767433e-02f};
struct Args { const float* in[12]; float* out; unsigned char* ws; int ph_lo, ph_hi; };

__global__ void __launch_bounds__(NTHREADS, 2) mk_fwd(Args args) {
    extern __shared__ __attribute__((aligned(16))) unsigned char lds[];
    const int G = gridDim.x; const int bx = blockIdx.x; const int vcu = (G % 8 == 0) ? (bx % 8) * (G / 8) + bx / 8 : bx;
    const int NGW = G * NWAVES;
    unsigned char* ws = args.ws; float* X = args.out;
    bf16_t* Wgu = (bf16_t*)(ws + WS_WGU); bf16_t* Wd = (bf16_t*)(ws + WS_WD); bf16_t* Wqkv = (bf16_t*)(ws + WS_WQKV); bf16_t* Wo = (bf16_t*)(ws + WS_WO); bf16_t* W2 = (bf16_t*)(ws + WS_W2);
    bf16_t* A1P = (bf16_t*)(ws + WS_A1P); bf16_t* A1S = (bf16_t*)(ws + WS_A1S); bf16_t* A2 = (bf16_t*)(ws + WS_A2); float2* ROPE = (float2*)(ws + WS_ROPE); float* QKG = (float*)(ws + WS_QKG);
    bf16_t* XB0 = (bf16_t*)args.out; bf16_t* XBH = (bf16_t*)(ws + WS_XH); float* RSS = (float*)(ws + WS_RSS); bf16_t* FB = (bf16_t*)(ws + WS_F); bf16_t* TB = (bf16_t*)(ws + WS_T); bf16_t* HID = (bf16_t*)(ws + WS_HID);
    bf16_t* QO = (bf16_t*)(ws + WS_QO); bf16_t* KB = (bf16_t*)(ws + WS_K); bf16_t* VB = (bf16_t*)(ws + WS_V);
    LAS unsigned char* ldsl = (LAS unsigned char*)lds;
    const int lo = args.ph_lo, hi = args.ph_hi;
    int ph = 0;
    volatile LAS unsigned* MISC = (volatile LAS unsigned*)(ldsl + 131072 + 8192);
    if (threadIdx.x < 64) MISC[threadIdx.x] = 0u;
    __syncthreads();
    XcdBarrier xbar = xcd_barrier_post((unsigned*)(ws + 16384), MISC + 8);
    unsigned long long* TS = (unsigned long long*)(ws + WS_TS);
    if (MK_PROBE && bx == 0 && threadIdx.x == 0) TS[0] = __builtin_amdgcn_s_memrealtime();
#define PH_BEGIN if (ph >= lo && ph < hi) { const int tid = mk_tid(), lane = tid & 63, wave = __builtin_amdgcn_readfirstlane(tid >> 6), gw = vcu * NWAVES + wave; (void)lane; (void)gw;
#define PH_END } ++ph; if (ph > lo && ph < hi) { if (ph == 1 || MK_CG_ONLY) cg::this_grid().sync(); else xcd_barrier(xbar); } if (MK_PROBE && bx == 0 && threadIdx.x == 0) TS[ph] = __builtin_amdgcn_s_memrealtime();

    PH_BEGIN
    if (EN_P0) {
        LAS float* scr = (LAS float*)(ldsl + wave * 16384);
        if (MK_PROBE2 && bx == 0 && threadIdx.x == 0) TS[40] = __builtin_amdgcn_s_memrealtime();
        constexpr int I_G = 16 * 44, I_D = 44 * 16, I_QKV = 16 * 24, I_O = 16 * 16;
        constexpr int NITEMS = 4 * (2 * I_G + I_D) + 2 * (I_QKV + I_O);
        for (int it = gw; it < NITEMS; it += NGW) {
            int r = it;
            if (r < 4 * I_G) { const int l = r / I_G; transpose_item(args.in[9] + (size_t)l * DM * DFF, DM, DFF, Wgu + (size_t)l * 2 * DFF * DM, DM, args.in[3] + l * DM, RmGU{0}, scr, r % I_G, lane); continue; } r -= 4 * I_G;
            if (r < 4 * I_G) { const int l = r / I_G; transpose_item(args.in[10] + (size_t)l * DM * DFF, DM, DFF, Wgu + (size_t)l * 2 * DFF * DM, DM, args.in[3] + l * DM, RmGU{128}, scr, r % I_G, lane); continue; } r -= 4 * I_G;
            if (r < 4 * I_D) { const int l = r / I_D; transpose_item(args.in[11] + (size_t)l * DFF * DM, DFF, DM, Wd + (size_t)l * DM * DFF, DFF, (const float*)nullptr, RmId{}, scr, r % I_D, lane); continue; } r -= 4 * I_D;
            if (r < 2 * I_QKV) { const int j = r / I_QKV; transpose_item(args.in[5] + (size_t)j * DM * NQKV, DM, NQKV, Wqkv + (size_t)j * NQKV * DM, DM, args.in[2] + (2 * j + 1) * DM, RmId{}, scr, r % I_QKV, lane); continue; } r -= 2 * I_QKV;
            { const int j = r / I_O; transpose_item(args.in[8] + (size_t)j * DM * DM, DM, DM, Wo + (size_t)j * DM * DM, DM, (const float*)nullptr, RmId{}, scr, r % I_O, lane); }
        }
        if (MK_PROBE2) { __syncthreads(); if (bx == 0 && threadIdx.x == 0) TS[41] = __builtin_amdgcn_s_memrealtime(); }
        {
          for (int task = gw; task < 2048; task += NGW) {
              const int nb = task & 15, cc = (task >> 4) & 3, g = (task >> 6) & 7, p = (task >> 9) & 1, j = task >> 10;
              const int n = nb * 64 + lane; const float* w = args.in[4] + (size_t)j * DM * DM + (size_t)(g * 128) * DM + n; const float* tb = CS128 + p * 128;
              float acc[32];
#pragma unroll
              for (int ci = 0; ci < 32; ++ci) acc[ci] = 0.f;
              for (int jp0 = 0; jp0 < 128; jp0 += 8) { float wv[8];
#pragma unroll
                  for (int d = 0; d < 8; ++d) wv[d] = w[(size_t)(jp0 + d) * DM];
#pragma unroll
                  for (int d = 0; d < 8; ++d)
#pragma unroll
                      for (int ci = 0; ci < 32; ++ci) acc[ci] += tb[((cc * 32 + ci) * (jp0 + d)) & 127] * wv[d]; }
              const float* gain = args.in[2] + (2 * j) * DM + g * 128 + cc * 32;
              bf16_t* dst = W2 + (size_t)j * DM * 2048 + (size_t)n * 2048 + p * 1024 + g * 128 + cc * 32;
#pragma unroll
              for (int q4 = 0; q4 < 4; ++q4) { v4u o; const float sc = 0.08838834764831845f;
                  o.x = pk2(acc[8 * q4 + 0] * gain[8 * q4 + 0] * sc, acc[8 * q4 + 1] * gain[8 * q4 + 1] * sc); o.y = pk2(acc[8 * q4 + 2] * gain[8 * q4 + 2] * sc, acc[8 * q4 + 3] * gain[8 * q4 + 3] * sc);
                  o.z = pk2(acc[8 * q4 + 4] * gain[8 * q4 + 4] * sc, acc[8 * q4 + 5] * gain[8 * q4 + 5] * sc); o.w = pk2(acc[8 * q4 + 6] * gain[8 * q4 + 6] * sc, acc[8 * q4 + 7] * gain[8 * q4 + 7] * sc);
                  *(v4u*)(dst + 8 * q4) = o; }
          }
          LDS_WAIT(); asm volatile("" ::: "memory");
        }
        if (MK_PROBE2) { __syncthreads(); if (bx == 0 && threadIdx.x == 0) TS[42] = __builtin_amdgcn_s_memrealtime(); }
        { const int gt = gw * 64 + lane, NGT = NGW * 64;
          for (int e2 = gt; e2 < 64 * 256 * 64; e2 += NGT) {
              const int s1 = (e2 & 63) * 2, m = (e2 >> 6) & 255, s2 = e2 >> 14, k1 = m >> 1, pp = m & 1; float v[2];
#pragma unroll
              for (int d = 0; d < 2; ++d) { const int s = 64 * (s1 + d) + s2, r = (k1 * s) & 8191; const float x = (float)r * (1.0f / 4096.0f); v[d] = (pp ? -sinpif(x) : cospif(x)) * 0.08838834764831845f; }
              ((unsigned*)A1P)[e2] = pk2(v[0], v[1]); }
          for (int e2 = gt; e2 < 64 * 128 * 32; e2 += NGT) {
              const int s1 = (e2 & 31) * 2, m = (e2 >> 5) & 127, s2 = e2 >> 12, k1 = m >> 1, pp = m & 1; float v[2];
#pragma unroll
              for (int d = 0; d < 2; ++d) { const int s = 64 * (s1 + d) + s2, r = (k1 * s) & 4095; const float x = (float)r * (1.0f / 2048.0f); v[d] = (pp ? -sinpif(x) : cospif(x)) * 0.125f; }
              ((unsigned*)A1S)[e2] = pk2(v[0], v[1]); }
          for (int e2 = gt; e2 < 128 * 64; e2 += NGT) {
              const int k = (e2 & 63) * 2, m = e2 >> 6, k2 = m >> 1, pp = m & 1, p = k >> 6; float v[2];
#pragma unroll
              for (int d = 0; d < 2; ++d) { const int s2 = (k + d) & 63, r = (k2 * s2) & 63; const float x = (float)r * (1.0f / 32.0f); const float c = cospif(x), s = sinpif(x);
                  v[d] = (pp == 0 ? (p == 0 ? c : s) : (p == 0 ? -s : c)) * 0.125f; }
              ((unsigned*)A2)[e2] = pk2(v[0], v[1]); }
          if (gw == 0) {
#pragma unroll
              for (int j2 = 0; j2 < 2; ++j2) { float mq = fmaxf(fabsf(args.in[6][j2 * 128 + lane]), fabsf(args.in[6][j2 * 128 + 64 + lane])), mk = fmaxf(fabsf(args.in[7][j2 * 128 + lane]), fabsf(args.in[7][j2 * 128 + 64 + lane]));
#pragma unroll
                  for (int o = 1; o < 64; o <<= 1) { mq = fmaxf(mq, __shfl_xor(mq, o)); mk = fmaxf(mk, __shfl_xor(mk, o)); }
                  if (lane == 0) QKG[512 + j2] = -(128.0f * 1.02f * mq * mk) * (att::SCALE * 1.4426950408889634f); }
          }
          for (int e = gt; e < 512; e += NGT) { const int j = e >> 8, r = e & 255; QKG[e] = r < 128 ? args.in[6][j * 128 + r] : args.in[7][j * 128 + r - 128]; }
          for (int e = gt; e < 128 * 32; e += NGT) { const int i = e & 31, pos = e >> 5; const float inv = powf(10000.0f, -(float)i * (1.0f / 32.0f)); const float a = (float)pos * inv; ROPE[e] = make_float2(cosf(a), sinf(a)); }
        }
        if (MK_PROBE2) { __syncthreads(); if (bx == 0 && threadIdx.x == 0) TS[43] = __builtin_amdgcn_s_memrealtime(); }
        for (int m = 2 * gw; m < NTOK; m += 2 * NGW) { const float* src = m < NTOK_P ? args.in[0] + (size_t)m * DM : args.in[1] + (size_t)(m - NTOK_P) * DM; cvt_row2(src, src + DM, XB0 + (size_t)m * DM, XB0 + (size_t)(m + 1) * DM, RSS + (size_t)m * 4, RSS + (size_t)(m + 1) * 4, lane); }
    }
    PH_END

    for (int layer = 0; layer < 4; ++layer) {
        const int jj = layer >> 1;
        const float* rss_mix = RSS + (size_t)(2 * layer) * RSS_STRIDE;
        float* rss_ffn = RSS + (size_t)(2 * layer + 1) * RSS_STRIDE;
        float* rss_next = RSS + (size_t)(2 * layer + 2) * RSS_STRIDE;
        bf16_t* XBF = layer == 3 ? XBH : XB0;
        PG8_LAS float* Pscr = (PG8_LAS float*)(ldsl + 131072);
        if ((layer & 1) == 0) {
            PH_BEGIN
            if (EN_FFT) {
                char* wl = (char*)lds + wave * 16384;
                for (int u = gw; u < 2048; u += NGW) { const int cb = u & 15, s2 = (u >> 4) & 63, b = u >> 10; const size_t tok = (size_t)b * SEQ_P + s2;
                    fft_unit<128, 256, true>(A1P + (size_t)s2 * 256 * 128, XB0 + tok * DM + cb * 64, (size_t)64 * DM, TB + ((size_t)b * 2 * SEQ_P + s2) * DM + cb * 64, (size_t)2 * 64 * DM, (size_t)64 * DM, wl, lane, rss_mix + tok * 4, (size_t)64); }
                for (int u = gw; u < 8192; u += NGW) { const int cb = u & 15, s2 = (u >> 4) & 63, b = u >> 10; const size_t tok = (size_t)NTOK_P + (size_t)b * SEQ_S + s2;
                    fft_unit<64, 128, true>(A1S + (size_t)s2 * 128 * 64, XB0 + tok * DM + cb * 64, (size_t)64 * DM, TB + ((size_t)2 * NTOK_P + (size_t)b * 2 * SEQ_S + s2) * DM + cb * 64, (size_t)2 * 64 * DM, (size_t)64 * DM, wl, lane, rss_mix + tok * 4, (size_t)64); }
            }
            PH_END
            PH_BEGIN
            if (EN_FFT) {
                char* wl = (char*)lds + wave * 16384;
                for (int u = gw; u < 4096 + 8192; u += NGW) {
                    const bool P = u < 4096; const int v = P ? u : u - 4096; const int cb = v & 15; const int k1 = P ? ((v >> 4) & 127) : ((v >> 4) & 63); const int b = P ? (v >> 11) : (v >> 10);
                    const size_t trow = P ? ((size_t)b * 2 * SEQ_P + (size_t)k1 * 128) : ((size_t)2 * NTOK_P + (size_t)b * 2 * SEQ_S + (size_t)k1 * 128);
                    const size_t frow = P ? ((size_t)b * SEQ_P + k1) : ((size_t)NTOK_P + (size_t)b * SEQ_S + k1);
                    fft_unit<128, 128, false>(A2, TB + trow * DM + cb * 64, (size_t)DM, FB + frow * 2048 + cb * 64, P ? (size_t)128 * 2048 : (size_t)64 * 2048, (size_t)1024, wl, lane);
                }
            }
            PH_END
        } else {
            PH_BEGIN
            if (EN_QKV) {
                pg8::Gemm g{XB0, Wqkv + (size_t)jj * NQKV * DM, NTOK, NQKV, DM}; pg8::StaticOrder S; S.init(NTOK, NQKV, G, bx);
                pg8::EpiQKV E{QO, KB, VB, rss_mix, QKG + jj * 256, (const float*)ROPE, (PG8_LAS float*)(ldsl + 131072), att::SCALE * 1.4426950408889634f};
                pg8::gemm_phase<pg8::EpiQKV, pg8::StaticOrder, GU_ALIGN, GEMM_SP2>(ldsl, g, S, E);
            }
            PH_END
            PH_BEGIN
            if (EN_ATT) {
                const float* qg = QKG + jj * 256; const float negmc = QKG[512 + jj];
                for (int j = vcu; j < 1536; j += G) {
                    int b, h, qb, tok0, seq;
                    if (j < 512) { const int bh = j >> 5; qb = j & 31; b = bh >> 3; h = bh & 7; tok0 = b * SEQ_P; seq = SEQ_P; }
                    else { const int v = j - 512, bh = v >> 4; qb = v & 15; b = bh >> 3; h = bh & 7; tok0 = NTOK_P + b * SEQ_S; seq = SEQ_S; }
                    const att::bf16* Qb = (const att::bf16*)QO + ((size_t)tok0 + qb * 256) * 1024 + h * 128;
                    const att::bf16* Kh = (const att::bf16*)KB + (size_t)tok0 * 256 + (h >> 2) * 128;
                    const att::bf16* Vh = (const att::bf16*)VB + (size_t)tok0 * 256 + (h >> 2) * 128;
                    att::attn_unit(Qb, Kh, Vh, (att::bf16*)Qb, seq, qb * 256, qg, ROPE, negmc, (char*)lds);
                }
            }
            PH_END
        }
        PH_BEGIN
        if (EN_RES) {
            pg8::Gemm g = (layer & 1) ? pg8::Gemm{QO, Wo + (size_t)jj * DM * DM, NTOK, DM, DM} : pg8::Gemm{FB, W2 + (size_t)jj * DM * 2048, NTOK, DM, 2048};
            pg8::StaticOrder S; S.init(NTOK, DM, G, bx); pg8::EpiResB E{XB0, XBF, (float*)nullptr, rss_ffn, Pscr};
            pg8::gemm_phase<pg8::EpiResB, pg8::StaticOrder, true, GEMM_SP2>(ldsl, g, S, E);
        }
        PH_END
        PH_BEGIN
        if (EN_GU) {
            if (MK_SLEEP_US) { const unsigned long long t0 = __builtin_amdgcn_s_memrealtime(); while (__builtin_amdgcn_s_memrealtime() - t0 < 100ull * MK_SLEEP_US) __builtin_amdgcn_s_sleep(64); }
            pg8::Gemm g{XBF, Wgu + (size_t)layer * 2 * DFF * DM, NTOK, 2 * DFF, DM}; pg8::StaticOrder S; S.init(NTOK, 2 * DFF, G, bx);
            pg8::EpiSwiGLU E{HID, DFF, rss_ffn};
            pg8::gemm_phase<pg8::EpiSwiGLU, pg8::StaticOrder, GU_ALIGN, GEMM_SP2>(ldsl, g, S, E);
        }
        PH_END
        PH_BEGIN
        if (EN_RES) {
            pg8::Gemm g{HID, Wd + (size_t)layer * DM * DFF, NTOK, DM, DFF}; pg8::StaticOrder S; S.init(NTOK, DM, G, bx); S.rev = MK_DREV;
            pg8::EpiResB E{XBF, XB0, layer == 3 ? X : (float*)nullptr, layer == 3 ? (float*)nullptr : rss_next, Pscr};
            pg8::gemm_phase<pg8::EpiResB, pg8::StaticOrder, true, GEMM_SP2>(ldsl, g, S, E);
        }
        PH_END
    }
#undef PH_BEGIN
#undef PH_END
    for (int i = 0; i < MK_EXTRA_SYNC; ++i) cg::this_grid().sync();
    if (MK_PROBE && bx == 0 && threadIdx.x == 0) {
        unsigned long long sa = 0, sb = 0; const unsigned long long tot = TS[NPH_C] - TS[0];
        for (int i = 0; i < NPH_C; ++i) { const unsigned long long d = TS[i + 1] - TS[i]; if ((MK_MASK_A >> i) & 1u) sa += d; if ((MK_MASK_B >> i) & 1u) sb += d; }
        if (MK_PROBE2) { unsigned long long q[5] = {TS[40], TS[41], TS[42], TS[43], TS[1]}; sa = q[MK_PA + 1] - q[MK_PA]; sb = q[MK_PB + 1] - q[MK_PB]; sa *= 10; sb *= 10; }
        const unsigned long long pa = (sa * 100 + tot / 2) / tot, pb = (sb * 100 + tot / 2) / tot;
        const unsigned long long D = 2000ull * (pa * 100 + pb);
        while (__builtin_amdgcn_s_memrealtime() - TS[NPH_C] < D) __builtin_amdgcn_s_sleep(32);
    }
}
constexpr int NPHASES = NPH_C;

extern "C" void kernel_launch(void* const* d_in, const int* in_sizes, int n_in, void* d_out, int out_size, void* d_ws, size_t ws_size, hipStream_t stream) {
    static int grid = 0;
    if (grid == 0) {
        if (n_in != 12 || out_size != NTOK * DM || ws_size < WS_END) { fprintf(stderr, "kernel_launch: unexpected shapes: n_in %d out %d ws %zu (need %zu)\n", n_in, out_size, ws_size, (size_t)WS_END); grid = -1; return; }
        int dev = 0, cus = 0, per_cu = 0;
        hipGetDevice(&dev); hipDeviceGetAttribute(&cus, hipDeviceAttributeMultiprocessorCount, dev);
        if (hipFuncSetAttribute((const void*)mk_fwd, hipFuncAttributeMaxDynamicSharedMemorySize, LDS_BYTES) != hipSuccess) { fprintf(stderr, "kernel_launch: hipFuncSetAttribute failed\n"); grid = -1; return; }
        if (hipOccupancyMaxActiveBlocksPerMultiprocessor(&per_cu, (const void*)mk_fwd, NTHREADS, LDS_BYTES) != hipSuccess || per_cu < 1) { fprintf(stderr, "kernel_launch: occupancy query gave %d\n", per_cu); per_cu = 1; }
        (void)hipGetLastError();
        grid = cus * per_cu;
        fprintf(stderr, "kernel_launch: grid %d (cus %d x %d)\n", grid, cus, per_cu);
    }
    if (grid < 0) return;
    if (hipMemsetAsync(d_ws, 0, 65536, stream) != hipSuccess) { fprintf(stderr, "kernel_launch: memset failed\n"); return; }
    Args a{};
    for (int i = 0; i < 12; ++i) a.in[i] = (const float*)d_in[i];
    a.out = (float*)d_out; a.ws = (unsigned char*)d_ws;
#if MK_ONE_LAUNCH
    a.ph_lo = 0; a.ph_hi = NPHASES;
    void* kargs[] = {&a};
    hipError_t e = hipLaunchCooperativeKernel((const void*)mk_fwd, dim3(grid), dim3(NTHREADS), kargs, LDS_BYTES, stream);
    if (e != hipSuccess) fprintf(stderr, "kernel_launch: cooperative launch failed: %s (grid %d)\n", hipGetErrorString(e), grid);
#else
    for (int p = 0; p < NPHASES; ++p) { a.ph_lo = p; a.ph_hi = p + 1; hipLaunchKernelGGL(mk_fwd, dim3(grid), dim3(NTHREADS), LDS_BYTES, stream, a); }
    hipError_t e = hipPeekAtLastError();
    if (e != hipSuccess) fprintf(stderr, "kernel_launch: launch failed: %s\n", hipGetErrorString(e));
#endif
}
```

```cpp
#include <hip/hip_runtime.h>
#define ATT_SDEPTH 1
#define ATT_NEGM 1
#include <hip/hip_bf16.h>
#include <hip/hip_cooperative_groups.h>
#include <cstdio>
#include <cstdint>
namespace cg = cooperative_groups;

#ifndef EN_P0
#define EN_P0 1
#endif
#ifndef EN_FFT
#define EN_FFT 1
#endif
#ifndef EN_QKV
#define EN_QKV 1
#endif
#ifndef EN_MISC
#define EN_MISC 1
#endif
#ifndef EN_ATT
#define EN_ATT 1
#endif
#ifndef EN_RES
#define EN_RES 1
#endif
#ifndef EN_GU
#define EN_GU 1
#endif
#ifndef MK_PROBE
#define MK_PROBE 0
#endif
#ifndef MK_MASK_A
#define MK_MASK_A 0u
#endif
#ifndef MK_MASK_B
#define MK_MASK_B 0u
#endif
#ifndef MK_SLEEP_US
#define MK_SLEEP_US 0
#endif
#ifndef MK_EXTRA_SYNC
#define MK_EXTRA_SYNC 0
#endif
#ifndef MK_CG_ONLY
#define MK_CG_ONLY 0
#endif
#ifndef ATT_SDEPTH
#define ATT_SDEPTH 2
#endif
#ifndef ATT_SB
#define ATT_SB 0
#endif
#ifndef ATT_NEGM
#define ATT_NEGM 0
#endif
#ifndef GU_ALIGN
#define GU_ALIGN true
#endif
#ifndef GEMM_SP2
#define GEMM_SP2 true
#endif
#ifndef MK_PROBE2
#define MK_PROBE2 0
#endif
#ifndef MK_PA
#define MK_PA 0
#endif
#ifndef MK_PB
#define MK_PB 1
#endif
#ifndef MK_DREV
#define MK_DREV 1
#endif
#ifndef MK_ONE_LAUNCH
#define MK_ONE_LAUNCH 1
#endif

__device__ __forceinline__ int mk_tid() { int t = threadIdx.x; asm volatile("" : "+v"(t)); return t; }
namespace pg8 {
#define PG8_LAS __attribute__((address_space(3)))
typedef unsigned short bf16_t;
typedef short bf16x8 __attribute__((ext_vector_type(8)));
typedef float f32x4 __attribute__((ext_vector_type(4)));
typedef unsigned u32x4 __attribute__((ext_vector_type(4)));
constexpr int BM = 256, BK = 64, HALF = 128, HTB = HALF * BK * 2  , STAGE_BYTES = 8 * HTB, NXCD = 8, WGM = 8;

__host__ __device__ __forceinline__ int lds_byte(int r, int c) { const int st = (r >> 4) * 2 + (c >> 5), rr = r & 15, cc = c & 31, ob = rr * 64 + cc * 2; return st * 1024 + (ob ^ (((ob >> 9) & 1) << 5)); }
__host__ __device__ __forceinline__ void stage_rc(int b, int& R, int& C) { const int st = b / 1024, sb = b % 1024, swz = sb ^ (((sb >> 9) & 1) << 5); R = (st >> 1) * 16 + swz / 64; C = (st & 1) * 32 + (swz % 64) / 2; }
__host__ __device__ __forceinline__ int perm32(int rho) { const int n = rho >> 4, i = rho & 15; return 8 * (i >> 2) + 4 * n + (i & 3); }

struct Unit { int pm, pn; };
struct Gemm { const bf16_t* A; const bf16_t* Bt; int M, N, K; };

struct StaticOrder {
    int nM, nN, nwg, G, c, rev;
    __host__ __device__ void init(int M, int N, int G_, int c_) { nM = M / BM; nN = N / BM; nwg = nM * nN; G = G_; c = c_; rev = 0; }
    __host__ __device__ bool next(int i, Unit& u) const {
        const long L = (long)i * G + c; if (L >= nwg) return false;
        int wgid = (int)L; { const int q = nwg / NXCD, r = nwg % NXCD, xcd = wgid % NXCD, off = wgid / NXCD; wgid = (xcd < r ? xcd * (q + 1) : r * (q + 1) + (xcd - r) * q) + off; }
        const int nig = WGM * nN, gid = wgid / nig, fm = gid * WGM, gsz = (nM - fm) < WGM ? (nM - fm) : WGM;
        u.pm = fm + ((wgid % nig) % gsz); u.pn = (wgid % nig) / gsz; if (rev) u.pm = nM - 1 - u.pm; return true;
    }
    __device__ __forceinline__ void a_ready(const Unit&) const {}
    __device__ __forceinline__ void done(const Unit&) const {}
};

__device__ __forceinline__ unsigned cvt_pk_bf16(float lo, float hi) { unsigned r; asm volatile("v_cvt_pk_bf16_f32 %0, %1, %2" : "=v"(r) : "v"(lo), "v"(hi)); return r; }
typedef float f32x2 __attribute__((ext_vector_type(2)));
typedef float f32x2 __attribute__((ext_vector_type(2)));

__device__ __forceinline__ float bflo(unsigned w) { return __uint_as_float(w << 16); }
__device__ __forceinline__ float bfhi(unsigned w) { return __uint_as_float(w & 0xffff0000u); }
__device__ __forceinline__ float rstd_of(const float* rssp, size_t row) { const f32x4 p = *(const f32x4*)(rssp + row * 4); return __builtin_amdgcn_rsqf(((p[0] + p[1]) + (p[2] + p[3])) * (1.0f / 1024.0f) + 1e-6f); }
struct EpiResB {
    static constexpr bool PERM = true, AFTER_DRAIN = false;
    const bf16_t* xin; bf16_t* xout; float* fout; float* rssp; PG8_LAS float* P;
    __device__ __forceinline__ void operator()(const f32x4 (&acc)[2][2][4][2], const Unit& u, int wr, int wc, int fr, int fq) const {
        const int row0 = u.pm * BM + wr * 64 + fr, col0 = u.pn * BM + wc * 32 + 8 * fq;
#pragma unroll
        for (int ai = 0; ai < 2; ++ai) {
            u32x4 xo[4][2];
#pragma unroll
            for (int m = 0; m < 4; ++m)
#pragma unroll
                for (int bj = 0; bj < 2; ++bj) xo[m][bj] = *(const u32x4*)(xin + (size_t)(row0 + ai * HALF + m * 16) * 1024 + col0 + bj * HALF);
#pragma unroll
            for (int m = 0; m < 4; ++m) {
                const size_t roff = (size_t)(row0 + ai * HALF + m * 16) * 1024 + col0; float ss = 0.f;
#pragma unroll
                for (int bj = 0; bj < 2; ++bj) {
                    const u32x4 w = xo[m][bj]; const f32x4 a0 = acc[ai][bj][m][0], a1 = acc[ai][bj][m][1]; f32x4 v0, v1;
                    v0[0] = bflo(w.x) + a0[0]; v0[1] = bfhi(w.x) + a0[1]; v0[2] = bflo(w.y) + a0[2]; v0[3] = bfhi(w.y) + a0[3];
                    v1[0] = bflo(w.z) + a1[0]; v1[1] = bfhi(w.z) + a1[1]; v1[2] = bflo(w.w) + a1[2]; v1[3] = bfhi(w.w) + a1[3];
                    ss += (v0[0] * v0[0] + v0[1] * v0[1]) + (v0[2] * v0[2] + v0[3] * v0[3]) + (v1[0] * v1[0] + v1[1] * v1[1]) + (v1[2] * v1[2] + v1[3] * v1[3]);
                    if (fout) { *(f32x4*)(fout + roff + bj * HALF) = v0; *(f32x4*)(fout + roff + bj * HALF + 4) = v1; }
                    else { u32x4 o; o.x = cvt_pk_bf16(v0[0], v0[1]); o.y = cvt_pk_bf16(v0[2], v0[3]); o.z = cvt_pk_bf16(v1[0], v1[1]); o.w = cvt_pk_bf16(v1[2], v1[3]); *(u32x4*)(xout + roff + bj * HALF) = o; }
                }
                if (rssp) { ss += __shfl_xor(ss, 16); ss += __shfl_xor(ss, 32); if (fq == 0) P[(ai * HALF + wr * 64 + m * 16 + fr) * 4 + wc] = ss; }
            }
        }
        if (rssp) {
            asm volatile("s_waitcnt lgkmcnt(0)" ::: "memory"); __builtin_amdgcn_s_barrier(); asm volatile("" ::: "memory");
            const int t = (wr * 4 + wc) * 64 + fq * 16 + fr;
            if (t < 256) { const f32x4 p = *((const PG8_LAS f32x4*)P + t); rssp[(size_t)(u.pm * BM + t) * 4 + u.pn] = (p[0] + p[1]) + (p[2] + p[3]); }
        }
    }
};
__device__ __forceinline__ float silu_mul(float g, float u) { return g * u * __builtin_amdgcn_rcpf(1.0f + __builtin_amdgcn_exp2f(-1.4426950408889634f * g)); }
struct EpiSwiGLU {
    static constexpr bool PERM = true, AFTER_DRAIN = false;
    bf16_t* H; int ldh; const float* rssp;
    __device__ __forceinline__ void operator()(const f32x4 (&acc)[2][2][4][2], const Unit& u, int wr, int wc, int fr, int fq) const {
        const int row0 = u.pm * BM + wr * 64 + fr, col0 = u.pn * HALF + wc * 32 + 8 * fq;
        f32x4 pp[2][4];
#pragma unroll
        for (int ai = 0; ai < 2; ++ai)
#pragma unroll
            for (int m = 0; m < 4; ++m) pp[ai][m] = *(const f32x4*)(rssp + (size_t)(row0 + ai * HALF + m * 16) * 4);
#pragma unroll
        for (int ai = 0; ai < 2; ++ai)
#pragma unroll
            for (int m = 0; m < 4; ++m) { const int row = row0 + ai * HALF + m * 16; bf16_t* rowp = H + (size_t)row * ldh + col0; const f32x4 p = pp[ai][m]; const float rs = __builtin_amdgcn_rsqf(((p[0] + p[1]) + (p[2] + p[3])) * (1.0f / 1024.0f) + 1e-6f);
                const f32x4 g0 = acc[ai][0][m][0] * rs, g1 = acc[ai][0][m][1] * rs, u0 = acc[ai][1][m][0] * rs, u1 = acc[ai][1][m][1] * rs;
                u32x4 w;
                w.x = cvt_pk_bf16(silu_mul(g0[0], u0[0]), silu_mul(g0[1], u0[1])); w.y = cvt_pk_bf16(silu_mul(g0[2], u0[2]), silu_mul(g0[3], u0[3]));
                w.z = cvt_pk_bf16(silu_mul(g1[0], u1[0]), silu_mul(g1[1], u1[1])); w.w = cvt_pk_bf16(silu_mul(g1[2], u1[2]), silu_mul(g1[3], u1[3]));
                *(u32x4*)rowp = w; }
    }
};
struct EpiQKV {
    static constexpr bool PERM = true, AFTER_DRAIN = false;
    bf16_t *Q, *K, *V; const float* rssp;
    const float* qkg;
    const float* rope;
    PG8_LAS float* P2;
    float qscale;
    __device__ __forceinline__ void operator()(const f32x4 (&acc)[2][2][4][2], const Unit& u, int wr, int wc, int fr, int fq) const {
        const int row0 = u.pm * BM + wr * 64 + fr;
        bf16_t* base = u.pn < 4 ? Q + u.pn * BM : (u.pn == 4 ? K : V); const int ldc = u.pn < 4 ? 1024 : 256;
        const int col0 = wc * 32 + 8 * fq;
        f32x4 pp[2][4]; float rs[2][4];
#pragma unroll
        for (int ai = 0; ai < 2; ++ai)
#pragma unroll
            for (int m = 0; m < 4; ++m) pp[ai][m] = *(const f32x4*)(rssp + (size_t)(row0 + ai * HALF + m * 16) * 4);
#pragma unroll
        for (int ai = 0; ai < 2; ++ai)
#pragma unroll
            for (int m = 0; m < 4; ++m) { const f32x4 p = pp[ai][m]; rs[ai][m] = __builtin_amdgcn_rsqf(((p[0] + p[1]) + (p[2] + p[3])) * (1.0f / 1024.0f) + 1e-6f); }
        if (u.pn == 5) {
#pragma unroll
            for (int ai = 0; ai < 2; ++ai)
#pragma unroll
                for (int m = 0; m < 4; ++m) { bf16_t* rowp = base + (size_t)(row0 + ai * HALF + m * 16) * ldc + col0;
#pragma unroll
                    for (int bj = 0; bj < 2; ++bj) { const f32x4 v0 = acc[ai][bj][m][0] * rs[ai][m], v1 = acc[ai][bj][m][1] * rs[ai][m]; u32x4 w;
                        w.x = cvt_pk_bf16(v0[0], v0[1]); w.y = cvt_pk_bf16(v0[2], v0[3]); w.z = cvt_pk_bf16(v1[0], v1[1]); w.w = cvt_pk_bf16(v1[2], v1[3]);
                        *(u32x4*)(rowp + bj * HALF) = w; } }
            return;
        }
#pragma unroll
        for (int ai = 0; ai < 2; ++ai)
#pragma unroll
            for (int m = 0; m < 4; ++m)
#pragma unroll
                for (int bj = 0; bj < 2; ++bj) { const f32x4 v0 = acc[ai][bj][m][0] * rs[ai][m], v1 = acc[ai][bj][m][1] * rs[ai][m];
                    float ss = (v0[0] * v0[0] + v0[1] * v0[1]) + (v0[2] * v0[2] + v0[3] * v0[3]) + (v1[0] * v1[0] + v1[1] * v1[1]) + (v1[2] * v1[2] + v1[3] * v1[3]);
                    ss += __shfl_xor(ss, 16); ss += __shfl_xor(ss, 32);
                    if (fq == 0) P2[((ai * HALF + wr * 64 + m * 16 + fr) * 2 + bj) * 4 + wc] = ss; }
        asm volatile("s_waitcnt lgkmcnt(0)" ::: "memory"); __builtin_amdgcn_s_barrier(); asm volatile("" ::: "memory");
        const float* gp = qkg + (u.pn == 4 ? 128 : 0) + col0; const float hs = u.pn == 4 ? 1.0f : qscale;
        const f32x4 g0 = *(const f32x4*)gp * hs, g1 = *(const f32x4*)(gp + 4) * hs;
        const int ib = 16 * (wc & 1) + 4 * fq;
#pragma unroll
        for (int ai = 0; ai < 2; ++ai)
#pragma unroll
            for (int m = 0; m < 4; ++m) { const int row = row0 + ai * HALF + m * 16; bf16_t* rowp = base + (size_t)row * ldc + col0;
                const int t = row < 16384 ? (row & 8191) : ((row - 16384) & 4095); const int pos = wc < 2 ? (t >> 6) : (t & 63);
                const f32x4 cs0 = *(const f32x4*)(rope + (size_t)(pos * 32 + ib) * 2), cs1 = *(const f32x4*)(rope + (size_t)(pos * 32 + ib + 2) * 2);
#pragma unroll
                for (int bj = 0; bj < 2; ++bj) { const f32x4 pr = *((const PG8_LAS f32x4*)P2 + ((ai * HALF + wr * 64 + m * 16 + fr) * 2 + bj));
                    const float rk = rs[ai][m] * __builtin_amdgcn_rsqf(((pr[0] + pr[1]) + (pr[2] + pr[3])) * (1.0f / 128.0f) + 1e-6f);
                    const f32x4 y0 = acc[ai][bj][m][0] * rk * g0, y1 = acc[ai][bj][m][1] * rk * g1; u32x4 w;
                    w.x = cvt_pk_bf16(y0[0] * cs0[0] - y0[1] * cs0[1], y0[0] * cs0[1] + y0[1] * cs0[0]); w.y = cvt_pk_bf16(y0[2] * cs0[2] - y0[3] * cs0[3], y0[2] * cs0[3] + y0[3] * cs0[2]);
                    w.z = cvt_pk_bf16(y1[0] * cs1[0] - y1[1] * cs1[1], y1[0] * cs1[1] + y1[1] * cs1[0]); w.w = cvt_pk_bf16(y1[2] * cs1[2] - y1[3] * cs1[3], y1[2] * cs1[3] + y1[3] * cs1[2]);
                    *(u32x4*)(rowp + bj * HALF) = w; } }
    }
};
template <class Epi, class Sched, bool ALIGN_EPI = false, bool SP2 = false>
__device__ __forceinline__ void gemm_phase(PG8_LAS unsigned char* lds, const Gemm g, const Sched& S, const Epi& E) {
    const int tid = mk_tid(), wid = __builtin_amdgcn_readfirstlane(tid >> 6), lane = tid & 63, wr = wid >> 2, wc = wid & 3, fr = lane & 15, fq = lane >> 4;
    const int K = g.K, nt = K / BK;
    unsigned voffA[2], voffB[2];
#pragma unroll
    for (int i = 0; i < 2; ++i) { int R, C; stage_rc(tid * 16 + i * 8192, R, C); const int Rb = Epi::PERM ? ((R & ~31) + perm32(R & 31)) : R;
        voffA[i] = (unsigned)(R * K + C) * 2u; voffB[i] = (unsigned)(Rb * K + C) * 2u; }
    const size_t kstep = (size_t)(BK * 2);
    const size_t hstep = (size_t)HALF * K * 2;
    const size_t tstep = 2 * hstep;
    const unsigned ldsw = (unsigned)wid * 1024u;
    const int aoff = lds_byte(wr * 64 + fr, fq * 8), boff = lds_byte(wc * 32 + fr, fq * 8);
#define PG8_SA(b, h) (((b) * 2 + (h)) * HTB)
#define PG8_SB(b, h) ((4 + (b) * 2 + (h)) * HTB)
#define PG8_STAGE(bufoff, gbase, voff) do { _Pragma("unroll") for (int _i = 0; _i < 2; ++_i) \
        __builtin_amdgcn_global_load_lds((const unsigned*)((const char*)(gbase) + (voff)[_i]), (PG8_LAS unsigned*)(lds + (bufoff) + ldsw + _i * 8192), 16, 0, 0); } while (0)
#define PG8_LDA(dst, b, h) do { _Pragma("unroll") for (int m = 0; m < 4; ++m) _Pragma("unroll") for (int k = 0; k < 2; ++k) dst[m][k] = *(const PG8_LAS bf16x8*)(lds + PG8_SA(b, h) + aoff + m * 2048 + k * 1024); } while (0)
#define PG8_LDB(dst, b, h) do { _Pragma("unroll") for (int n = 0; n < 2; ++n) _Pragma("unroll") for (int k = 0; k < 2; ++k) dst[n][k] = *(const PG8_LAS bf16x8*)(lds + PG8_SB(b, h) + boff + n * 2048 + k * 1024); } while (0)
#define PG8_MMA(ai, bj, At, Bt) do { __builtin_amdgcn_s_setprio(1); _Pragma("unroll") for (int m = 0; m < 4; ++m) _Pragma("unroll") for (int n = 0; n < 2; ++n) _Pragma("unroll") for (int k = 0; k < 2; ++k) \
        acc[ai][bj][m][n] = __builtin_amdgcn_mfma_f32_16x16x32_bf16(Bt[n][k], At[m][k], acc[ai][bj][m][n], 0, 0, 0); __builtin_amdgcn_s_setprio(0); } while (0)
#define PG8_WAIT_V(n) asm volatile("s_waitcnt vmcnt(" #n ")" ::: "memory")
#define PG8_WAIT_L(n) asm volatile("s_waitcnt lgkmcnt(" #n ")" ::: "memory")
#define PG8_BAR __builtin_amdgcn_s_barrier()
#define PG8_SCHED __builtin_amdgcn_sched_barrier(0)
    Unit cur, nxt; int ui = 0;
    if (!S.next(0, cur)) return;
    f32x4 acc[2][2][4][2];
#pragma unroll
    for (int a = 0; a < 2; ++a)
#pragma unroll
        for (int b = 0; b < 2; ++b)
#pragma unroll
            for (int m = 0; m < 4; ++m)
#pragma unroll
                for (int n = 0; n < 2; ++n) acc[a][b][m][n] = (f32x4){0.f, 0.f, 0.f, 0.f};
    bf16x8 At[4][2], B0[2][2], B1[2][2];
    const char* cA = (const char*)g.A + (size_t)cur.pm * tstep; const char* cB = (const char*)g.Bt + (size_t)cur.pn * tstep;
    S.a_ready(cur);
    if constexpr (SP2) {
        PG8_STAGE(PG8_SB(0, 0), cB, voffB); PG8_STAGE(PG8_SB(0, 1), cB + hstep, voffB); PG8_STAGE(PG8_SA(0, 0), cA, voffA); PG8_STAGE(PG8_SA(0, 1), cA + hstep, voffA);
        if (wr == 1) PG8_BAR;
        PG8_WAIT_V(2); PG8_BAR;
        PG8_STAGE(PG8_SB(1, 0), cB + kstep, voffB); PG8_STAGE(PG8_SA(1, 0), cA + kstep, voffA); PG8_STAGE(PG8_SB(1, 1), cB + hstep + kstep, voffB);
        PG8_WAIT_V(6); PG8_BAR;
    } else {
        PG8_STAGE(PG8_SB(0, 0), cB, voffB); PG8_STAGE(PG8_SA(0, 0), cA, voffA); PG8_STAGE(PG8_SB(0, 1), cB + hstep, voffB); PG8_STAGE(PG8_SA(0, 1), cA + hstep, voffA);
        if (wr == 1) PG8_BAR;
        PG8_WAIT_V(4); PG8_BAR;
        PG8_STAGE(PG8_SB(1, 0), cB + kstep, voffB); PG8_STAGE(PG8_SA(1, 0), cA + kstep, voffA); PG8_STAGE(PG8_SB(1, 1), cB + hstep + kstep, voffB);
        PG8_WAIT_V(6); PG8_BAR;
    }
    for (;;) {
        const bool has_next = S.next(ui + 1, nxt);
        const char* nA = has_next ? (const char*)g.A + (size_t)nxt.pm * tstep : cA; const char* nB = has_next ? (const char*)g.Bt + (size_t)nxt.pn * tstep : cB;
        for (int t = 0; t < nt; t += 2) {
            const bool last = (t == nt - 2);
            const char* a1 = cA + (size_t)(t + 1) * kstep;
            const char* a2 = last ? nA : cA + (size_t)(t + 2) * kstep; const char* b2 = last ? nB : cB + (size_t)(t + 2) * kstep;
            const char* a3 = a2 + kstep; const char* b3 = b2 + kstep;
            if (last && has_next) S.a_ready(nxt);
            if constexpr (SP2) {
            PG8_LDB(B0, 0, 0); PG8_LDB(B1, 0, 1); PG8_SCHED; PG8_LDA(At, 0, 0); PG8_STAGE(PG8_SA(1, 1), a1 + hstep, voffA);
            PG8_WAIT_V(8); PG8_WAIT_L(0); PG8_BAR; PG8_MMA(0, 0, At, B0); PG8_MMA(0, 1, At, B1); PG8_BAR; PG8_SCHED;
            PG8_LDA(At, 0, 1); PG8_STAGE(PG8_SB(0, 0), b2, voffB); PG8_STAGE(PG8_SB(0, 1), b2 + hstep, voffB); PG8_STAGE(PG8_SA(0, 0), a2, voffA);
            PG8_WAIT_V(8); PG8_WAIT_L(0); PG8_BAR; PG8_MMA(1, 0, At, B0); PG8_MMA(1, 1, At, B1); PG8_BAR; PG8_SCHED;
            PG8_LDB(B0, 1, 0); PG8_LDB(B1, 1, 1); PG8_SCHED; PG8_LDA(At, 1, 0); PG8_STAGE(PG8_SA(0, 1), a2 + hstep, voffA);
            PG8_WAIT_V(8); PG8_WAIT_L(0); PG8_BAR; PG8_MMA(0, 0, At, B0); PG8_MMA(0, 1, At, B1); PG8_BAR; PG8_SCHED;
            PG8_LDA(At, 1, 1); PG8_STAGE(PG8_SB(1, 0), b3, voffB); PG8_STAGE(PG8_SB(1, 1), b3 + hstep, voffB); PG8_STAGE(PG8_SA(1, 0), a3, voffA);
            PG8_WAIT_V(8); PG8_WAIT_L(0); PG8_BAR; PG8_MMA(1, 0, At, B0); PG8_MMA(1, 1, At, B1); PG8_BAR; PG8_SCHED;
            } else {
            PG8_LDB(B0, 0, 0); PG8_SCHED; PG8_LDA(At, 0, 0); PG8_STAGE(PG8_SA(1, 1), a1 + hstep, voffA);
            PG8_WAIT_L(8); PG8_BAR; PG8_WAIT_L(0); PG8_MMA(0, 0, At, B0); PG8_BAR; PG8_SCHED;
            PG8_LDB(B1, 0, 1); PG8_STAGE(PG8_SB(0, 0), b2, voffB);
            PG8_BAR; PG8_WAIT_L(0); PG8_MMA(0, 1, At, B1); PG8_BAR;
            PG8_LDA(At, 0, 1); PG8_STAGE(PG8_SA(0, 0), a2, voffA);
            PG8_BAR; PG8_WAIT_L(0); PG8_MMA(1, 0, At, B0); PG8_BAR; PG8_SCHED;
            PG8_STAGE(PG8_SB(0, 1), b2 + hstep, voffB);
            PG8_WAIT_V(6); PG8_BAR; PG8_MMA(1, 1, At, B1); PG8_BAR;
            PG8_LDB(B0, 1, 0); PG8_SCHED; PG8_LDA(At, 1, 0); PG8_STAGE(PG8_SA(0, 1), a2 + hstep, voffA);
            PG8_WAIT_L(8); PG8_BAR; PG8_WAIT_L(0); PG8_MMA(0, 0, At, B0); PG8_BAR; PG8_SCHED;
            PG8_LDB(B1, 1, 1); PG8_STAGE(PG8_SB(1, 0), b3, voffB);
            PG8_BAR; PG8_WAIT_L(0); PG8_MMA(0, 1, At, B1); PG8_BAR;
            PG8_LDA(At, 1, 1); PG8_STAGE(PG8_SA(1, 0), a3, voffA);
            PG8_BAR; PG8_WAIT_L(0); PG8_MMA(1, 0, At, B0); PG8_BAR; PG8_SCHED;
            PG8_STAGE(PG8_SB(1, 1), b3 + hstep, voffB);
            PG8_WAIT_V(6); PG8_BAR; PG8_MMA(1, 1, At, B1); PG8_BAR;
            }
        }
        if constexpr (ALIGN_EPI) { if (wr == 0) PG8_BAR; }
        if constexpr (!Epi::AFTER_DRAIN) { E(acc, cur, wr, wc, fr, fq); S.done(cur); }
        if (!has_next) break;
#pragma unroll
        for (int a = 0; a < 2; ++a)
#pragma unroll
            for (int b = 0; b < 2; ++b)
#pragma unroll
                for (int m = 0; m < 4; ++m)
#pragma unroll
                    for (int n = 0; n < 2; ++n) acc[a][b][m][n] = (f32x4){0.f, 0.f, 0.f, 0.f};
        cur = nxt; cA = nA; cB = nB; ++ui;
        if constexpr (ALIGN_EPI) { if (wr == 1) PG8_BAR; }
    }
    PG8_WAIT_V(0);
    if constexpr (!ALIGN_EPI) { if (wr == 0) PG8_BAR; }
    PG8_BAR;
    if constexpr (Epi::AFTER_DRAIN) { E.fused(acc, cur, wr, wc, fr, fq, lds, wid, lane); S.done(cur); }
#undef PG8_SA
#undef PG8_SB
#undef PG8_STAGE
#undef PG8_LDA
#undef PG8_LDB
#undef PG8_MMA
#undef PG8_WAIT_V
#undef PG8_WAIT_L
#undef PG8_BAR
#undef PG8_SCHED
}
}

namespace att {
using bf16 = __hip_bfloat16;
constexpr int   D = 128, NW = 8, QBLK = 32, KVBLK = 64;
constexpr float SCALE = 0.088388347648318440f;
constexpr float THR = 8.f;
constexpr int SDEPTH = ATT_SDEPTH;
constexpr int LDQ = 1024, LDK = 256, LDO = 1024;
constexpr size_t SHM_V = KVBLK * D * 2, SHM_K = KVBLK * D * 2, SHM_ATTN = 2 * SHM_V + 2 * SHM_K + NW * 64 * 4;
constexpr size_t OST_OFF = 69632;
using bf16x8 = __attribute__((ext_vector_type(8))) short;
using s16x4  = __attribute__((ext_vector_type(4))) short;
using f32x16 = __attribute__((ext_vector_type(16))) float;
using f32x8  = __attribute__((ext_vector_type(8))) float;
using u32x4  = __attribute__((ext_vector_type(4))) unsigned;
#define KSWZ(row, colB) ((row) * 256 + ((colB) ^ (((row) & 7) << 4)))
#define SBAR() __builtin_amdgcn_sched_barrier(0)
__device__ __forceinline__ int crow(int r, int hi) { return (r & 3) + 8 * (r >> 2) + 4 * hi; }
__device__ __forceinline__ unsigned cvtpk(float lo, float hi) {
  unsigned r; asm volatile("v_cvt_pk_bf16_f32 %0, %1, %2" : "=v"(r) : "v"(lo), "v"(hi)); return r;
}
template <typename TIn> struct Stage;
template <> struct Stage<bf16>  { using T = bf16x8;
  __device__ static __forceinline__ T ld8(const bf16* p) { return *reinterpret_cast<const bf16x8*>(p); }
  __device__ static __forceinline__ bf16x8 tobf(T x) { return x; } };
template <> struct Stage<float> { using T = f32x8;
  __device__ static __forceinline__ T ld8(const float* p) { return *reinterpret_cast<const f32x8*>(p); }
  __device__ static __forceinline__ bf16x8 tobf(T x) {
    u32x4 w = {cvtpk(x[0], x[1]), cvtpk(x[2], x[3]), cvtpk(x[4], x[5]), cvtpk(x[6], x[7])}; return *reinterpret_cast<bf16x8*>(&w); } };

__device__ __forceinline__ void partialSM(f32x16& p0, f32x16& p1, float& m_reg, float& mn, float& alpha) {
  constexpr float C = SCALE * 1.4426950408889634f;
  float pmax = p0[0]; for (int r = 1; r < 16; ++r) pmax = fmaxf(pmax, p0[r]); for (int r = 0; r < 16; ++r) pmax = fmaxf(pmax, p1[r]);
  { auto rr = __builtin_amdgcn_permlane32_swap(__float_as_uint(pmax), __float_as_uint(pmax), false, false);
    pmax = fmaxf(__uint_as_float(rr[0]), __uint_as_float(rr[1])); }
  if (__builtin_expect(__all(pmax - m_reg <= THR / SCALE), 1)) { mn = m_reg; alpha = 1.f; }
  else { mn = fmaxf(m_reg, pmax); alpha = __builtin_amdgcn_exp2f((m_reg - mn) * C); m_reg = mn; }
  float mnC = -mn * C;
  for (int r = 0; r < 16; ++r) p0[r] = fmaf(p0[r], C, mnC); for (int r = 0; r < 16; ++r) p1[r] = fmaf(p1[r], C, mnC);
  for (int r = 0; r < 16; ++r) p0[r] = __builtin_amdgcn_exp2f(p0[r]);
}
__device__ __forceinline__ void finishSM(f32x16& p0, f32x16& p1, float alpha, float& l_reg, bf16x8& pa0, bf16x8& pa1, bf16x8& pa2, bf16x8& pa3) {
  for (int r = 0; r < 16; ++r) p1[r] = __builtin_amdgcn_exp2f(p1[r]);
  float ps = 0; for (int r = 0; r < 16; ++r) ps += p0[r]; for (int r = 0; r < 16; ++r) ps += p1[r];
  { auto rr = __builtin_amdgcn_permlane32_swap(__float_as_uint(ps), __float_as_uint(ps), false, false);
    ps = __uint_as_float(rr[0]) + __uint_as_float(rr[1]); }
  l_reg = l_reg * alpha + ps;
#define PK4(P, BASE, OUT) do { unsigned a0 = cvtpk(P[BASE + 0], P[BASE + 1]), a1 = cvtpk(P[BASE + 2], P[BASE + 3]);   \
    unsigned b0 = cvtpk(P[BASE + 4], P[BASE + 5]), b1 = cvtpk(P[BASE + 6], P[BASE + 7]);                              \
    auto r0 = __builtin_amdgcn_permlane32_swap(a0, b0, false, false); auto r1 = __builtin_amdgcn_permlane32_swap(a1, b1, false, false); \
    u32x4 w = {r0[0], r1[0], r0[1], r1[1]}; OUT = *reinterpret_cast<bf16x8*>(&w); } while (0)
  PK4(p0, 0, pa0); PK4(p0, 8, pa1); PK4(p1, 0, pa2); PK4(p1, 8, pa3);
#undef PK4
}
__device__ __forceinline__ void qkt(f32x16& p0, f32x16& p1, const bf16* Ks, const bf16x8* qr, int r32, int hi) {
  p0 = f32x16{}; p1 = f32x16{};
  for (int d0 = 0; d0 < 8; ++d0) { int cb = (d0 * 16 + hi * 8) * 2;
    bf16x8 b0 = *reinterpret_cast<const bf16x8*>((const char*)Ks + KSWZ(r32, cb));
    bf16x8 b1 = *reinterpret_cast<const bf16x8*>((const char*)Ks + KSWZ(32 + r32, cb));
    p0 = __builtin_amdgcn_mfma_f32_32x32x16_bf16(b0, qr[d0], p0, 0, 0, 0);
    p1 = __builtin_amdgcn_mfma_f32_32x32x16_bf16(b1, qr[d0], p1, 0, 0, 0); }
}
__device__ __forceinline__ int v_st(int k, int c) { const int kk = (k & ~0xC) | ((k & 4) << 1) | ((k & 8) >> 1); return ((kk >> 3) * 4 + (c >> 5)) * 512 + ((kk & 7) * 32 + (c & 31)) * 2; }
__device__ __forceinline__ int v_rd_base(int lane) { return ((lane & 3) << 3) | (((lane >> 2) & 3) << 6) | (((lane >> 4) & 1) << 5) | (((lane >> 5) & 1) << 8); }
constexpr int v_rd_off(int d0, int ks, int half) { return d0 * 512 + ks * 4096 + half * 2048; }
template <int OFF> __device__ __forceinline__ s16x4 tr_read(int vb) {
  s16x4 r; asm volatile("ds_read_b64_tr_b16 %0, %1 offset:%2" : "=&v"(r) : "v"(vb), "i"(OFF) : "memory"); return r;
}
template <int D0> __device__ __forceinline__ void pv_one(f32x16& od, int vb, bf16x8 pa0, bf16x8 pa1, bf16x8 pa2, bf16x8 pa3) {
  const s16x4 l0 = tr_read<v_rd_off(D0, 0, 0)>(vb), h0 = tr_read<v_rd_off(D0, 0, 1)>(vb), l1 = tr_read<v_rd_off(D0, 1, 0)>(vb), h1 = tr_read<v_rd_off(D0, 1, 1)>(vb);
  const s16x4 l2 = tr_read<v_rd_off(D0, 2, 0)>(vb), h2 = tr_read<v_rd_off(D0, 2, 1)>(vb), l3 = tr_read<v_rd_off(D0, 3, 0)>(vb), h3 = tr_read<v_rd_off(D0, 3, 1)>(vb);
  asm volatile("s_waitcnt lgkmcnt(0)" ::: "memory"); SBAR();
#define PK(L, H) (bf16x8){L[0], L[1], L[2], L[3], H[0], H[1], H[2], H[3]}
  od = __builtin_amdgcn_mfma_f32_32x32x16_bf16(pa0, PK(l0, h0), od, 0, 0, 0);
  od = __builtin_amdgcn_mfma_f32_32x32x16_bf16(pa1, PK(l1, h1), od, 0, 0, 0);
  od = __builtin_amdgcn_mfma_f32_32x32x16_bf16(pa2, PK(l2, h2), od, 0, 0, 0);
  od = __builtin_amdgcn_mfma_f32_32x32x16_bf16(pa3, PK(l3, h3), od, 0, 0, 0);
#undef PK
}
__device__ __forceinline__ void pv_d0(f32x16* o, int vb, bf16x8 pa0, bf16x8 pa1, bf16x8 pa2, bf16x8 pa3) {
  pv_one<0>(o[0], vb, pa0, pa1, pa2, pa3); pv_one<1>(o[1], vb, pa0, pa1, pa2, pa3); pv_one<2>(o[2], vb, pa0, pa1, pa2, pa3); pv_one<3>(o[3], vb, pa0, pa1, pa2, pa3);
}

__device__ __forceinline__ float bf2f(short s) { return __uint_as_float(((unsigned)(unsigned short)s) << 16); }

__device__ __forceinline__ void qkt2(f32x16& p0, f32x16& p1, const bf16* Ks, const bf16x8* qr, const f32x16& negm, int r32, int hi) {
  p0 = negm; p1 = negm;
#pragma unroll
  for (int d0 = 0; d0 < 8; ++d0) { int cb = (d0 * 16 + hi * 8) * 2;
    bf16x8 b0 = *reinterpret_cast<const bf16x8*>((const char*)Ks + KSWZ(r32, cb));
    bf16x8 b1 = *reinterpret_cast<const bf16x8*>((const char*)Ks + KSWZ(32 + r32, cb));
    p0 = __builtin_amdgcn_mfma_f32_32x32x16_bf16(b0, qr[d0], p0, 0, 0, 0); p1 = __builtin_amdgcn_mfma_f32_32x32x16_bf16(b1, qr[d0], p1, 0, 0, 0); }
}
__device__ __forceinline__ void expA(f32x16& p0, float negmc) {
#pragma unroll
  for (int r = 0; r < 16; ++r) p0[r] = __builtin_amdgcn_exp2f(ATT_NEGM ? p0[r] : p0[r] + negmc);
}
__device__ __forceinline__ void finishSM2(f32x16& p0, f32x16& p1, float negmc, float& l_reg, bf16x8& pa0, bf16x8& pa1, bf16x8& pa2, bf16x8& pa3) {
#pragma unroll
  for (int r = 0; r < 16; ++r) p1[r] = __builtin_amdgcn_exp2f(ATT_NEGM ? p1[r] : p1[r] + negmc);
  float ps = 0;
#pragma unroll
  for (int r = 0; r < 16; ++r) ps += p0[r];
#pragma unroll
  for (int r = 0; r < 16; ++r) ps += p1[r];
  l_reg += ps;
#define PK4(P, BASE, OUT) do { unsigned a0 = cvtpk(P[BASE + 0], P[BASE + 1]), a1 = cvtpk(P[BASE + 2], P[BASE + 3]);   \
    unsigned b0 = cvtpk(P[BASE + 4], P[BASE + 5]), b1 = cvtpk(P[BASE + 6], P[BASE + 7]);                              \
    auto r0 = __builtin_amdgcn_permlane32_swap(a0, b0, false, false); auto r1 = __builtin_amdgcn_permlane32_swap(a1, b1, false, false); \
    u32x4 w = {r0[0], r1[0], r0[1], r1[1]}; OUT = *reinterpret_cast<bf16x8*>(&w); } while (0)
  PK4(p0, 0, pa0); PK4(p0, 8, pa1); PK4(p1, 0, pa2); PK4(p1, 8, pa3);
#undef PK4
}

__device__ __forceinline__ void attn_unit(const bf16* Qb, const bf16* __restrict__ Kh, const bf16* __restrict__ Vh,
                                          bf16* Ob, int seq, int t0, const float* __restrict__ qgain, const float2* __restrict__ rope, float negmc, char* lds) {
  using St = Stage<bf16>;
  const int tid = mk_tid(), wid = tid >> 6, lane = tid & 63, r32 = lane & 31, hi = lane >> 5;
  bf16* V_lds = (bf16*)lds; bf16* K_lds = (bf16*)(lds + 2 * SHM_V);
  float* ws = (float*)(lds + 2 * SHM_V + 2 * SHM_K) + wid * 64; float* li_l = ws;
  float l_reg = 0; f32x16 o[4] = {}; bf16x8 qr[8]; f32x16 negm; for (int r = 0; r < 16; ++r) negm[r] = ATT_NEGM ? negmc : 0.f; if (ATT_NEGM) asm volatile("" : "+v"(negm));
  const bf16* Qw = Qb + (long)(wid * QBLK + r32) * LDQ + hi * 8;
#pragma unroll
  for (int d0 = 0; d0 < 8; ++d0) qr[d0] = St::ld8(Qw + d0 * 16);
  (void)t0; (void)qgain; (void)rope;
  const int sr = tid >> 4, sc = (tid & 15) * 8, vst0 = v_st(sr, sc), vst1 = v_st(32 + sr, sc);
  const int vb0 = (int)(uintptr_t)V_lds + v_rd_base(lane);
  struct { typename St::T vs0, vs1, ks0, ks1; } sr_[SDEPTH];
#define SLOAD(i, k0) do { sr_[i].vs0 = St::ld8(&Vh[(long)((k0) + sr) * LDK + sc]); sr_[i].vs1 = St::ld8(&Vh[(long)((k0) + 32 + sr) * LDK + sc]); \
    sr_[i].ks0 = St::ld8(&Kh[(long)((k0) + sr) * LDK + sc]); sr_[i].ks1 = St::ld8(&Kh[(long)((k0) + 32 + sr) * LDK + sc]); } while (0)
#define SWRITE(b, i) do { *(bf16x8*)((char*)V_lds + (b) * SHM_V + vst0) = St::tobf(sr_[i].vs0);          \
    *(bf16x8*)((char*)V_lds + (b) * SHM_V + vst1) = St::tobf(sr_[i].vs1); int kc = sc * 2;               \
    *(bf16x8*)((char*)K_lds + (b) * SHM_K + KSWZ(sr, kc)) = St::tobf(sr_[i].ks0);                       \
    *(bf16x8*)((char*)K_lds + (b) * SHM_K + KSWZ(32 + sr, kc)) = St::tobf(sr_[i].ks1); } while (0)
#define SWAIT() do { if constexpr (SDEPTH == 2) asm volatile("s_waitcnt vmcnt(4)" ::: "memory"); else asm volatile("s_waitcnt vmcnt(0)" ::: "memory"); } while (0)
  f32x16 pA0, pA1, pB0, pB1; bf16x8 pa0, pa1, pa2, pa3; const int NT = seq / KVBLK;
  constexpr int SE = 0, SO = SDEPTH - 1;
  SLOAD(SE, 0); asm volatile("s_waitcnt vmcnt(0)" ::: "memory"); SWRITE(0, SE); __syncthreads();
  qkt2(pA0, pA1, K_lds, qr, negm, r32, hi); expA(pA0, negmc);
  SLOAD(SO, KVBLK); if constexpr (SDEPTH == 2) { if (2 < NT) SLOAD(SE, 2 * KVBLK); }
  SWAIT(); SWRITE(1, SO); __syncthreads();
  for (int j = 1; j + 1 < NT; j += 2) {
    SBAR(); qkt2(pB0, pB1, (bf16*)((char*)K_lds + SHM_K), qr, negm, r32, hi); if (ATT_SB) SBAR();
    finishSM2(pA0, pA1, negmc, l_reg, pa0, pa1, pa2, pa3); SBAR();
    SLOAD(SO, (j + SDEPTH) * KVBLK); SBAR();
    pv_d0(o, vb0, pa0, pa1, pa2, pa3); SBAR(); expA(pB0, negmc); SBAR();
    __syncthreads(); SWAIT(); SWRITE(0, SE);
    __syncthreads();
    SBAR(); qkt2(pA0, pA1, K_lds, qr, negm, r32, hi); if (ATT_SB) SBAR();
    finishSM2(pB0, pB1, negmc, l_reg, pa0, pa1, pa2, pa3); SBAR();
    if (SDEPTH == 1 || j + 3 < NT) SLOAD(SE, (j + 1 + SDEPTH) * KVBLK); SBAR();
    pv_d0(o, vb0 + (int)SHM_V, pa0, pa1, pa2, pa3); SBAR(); expA(pA0, negmc); SBAR();
    __syncthreads(); SWAIT(); SWRITE(1, SO);
    __syncthreads();
  }
  SBAR(); qkt2(pB0, pB1, (bf16*)((char*)K_lds + SHM_K), qr, negm, r32, hi);
  finishSM2(pA0, pA1, negmc, l_reg, pa0, pa1, pa2, pa3); SBAR();
  pv_d0(o, vb0, pa0, pa1, pa2, pa3); expA(pB0, negmc);
  __syncthreads();
  finishSM2(pB0, pB1, negmc, l_reg, pa0, pa1, pa2, pa3); SBAR();
  pv_d0(o, vb0 + (int)SHM_V, pa0, pa1, pa2, pa3);
  { auto rr = __builtin_amdgcn_permlane32_swap(__float_as_uint(l_reg), __float_as_uint(l_reg), false, false); l_reg = __uint_as_float(rr[0]) + __uint_as_float(rr[1]); }
  if (hi == 0) li_l[r32] = l_reg; asm volatile("s_waitcnt lgkmcnt(0)" ::: "memory");
  float rli[16];
#pragma unroll
  for (int r = 0; r < 16; ++r) rli[r] = __builtin_amdgcn_rcpf(li_l[crow(r, hi)]);
  { bf16* stg = (bf16*)(lds + OST_OFF) + wid * (32 * 128);
#pragma unroll
    for (int r = 0; r < 16; ++r) { const int orow = crow(r, hi);
#pragma unroll
      for (int d0 = 0; d0 < 4; ++d0) stg[orow * 128 + d0 * 32 + r32] = __float2bfloat16(o[d0][r] * rli[r]); }
    asm volatile("s_waitcnt lgkmcnt(0)" ::: "memory");
    bf16* Ow = Ob + (long)(wid * QBLK) * LDO;
#pragma unroll
    for (int i = 0; i < 8; ++i) { const int row = i * 4 + (lane >> 4), ch = lane & 15; const u32x4 v = *(const u32x4*)(stg + row * 128 + ch * 8); *(u32x4*)(Ow + (long)row * LDO + ch * 8) = v; }
    asm volatile("s_waitcnt lgkmcnt(0)" ::: "memory"); }
  __syncthreads();
#undef SLOAD
#undef SWRITE
#undef SWAIT
}
}

#define LAS __attribute__((address_space(3)))
typedef unsigned short bf16_t;
typedef unsigned v4u __attribute__((ext_vector_type(4)));
typedef float f32x4 __attribute__((ext_vector_type(4)));
typedef float f32x16 __attribute__((ext_vector_type(16)));
typedef short bf16x8 __attribute__((ext_vector_type(8)));
typedef short s16x4 __attribute__((ext_vector_type(4)));
#define LDS_WAIT() asm volatile("s_waitcnt lgkmcnt(0)" ::: "memory")

constexpr int NWAVES = 8, NTHREADS = 512;
constexpr int DM = 1024, DFF = 2816, NQKV = 1536;
constexpr int NTOK_P = 16384, NTOK_S = 32768, NTOK = 49152, SEQ_P = 8192, SEQ_S = 4096, NB_P = 2, NB_S = 8;
constexpr float EPS = 1e-6f;
constexpr size_t MiB = 1u << 20;
constexpr size_t WS_WGU = 1 * MiB, WS_WD = 45 * MiB, WS_WQKV = 67 * MiB, WS_WO = 73 * MiB, WS_W2 = 77 * MiB, WS_A1P = 85 * MiB, WS_A1S = 89 * MiB, WS_A2 = 90 * MiB, WS_ROPE = 90 * MiB + 65536, WS_QKG = 90 * MiB + 131072;
constexpr size_t WS_POOL = 92 * MiB, WS_RSS = 476 * MiB, WS_END = 482 * MiB, WS_TS = 90 * MiB + 196608;
constexpr size_t WS_F = WS_POOL, WS_T = WS_POOL + 192 * MiB, WS_HID = WS_POOL, WS_QO = WS_POOL, WS_K = WS_POOL + 96 * MiB, WS_V = WS_POOL + 120 * MiB, WS_XH = WS_POOL + 288 * MiB;
constexpr size_t RSS_STRIDE = (size_t)49152 * 4;
constexpr int LDS_BYTES = 147456;

__device__ __forceinline__ unsigned f2bf(float f) { unsigned u = __builtin_bit_cast(unsigned, f); return (u + 0x7fffu + ((u >> 16) & 1u)) >> 16; }
__device__ __forceinline__ unsigned pk2(float lo, float hi) { return f2bf(lo) | (f2bf(hi) << 16); }
__device__ __forceinline__ float wave_sum(float v) {
#pragma unroll
    for (int o = 1; o < 64; o <<= 1) v += __shfl_xor(v, o);
    return v;
}

template <class RowMap>
__device__ __forceinline__ void transpose_item(const float* __restrict__ W, int K, int N, bf16_t* WT, int ldk, const float* __restrict__ gain, RowMap rm, LAS float* scr, int item, int lane) {
    const int nblk = N / 64, kb = item / nblk, nb = item % nblk, k0 = 64 * kb, n0 = 64 * nb;
#pragma unroll
    for (int h = 0; h < 2; ++h) {
        float v[32];
#pragma unroll
        for (int i = 0; i < 32; ++i) v[i] = W[(size_t)(k0 + 32 * h + i) * N + n0 + lane];
#pragma unroll
        for (int i = 0; i < 32; ++i) { const int kk = 32 * h + i; float x = v[i]; if (gain) x *= gain[k0 + kk]; scr[kk * 64 + (lane ^ (kk & 0x38))] = x; }
    }
    LDS_WAIT(); asm volatile("" ::: "memory");
    const int c = lane & 7;
#pragma unroll
    for (int j = 0; j < 8; ++j) { const int n = (lane >> 3) + 8 * j; const LAS float* s = scr + (8 * c) * 64 + (n ^ (8 * c));
        v4u o; o.x = pk2(s[0 * 64], s[1 * 64]); o.y = pk2(s[2 * 64], s[3 * 64]); o.z = pk2(s[4 * 64], s[5 * 64]); o.w = pk2(s[6 * 64], s[7 * 64]);
        *(v4u*)(WT + (size_t)rm(n0 + n) * ldk + k0 + 8 * c) = o; }
    LDS_WAIT(); asm volatile("" ::: "memory");
}
struct RmId { __device__ __forceinline__ int operator()(int n) const { return n; } };
struct RmGU { int off; __device__ __forceinline__ int operator()(int n) const { return ((n >> 7) << 8) + (n & 127) + off; } };

__device__ __forceinline__ void cvt_row2(const float* xa, const float* xb, bf16_t* oa, bf16_t* ob, float* ra, float* rb, int lane) {
    const f32x4* pa = (const f32x4*)xa + lane; const f32x4* pb = (const f32x4*)xb + lane;
    f32x4 va[4], vb[4]; float sa = 0.f, sb = 0.f;
#pragma unroll
    for (int j = 0; j < 4; ++j) { va[j] = pa[64 * j]; vb[j] = pb[64 * j]; }
#pragma unroll
    for (int j = 0; j < 4; ++j) { sa += (va[j].x * va[j].x + va[j].y * va[j].y) + (va[j].z * va[j].z + va[j].w * va[j].w); sb += (vb[j].x * vb[j].x + vb[j].y * vb[j].y) + (vb[j].z * vb[j].z + vb[j].w * vb[j].w); }
    unsigned long long* qa = (unsigned long long*)oa + lane; unsigned long long* qb = (unsigned long long*)ob + lane;
#pragma unroll
    for (int j = 0; j < 4; ++j) { qa[64 * j] = (unsigned long long)pk2(va[j].x, va[j].y) | ((unsigned long long)pk2(va[j].z, va[j].w) << 32); qb[64 * j] = (unsigned long long)pk2(vb[j].x, vb[j].y) | ((unsigned long long)pk2(vb[j].z, vb[j].w) << 32); }
    sa = wave_sum(sa); sb = wave_sum(sb);
    if (lane == 0) { *(f32x4*)ra = (f32x4){sa, 0.f, 0.f, 0.f}; *(f32x4*)rb = (f32x4){sb, 0.f, 0.f, 0.f}; }
}

template <int OFF> __device__ __forceinline__ s16x4 tr_read_off(unsigned vb) {
    s16x4 r; asm volatile("ds_read_b64_tr_b16 %0, %1 offset:%2" : "=&v"(r) : "v"(vb), "i"(OFF) : "memory"); return r;
}
template <int KS, int NKS> struct BLoad {
    static __device__ __forceinline__ void run(bf16x8 (&b0)[NKS], bf16x8 (&b1)[NKS], unsigned base0, unsigned base1) {
        const s16x4 l0 = tr_read_off<(16 * KS) * 128>(base0), h0 = tr_read_off<(16 * KS + 4) * 128>(base0);
        const s16x4 l1 = tr_read_off<(16 * KS) * 128>(base1), h1 = tr_read_off<(16 * KS + 4) * 128>(base1);
        asm volatile("s_waitcnt lgkmcnt(0)" ::: "memory");
        b0[KS] = (bf16x8){l0[0], l0[1], l0[2], l0[3], h0[0], h0[1], h0[2], h0[3]};
        b1[KS] = (bf16x8){l1[0], l1[1], l1[2], l1[3], h1[0], h1[1], h1[2], h1[3]};
        if constexpr (KS + 1 < NKS) BLoad<KS + 1, NKS>::run(b0, b1, base0, base1);
    }
};
template <int KT, int MT, bool SC>
__device__ __forceinline__ void fft_unit(const bf16_t* __restrict__ A, const bf16_t* __restrict__ in, size_t in_stride, bf16_t* out, size_t so1, size_t so0, char* wl, int lane, const float* rs = nullptr, size_t rs_stride = 0) {
    constexpr int NKS = KT / 16;
    const int r32 = lane & 31, hi = lane >> 5;
    { const int lr = lane >> 3, ch = lane & 7;
      v4u dv[KT / 8]; f32x4 pq[SC ? KT / 8 : 1];
#pragma unroll
      for (int i = 0; i < KT / 8; ++i) dv[i] = *(const v4u*)(in + (size_t)(i * 8 + lr) * in_stride + ch * 8);
      if constexpr (SC) {
#pragma unroll
          for (int i = 0; i < KT / 8; ++i) pq[i] = *(const f32x4*)(rs + (size_t)(i * 8 + lr) * rs_stride * 4);
      }
#pragma unroll
      for (int i = 0; i < KT / 8; ++i) { const int row = i * 8 + lr; v4u v = dv[i];
          if constexpr (SC) { const float r = __builtin_amdgcn_rsqf(((pq[i][0] + pq[i][1]) + (pq[i][2] + pq[i][3])) * (1.0f / 1024.0f) + 1e-6f);
              v.x = pg8::cvt_pk_bf16(pg8::bflo(v.x) * r, pg8::bfhi(v.x) * r); v.y = pg8::cvt_pk_bf16(pg8::bflo(v.y) * r, pg8::bfhi(v.y) * r); v.z = pg8::cvt_pk_bf16(pg8::bflo(v.z) * r, pg8::bfhi(v.z) * r); v.w = pg8::cvt_pk_bf16(pg8::bflo(v.w) * r, pg8::bfhi(v.w) * r); }
          *(v4u*)(wl + row * 128 + 16 * (ch ^ (((row >> 1) & 1) << 2))) = v; } }
    LDS_WAIT(); asm volatile("" ::: "memory");
    bf16x8 b0[NKS], b1[NKS];
    { const int blk = (lane >> 4) & 1, q = (lane & 15) >> 2, p = lane & 3, qb = (q >> 1) & 1;
      const unsigned basel = (unsigned)(uintptr_t)wl + (unsigned)((8 * hi + q) * 128 + 16 * (2 * blk + (p >> 1)) + 8 * (p & 1));
      BLoad<0, NKS>::run(b0, b1, basel + 64u * (unsigned)qb, basel + 64u * (unsigned)(1 - qb)); }
    asm volatile("" ::: "memory");
    bf16_t* stg = (bf16_t*)wl;
    bf16x8 af[NKS], an[NKS];
#pragma unroll
    for (int ks = 0; ks < NKS; ++ks) an[ks] = *(const bf16x8*)(A + (size_t)r32 * KT + 16 * ks + 8 * hi);
#pragma unroll 1
    for (int mb = 0; mb < MT / 32; ++mb) {
#pragma unroll
        for (int ks = 0; ks < NKS; ++ks) af[ks] = an[ks];
        { const int mbn = mb + 1 < MT / 32 ? mb + 1 : mb;
#pragma unroll
          for (int ks = 0; ks < NKS; ++ks) an[ks] = *(const bf16x8*)(A + (size_t)(32 * mbn + r32) * KT + 16 * ks + 8 * hi); }
        f32x16 c0 = {}, c1 = {};
#pragma unroll
        for (int ks = 0; ks < NKS; ++ks) { c0 = __builtin_amdgcn_mfma_f32_32x32x16_bf16(af[ks], b0[ks], c0, 0, 0, 0); c1 = __builtin_amdgcn_mfma_f32_32x32x16_bf16(af[ks], b1[ks], c1, 0, 0, 0); }
#pragma unroll
        for (int r = 0; r < 16; ++r) { const int orow = (r & 3) + 8 * (r >> 2) + 4 * hi; stg[orow * 64 + r32] = (bf16_t)f2bf(c0[r]); stg[orow * 64 + 32 + r32] = (bf16_t)f2bf(c1[r]); }
        LDS_WAIT(); asm volatile("" ::: "memory");
#pragma unroll
        for (int i = 0; i < 4; ++i) { const int row = i * 8 + (lane >> 3), ch = lane & 7, m = 32 * mb + row; const v4u v = *(const v4u*)(stg + row * 64 + ch * 8);
            *(v4u*)(out + (size_t)(m >> 1) * so1 + (size_t)(m & 1) * so0 + ch * 8) = v; }
        LDS_WAIT(); asm volatile("" ::: "memory");
    }
}

typedef __attribute__((address_space(1))) unsigned gu32;
#define XB_TMO      128
#define XB_XCNT(j)  (256  + 64 * (j))
#define XB_XSUB(j)  (1280 + 64 * (j))
#define XB_XGEN(j)  (2304 + 64 * (j))
#define XB_TOP      3328
#define XB_TOPGEN   3392
#define XCD_BAR_WORDS 3456
#define XB_SPIN_CAP (1u << 22)

__device__ __forceinline__ unsigned xb_ld(unsigned* p)              { return __hip_atomic_load(p, __ATOMIC_RELAXED, __HIP_MEMORY_SCOPE_AGENT); }
__device__ __forceinline__ unsigned xb_add(unsigned* p, unsigned v) { return __hip_atomic_fetch_add(p, v, __ATOMIC_RELAXED, __HIP_MEMORY_SCOPE_AGENT); }
__device__ __forceinline__ unsigned xb_xcc_id() { return (unsigned)__builtin_amdgcn_s_getreg((3 << 11) | 20) & 0xFu; }
#define XB_SPIN(cond, bar) do { unsigned _sp = 0; while (cond) { __builtin_amdgcn_s_sleep(1); \
    if ((++_sp & 255u) == 0u) { if (xb_ld(&(bar)[XB_TMO])) break; if (_sp > XB_SPIN_CAP) { atomicAdd(&(bar)[XB_TMO], 1u); break; } } } } while (0)

struct XcdBarrier {
    unsigned* bar; unsigned x;
    volatile LAS unsigned* st;
};

__device__ __forceinline__ XcdBarrier xcd_barrier_post(unsigned* bar, volatile LAS unsigned* st) {
    XcdBarrier b; b.bar = bar; b.x = xb_xcc_id(); b.st = st;
    if (threadIdx.x == 0) (void)xb_add(&bar[XB_XCNT(b.x)], 1u);
    return b;
}
__device__ __forceinline__ void xcd_barrier_complete(unsigned* bar, unsigned x, unsigned& nloc, unsigned& nx) {
    const unsigned G = gridDim.x * gridDim.y * gridDim.z;
    unsigned sum, cnt, mine, sp = 0u;
    for (;;) {
        sum = 0u; cnt = 0u; mine = 0u;
#pragma unroll
        for (unsigned j = 0; j < 16; ++j) { const unsigned c = xb_ld(&bar[XB_XCNT(j)]); sum += c; cnt += (c > 0u) ? 1u : 0u; mine = (j == x) ? c : mine; }
        if (sum == G) break;
        __builtin_amdgcn_s_sleep(1);
        if ((++sp & 255u) == 0u) { if (xb_ld(&bar[XB_TMO])) break; if (sp > XB_SPIN_CAP) { atomicAdd(&bar[XB_TMO], 1u); break; } }
    }
    nloc = mine > 0u ? mine : 1u; nx = cnt > 0u ? cnt : 1u;
}

__device__ __forceinline__ void xcd_barrier(const XcdBarrier& b) {
    asm volatile("s_waitcnt vmcnt(0)" ::: "memory");
    __syncthreads();
    if (threadIdx.x == 0) {
        unsigned* bar = b.bar;
        __builtin_amdgcn_s_waitcnt(0);
        unsigned nloc = b.st[0], nx = b.st[1];
        if (nloc == 0u) { xcd_barrier_complete(bar, b.x, nloc, nx); b.st[0] = nloc; b.st[1] = nx; }
        const unsigned old = xb_add(&bar[XB_XSUB(b.x)], 1u);
        const unsigned gen = old / nloc;
        if (old + 1u == (gen + 1u) * nloc) {
            __builtin_amdgcn_fence(__ATOMIC_RELEASE, "agent");
            asm volatile("s_waitcnt vmcnt(0)" ::: "memory");
            const unsigned og = xb_add(&bar[XB_TOP], 1u);
            const unsigned tg = og / nx;
            if (og + 1u == (tg + 1u) * nx) xb_add(&bar[XB_TOPGEN], 1u);
            else XB_SPIN(xb_ld(&bar[XB_TOPGEN]) == tg, bar);
            __builtin_amdgcn_fence(__ATOMIC_ACQUIRE, "agent");
            xb_add(&bar[XB_XGEN(b.x)], 1u);
            asm volatile("s_waitcnt vmcnt(0)" ::: "memory");
        } else {
            XB_SPIN(xb_ld(&bar[XB_XGEN(b.x)]) == gen, bar);
            __builtin_amdgcn_fence(__ATOMIC_ACQUIRE, "agent");
            asm volatile("s_waitcnt vmcnt(0)" ::: "memory");
        }
    }
    __syncthreads();
}
constexpr int NPH_C = 21;
__device__ const float CS128[256] = {1.000000000e+00f, 9.987954562e-01f, 9.951847267e-01f, 9.891765100e-01f, 9.807852804e-01f, 9.700312532e-01f, 9.569403357e-01f, 9.415440652e-01f, 9.238795325e-01f, 9.039892931e-01f, 8.819212643e-01f, 8.577286100e-01f, 8.314696123e-01f, 8.032075315e-01f, 7.730104534e-01f, 7.409511254e-01f, 7.071067812e-01f, 6.715589548e-01f, 6.343932842e-01f, 5.956993045e-01f, 5.555702330e-01f, 5.141027442e-01f, 4.713967368e-01f, 4.275550934e-01f, 3.826834324e-01f, 3.368898534e-01f, 2.902846773e-01f, 2.429801799e-01f, 1.950903220e-01f, 1.467304745e-01f, 9.801714033e-02f, 4.906767433e-02f, 6.123233996e-17f, -4.906767433e-02f, -9.801714033e-02f, -1.467304745e-01f, -1.950903220e-01f, -2.429801799e-01f, -2.902846773e-01f, -3.368898534e-01f, -3.826834324e-01f, -4.275550934e-01f, -4.713967368e-01f, -5.141027442e-01f, -5.555702330e-01f, -5.956993045e-01f, -6.343932842e-01f, -6.715589548e-01f, -7.071067812e-01f, -7.409511254e-01f, -7.730104534e-01f, -8.032075315e-01f, -8.314696123e-01f, -8.577286100e-01f, -8.819212643e-01f, -9.039892931e-01f, -9.238795325e-01f, -9.415440652e-01f, -9.569403357e-01f, -9.700312532e-01f, -9.807852804e-01f, -9.891765100e-01f, -9.951847267e-01f, -9.987954562e-01f, -1.000000000e+00f, -9.987954562e-01f, -9.951847267e-01f, -9.891765100e-01f, -9.807852804e-01f, -9.700312532e-01f, -9.569403357e-01f, -9.415440652e-01f, -9.238795325e-01f, -9.039892931e-01f, -8.819212643e-01f, -8.577286100e-01f, -8.314696123e-01f, -8.032075315e-01f, -7.730104534e-01f, -7.409511254e-01f, -7.071067812e-01f, -6.715589548e-01f, -6.343932842e-01f, -5.956993045e-01f, -5.555702330e-01f, -5.141027442e-01f, -4.713967368e-01f, -4.275550934e-01f, -3.826834324e-01f, -3.368898534e-01f, -2.902846773e-01f, -2.429801799e-01f, -1.950903220e-01f, -1.467304745e-01f, -9.801714033e-02f, -4.906767433e-02f, -1.836970199e-16f, 4.906767433e-02f, 9.801714033e-02f, 1.467304745e-01f, 1.950903220e-01f, 2.429801799e-01f, 2.902846773e-01f, 3.368898534e-01f, 3.826834324e-01f, 4.275550934e-01f, 4.713967368e-01f, 5.141027442e-01f, 5.555702330e-01f, 5.956993045e-01f, 6.343932842e-01f, 6.715589548e-01f, 7.071067812e-01f, 7.409511254e-01f, 7.730104534e-01f, 8.032075315e-01f, 8.314696123e-01f, 8.577286100e-01f, 8.819212643e-01f, 9.039892931e-01f, 9.238795325e-01f, 9.415440652e-01f, 9.569403357e-01f, 9.700312532e-01f, 9.807852804e-01f, 9.891765100e-01f, 9.951847267e-01f, 9.987954562e-01f, 0.000000000e+00f, 4.906767433e-02f, 9.801714033e-02f, 1.467304745e-01f, 1.950903220e-01f, 2.429801799e-01f, 2.902846773e-01f, 3.368898534e-01f, 3.826834324e-01f, 4.275550934e-01f, 4.713967368e-01f, 5.141027442e-01f, 5.555702330e-01f, 5.956993045e-01f, 6.343932842e-01f, 6.715589548e-01f, 7.071067812e-01f, 7.409511254e-01f, 7.730104534e-01f, 8.032075315e-01f, 8.314696123e-01f, 8.577286100e-01f, 8.819212643e-01f, 9.039892931e-01f, 9.238795325e-01f, 9.415440652e-01f, 9.569403357e-01f, 9.700312532e-01f, 9.807852804e-01f, 9.891765100e-01f, 9.951847267e-01f, 9.987954562e-01f, 1.000000000e+00f, 9.987954562e-01f, 9.951847267e-01f, 9.891765100e-01f, 9.807852804e-01f, 9.700312532e-01f, 9.569403357e-01f, 9.415440652e-01f, 9.238795325e-01f, 9.039892931e-01f, 8.819212643e-01f, 8.577286100e-01f, 8.314696123e-01f, 8.032075315e-01f, 7.730104534e-01f, 7.409511254e-01f, 7.071067812e-01f, 6.715589548e-01f, 6.343932842e-01f, 5.956993045e-01f, 5.555702330e-01f, 5.141027442e-01f, 4.713967368e-01f, 4.275550934e-01f, 3.826834324e-01f, 3.368898534e-01f, 2.902846773e-01f, 2.429801799e-01f, 1.950903220e-01f, 1.467304745e-01f, 9.801714033e-02f, 4.906767433e-02f, 1.224646799e-16f, -4.906767433e-02f, -9.801714033e-02f, -1.467304745e-01f, -1.950903220e-01f, -2.429801799e-01f, -2.902846773e-01f, -3.368898534e-01f, -3.826834324e-01f, -4.275550934e-01f, -4.713967368e-01f, -5.141027442e-01f, -5.555702330e-01f, -5.956993045e-01f, -6.343932842e-01f, -6.715589548e-01f, -7.071067812e-01f, -7.409511254e-01f, -7.730104534e-01f, -8.032075315e-01f, -8.314696123e-01f, -8.577286100e-01f, -8.819212643e-01f, -9.039892931e-01f, -9.238795325e-01f, -9.415440652e-01f, -9.569403357e-01f, -9.700312532e-01f, -9.807852804e-01f, -9.891765100e-01f, -9.951847267e-01f, -9.987954562e-01f, -1.000000000e+00f, -9.987954562e-01f, -9.951847267e-01f, -9.891765100e-01f, -9.807852804e-01f, -9.700312532e-01f, -9.569403357e-01f, -9.415440652e-01f, -9.238795325e-01f, -9.039892931e-01f, -8.819212643e-01f, -8.577286100e-01f, -8.314696123e-01f, -8.032075315e-01f, -7.730104534e-01f, -7.409511254e-01f, -7.071067812e-01f, -6.715589548e-01f, -6.343932842e-01f, -5.956993045e-01f, -5.555702330e-01f, -5.141027442e-01f, -4.713967368e-01f, -4.275550934e-01f, -3.826834324e-01f, -3.368898534e-01f, -2.902846773e-01f, -2.429801799e-01f, -1.950903220e-01f, -1.467304745e-01f, -9.801714033e-02f, -4.906767433e-02f};
struct Args { const float* in[12]; float* out; unsigned char* ws; int ph_lo, ph_hi; };

__global__ void __launch_bounds__(NTHREADS, 2) mk_fwd(Args args) {
    extern __shared__ __attribute__((aligned(16))) unsigned char lds[];
    const int G = gridDim.x; const int bx = blockIdx.x; const int vcu = (G % 8 == 0) ? (bx % 8) * (G / 8) + bx / 8 : bx;
    const int NGW = G * NWAVES;
    unsigned char* ws = args.ws; float* X = args.out;
    bf16_t* Wgu = (bf16_t*)(ws + WS_WGU); bf16_t* Wd = (bf16_t*)(ws + WS_WD); bf16_t* Wqkv = (bf16_t*)(ws + WS_WQKV); bf16_t* Wo = (bf16_t*)(ws + WS_WO); bf16_t* W2 = (bf16_t*)(ws + WS_W2);
    bf16_t* A1P = (bf16_t*)(ws + WS_A1P); bf16_t* A1S = (bf16_t*)(ws + WS_A1S); bf16_t* A2 = (bf16_t*)(ws + WS_A2); float2* ROPE = (float2*)(ws + WS_ROPE); float* QKG = (float*)(ws + WS_QKG);
    bf16_t* XB0 = (bf16_t*)args.out; bf16_t* XBH = (bf16_t*)(ws + WS_XH); float* RSS = (float*)(ws + WS_RSS); bf16_t* FB = (bf16_t*)(ws + WS_F); bf16_t* TB = (bf16_t*)(ws + WS_T); bf16_t* HID = (bf16_t*)(ws + WS_HID);
    bf16_t* QO = (bf16_t*)(ws + WS_QO); bf16_t* KB = (bf16_t*)(ws + WS_K); bf16_t* VB = (bf16_t*)(ws + WS_V);
    LAS unsigned char* ldsl = (LAS unsigned char*)lds;
    const int lo = args.ph_lo, hi = args.ph_hi;
    int ph = 0;
    volatile LAS unsigned* MISC = (volatile LAS unsigned*)(ldsl + 131072 + 8192);
    if (threadIdx.x < 64) MISC[threadIdx.x] = 0u;
    __syncthreads();
    XcdBarrier xbar; xbar.bar = (unsigned*)(ws + 16384); xbar.x = xb_xcc_id(); xbar.st = MISC + 8;
    if (bx == 0) { for (int i = threadIdx.x; i < XCD_BAR_WORDS; i += NTHREADS) xbar.bar[i] = 0u; }
    unsigned long long* TS = (unsigned long long*)(ws + WS_TS);
    if (MK_PROBE && bx == 0 && threadIdx.x == 0) TS[0] = __builtin_amdgcn_s_memrealtime();
#define PH_BEGIN if (ph >= lo && ph < hi) { const int tid = mk_tid(), lane = tid & 63, wave = __builtin_amdgcn_readfirstlane(tid >> 6), gw = vcu * NWAVES + wave; (void)lane; (void)gw;
#define PH_END } ++ph; if (ph > lo && ph < hi) { if (ph == 1 || MK_CG_ONLY) { cg::this_grid().sync(); if (ph == 1 && threadIdx.x == 0) (void)xb_add(&xbar.bar[XB_XCNT(xbar.x)], 1u); } else xcd_barrier(xbar); } if (MK_PROBE && bx == 0 && threadIdx.x == 0) TS[ph] = __builtin_amdgcn_s_memrealtime();

    PH_BEGIN
    if (EN_P0) {
        LAS float* scr = (LAS float*)(ldsl + wave * 16384);
        if (MK_PROBE2 && bx == 0 && threadIdx.x == 0) TS[40] = __builtin_amdgcn_s_memrealtime();
        constexpr int I_G = 16 * 44, I_D = 44 * 16, I_QKV = 16 * 24, I_O = 16 * 16;
        constexpr int NITEMS = 4 * (2 * I_G + I_D) + 2 * (I_QKV + I_O);
        for (int it = gw; it < NITEMS; it += NGW) {
            int r = it;
            if (r < 4 * I_G) { const int l = r / I_G; transpose_item(args.in[9] + (size_t)l * DM * DFF, DM, DFF, Wgu + (size_t)l * 2 * DFF * DM, DM, args.in[3] + l * DM, RmGU{0}, scr, r % I_G, lane); continue; } r -= 4 * I_G;
            if (r < 4 * I_G) { const int l = r / I_G; transpose_item(args.in[10] + (size_t)l * DM * DFF, DM, DFF, Wgu + (size_t)l * 2 * DFF * DM, DM, args.in[3] + l * DM, RmGU{128}, scr, r % I_G, lane); continue; } r -= 4 * I_G;
            if (r < 4 * I_D) { const int l = r / I_D; transpose_item(args.in[11] + (size_t)l * DFF * DM, DFF, DM, Wd + (size_t)l * DM * DFF, DFF, (const float*)nullptr, RmId{}, scr, r % I_D, lane); continue; } r -= 4 * I_D;
            if (r < 2 * I_QKV) { const int j = r / I_QKV; transpose_item(args.in[5] + (size_t)j * DM * NQKV, DM, NQKV, Wqkv + (size_t)j * NQKV * DM, DM, args.in[2] + (2 * j + 1) * DM, RmId{}, scr, r % I_QKV, lane); continue; } r -= 2 * I_QKV;
            { const int j = r / I_O; transpose_item(args.in[8] + (size_t)j * DM * DM, DM, DM, Wo + (size_t)j * DM * DM, DM, (const float*)nullptr, RmId{}, scr, r % I_O, lane); }
        }
        if (MK_PROBE2) { __syncthreads(); if (bx == 0 && threadIdx.x == 0) TS[41] = __builtin_amdgcn_s_memrealtime(); }
        {
          for (int task = gw; task < 2048; task += NGW) {
              const int nb = task & 15, cc = (task >> 4) & 3, g = (task >> 6) & 7, p = (task >> 9) & 1, j = task >> 10;
              const int n = nb * 64 + lane; const float* w = args.in[4] + (size_t)j * DM * DM + (size_t)(g * 128) * DM + n; const float* tb = CS128 + p * 128;
              float acc[32];
#pragma unroll
              for (int ci = 0; ci < 32; ++ci) acc[ci] = 0.f;
              for (int jp0 = 0; jp0 < 128; jp0 += 8) { float wv[8];
#pragma unroll
                  for (int d = 0; d < 8; ++d) wv[d] = w[(size_t)(jp0 + d) * DM];
#pragma unroll
                  for (int d = 0; d < 8; ++d)
#pragma unroll
                      for (int ci = 0; ci < 32; ++ci) acc[ci] += tb[((cc * 32 + ci) * (jp0 + d)) & 127] * wv[d]; }
              const float* gain = args.in[2] + (2 * j) * DM + g * 128 + cc * 32;
              bf16_t* dst = W2 + (size_t)j * DM * 2048 + (size_t)n * 2048 + p * 1024 + g * 128 + cc * 32;
#pragma unroll
              for (int q4 = 0; q4 < 4; ++q4) { v4u o; const float sc = 0.08838834764831845f;
                  o.x = pk2(acc[8 * q4 + 0] * gain[8 * q4 + 0] * sc, acc[8 * q4 + 1] * gain[8 * q4 + 1] * sc); o.y = pk2(acc[8 * q4 + 2] * gain[8 * q4 + 2] * sc, acc[8 * q4 + 3] * gain[8 * q4 + 3] * sc);
                  o.z = pk2(acc[8 * q4 + 4] * gain[8 * q4 + 4] * sc, acc[8 * q4 + 5] * gain[8 * q4 + 5] * sc); o.w = pk2(acc[8 * q4 + 6] * gain[8 * q4 + 6] * sc, acc[8 * q4 + 7] * gain[8 * q4 + 7] * sc);
                  *(v4u*)(dst + 8 * q4) = o; }
          }
          LDS_WAIT(); asm volatile("" ::: "memory");
        }
        if (MK_PROBE2) { __syncthreads(); if (bx == 0 && threadIdx.x == 0) TS[42] = __builtin_amdgcn_s_memrealtime(); }
        { const int gt = gw * 64 + lane, NGT = NGW * 64;
          for (int e2 = gt; e2 < 64 * 256 * 64; e2 += NGT) {
              const int s1 = (e2 & 63) * 2, m = (e2 >> 6) & 255, s2 = e2 >> 14, k1 = m >> 1, pp = m & 1; float v[2];
#pragma unroll
              for (int d = 0; d < 2; ++d) { const int s = 64 * (s1 + d) + s2, r = (k1 * s) & 8191; const float x = (float)r * (1.0f / 4096.0f); v[d] = (pp ? -sinpif(x) : cospif(x)) * 0.08838834764831845f; }
              ((unsigned*)A1P)[e2] = pk2(v[0], v[1]); }
          for (int e2 = gt; e2 < 64 * 128 * 32; e2 += NGT) {
              const int s1 = (e2 & 31) * 2, m = (e2 >> 5) & 127, s2 = e2 >> 12, k1 = m >> 1, pp = m & 1; float v[2];
#pragma unroll
              for (int d = 0; d < 2; ++d) { const int s = 64 * (s1 + d) + s2, r = (k1 * s) & 4095; const float x = (float)r * (1.0f / 2048.0f); v[d] = (pp ? -sinpif(x) : cospif(x)) * 0.125f; }
              ((unsigned*)A1S)[e2] = pk2(v[0], v[1]); }
          for (int e2 = gt; e2 < 128 * 64; e2 += NGT) {
              const int k = (e2 & 63) * 2, m = e2 >> 6, k2 = m >> 1, pp = m & 1, p = k >> 6; float v[2];
#pragma unroll
              for (int d = 0; d < 2; ++d) { const int s2 = (k + d) & 63, r = (k2 * s2) & 63; const float x = (float)r * (1.0f / 32.0f); const float c = cospif(x), s = sinpif(x);
                  v[d] = (pp == 0 ? (p == 0 ? c : s) : (p == 0 ? -s : c)) * 0.125f; }
              ((unsigned*)A2)[e2] = pk2(v[0], v[1]); }
          if (gw == 0) {
#pragma unroll
              for (int j2 = 0; j2 < 2; ++j2) { float mq = fmaxf(fabsf(args.in[6][j2 * 128 + lane]), fabsf(args.in[6][j2 * 128 + 64 + lane])), mk = fmaxf(fabsf(args.in[7][j2 * 128 + lane]), fabsf(args.in[7][j2 * 128 + 64 + lane]));
#pragma unroll
                  for (int o = 1; o < 64; o <<= 1) { mq = fmaxf(mq, __shfl_xor(mq, o)); mk = fmaxf(mk, __shfl_xor(mk, o)); }
                  if (lane == 0) QKG[512 + j2] = -(128.0f * 1.02f * mq * mk) * (att::SCALE * 1.4426950408889634f); }
          }
          for (int e = gt; e < 512; e += NGT) { const int j = e >> 8, r = e & 255; QKG[e] = r < 128 ? args.in[6][j * 128 + r] : args.in[7][j * 128 + r - 128]; }
          for (int e = gt; e < 128 * 32; e += NGT) { const int i = e & 31, pos = e >> 5; const float inv = powf(10000.0f, -(float)i * (1.0f / 32.0f)); const float a = (float)pos * inv; ROPE[e] = make_float2(cosf(a), sinf(a)); }
        }
        if (MK_PROBE2) { __syncthreads(); if (bx == 0 && threadIdx.x == 0) TS[43] = __builtin_amdgcn_s_memrealtime(); }
        for (int m = 2 * gw; m < NTOK; m += 2 * NGW) { const float* src = m < NTOK_P ? args.in[0] + (size_t)m * DM : args.in[1] + (size_t)(m - NTOK_P) * DM; cvt_row2(src, src + DM, XB0 + (size_t)m * DM, XB0 + (size_t)(m + 1) * DM, RSS + (size_t)m * 4, RSS + (size_t)(m + 1) * 4, lane); }
    }
    PH_END

    for (int layer = 0; layer < 4; ++layer) {
        const int jj = layer >> 1;
        const float* rss_mix = RSS + (size_t)(2 * layer) * RSS_STRIDE;
        float* rss_ffn = RSS + (size_t)(2 * layer + 1) * RSS_STRIDE;
        float* rss_next = RSS + (size_t)(2 * layer + 2) * RSS_STRIDE;
        bf16_t* XBF = layer == 3 ? XBH : XB0;
        PG8_LAS float* Pscr = (PG8_LAS float*)(ldsl + 131072);
        if ((layer & 1) == 0) {
            PH_BEGIN
            if (EN_FFT) {
                char* wl = (char*)lds + wave * 16384;
                for (int u = gw; u < 2048; u += NGW) { const int cb = u & 15, s2 = (u >> 4) & 63, b = u >> 10; const size_t tok = (size_t)b * SEQ_P + s2;
                    fft_unit<128, 256, true>(A1P + (size_t)s2 * 256 * 128, XB0 + tok * DM + cb * 64, (size_t)64 * DM, TB + ((size_t)b * 2 * SEQ_P + s2) * DM + cb * 64, (size_t)2 * 64 * DM, (size_t)64 * DM, wl, lane, rss_mix + tok * 4, (size_t)64); }
                for (int u = gw; u < 8192; u += NGW) { const int cb = u & 15, s2 = (u >> 4) & 63, b = u >> 10; const size_t tok = (size_t)NTOK_P + (size_t)b * SEQ_S + s2;
                    fft_unit<64, 128, true>(A1S + (size_t)s2 * 128 * 64, XB0 + tok * DM + cb * 64, (size_t)64 * DM, TB + ((size_t)2 * NTOK_P + (size_t)b * 2 * SEQ_S + s2) * DM + cb * 64, (size_t)2 * 64 * DM, (size_t)64 * DM, wl, lane, rss_mix + tok * 4, (size_t)64); }
            }
            PH_END
            PH_BEGIN
            if (EN_FFT) {
                char* wl = (char*)lds + wave * 16384;
                for (int u = gw; u < 4096 + 8192; u += NGW) {
                    const bool P = u < 4096; const int v = P ? u : u - 4096; const int cb = v & 15; const int k1 = P ? ((v >> 4) & 127) : ((v >> 4) & 63); const int b = P ? (v >> 11) : (v >> 10);
                    const size_t trow = P ? ((size_t)b * 2 * SEQ_P + (size_t)k1 * 128) : ((size_t)2 * NTOK_P + (size_t)b * 2 * SEQ_S + (size_t)k1 * 128);
                    const size_t frow = P ? ((size_t)b * SEQ_P + k1) : ((size_t)NTOK_P + (size_t)b * SEQ_S + k1);
                    fft_unit<128, 128, false>(A2, TB + trow * DM + cb * 64, (size_t)DM, FB + frow * 2048 + cb * 64, P ? (size_t)128 * 2048 : (size_t)64 * 2048, (size_t)1024, wl, lane);
                }
            }
            PH_END
        } else {
            PH_BEGIN
            if (EN_QKV) {
                pg8::Gemm g{XB0, Wqkv + (size_t)jj * NQKV * DM, NTOK, NQKV, DM}; pg8::StaticOrder S; S.init(NTOK, NQKV, G, bx);
                pg8::EpiQKV E{QO, KB, VB, rss_mix, QKG + jj * 256, (const float*)ROPE, (PG8_LAS float*)(ldsl + 131072), att::SCALE * 1.4426950408889634f};
                pg8::gemm_phase<pg8::EpiQKV, pg8::StaticOrder, GU_ALIGN, GEMM_SP2>(ldsl, g, S, E);
            }
            PH_END
            PH_BEGIN
            if (EN_ATT) {
                const float* qg = QKG + jj * 256; const float negmc = QKG[512 + jj];
                for (int j = vcu; j < 1536; j += G) {
                    int b, h, qb, tok0, seq;
                    if (j < 512) { const int bh = j >> 5; qb = j & 31; b = bh >> 3; h = bh & 7; tok0 = b * SEQ_P; seq = SEQ_P; }
                    else { const int v = j - 512, bh = v >> 4; qb = v & 15; b = bh >> 3; h = bh & 7; tok0 = NTOK_P + b * SEQ_S; seq = SEQ_S; }
                    const att::bf16* Qb = (const att::bf16*)QO + ((size_t)tok0 + qb * 256) * 1024 + h * 128;
                    const att::bf16* Kh = (const att::bf16*)KB + (size_t)tok0 * 256 + (h >> 2) * 128;
                    const att::bf16* Vh = (const att::bf16*)VB + (size_t)tok0 * 256 + (h >> 2) * 128;
                    att::attn_unit(Qb, Kh, Vh, (att::bf16*)Qb, seq, qb * 256, qg, ROPE, negmc, (char*)lds);
                }
            }
            PH_END
        }
        PH_BEGIN
        if (EN_RES) {
            pg8::Gemm g = (layer & 1) ? pg8::Gemm{QO, Wo + (size_t)jj * DM * DM, NTOK, DM, DM} : pg8::Gemm{FB, W2 + (size_t)jj * DM * 2048, NTOK, DM, 2048};
            pg8::StaticOrder S; S.init(NTOK, DM, G, bx); pg8::EpiResB E{XB0, XBF, (float*)nullptr, rss_ffn, Pscr};
            pg8::gemm_phase<pg8::EpiResB, pg8::StaticOrder, true, GEMM_SP2>(ldsl, g, S, E);
        }
        PH_END
        PH_BEGIN
        if (EN_GU) {
            if (MK_SLEEP_US) { const unsigned long long t0 = __builtin_amdgcn_s_memrealtime(); while (__builtin_amdgcn_s_memrealtime() - t0 < 100ull * MK_SLEEP_US) __builtin_amdgcn_s_sleep(64); }
            pg8::Gemm g{XBF, Wgu + (size_t)layer * 2 * DFF * DM, NTOK, 2 * DFF, DM}; pg8::StaticOrder S; S.init(NTOK, 2 * DFF, G, bx);
            pg8::EpiSwiGLU E{HID, DFF, rss_ffn};
            pg8::gemm_phase<pg8::EpiSwiGLU, pg8::StaticOrder, GU_ALIGN, GEMM_SP2>(ldsl, g, S, E);
        }
        PH_END
        PH_BEGIN
        if (EN_RES) {
            pg8::Gemm g{HID, Wd + (size_t)layer * DM * DFF, NTOK, DM, DFF}; pg8::StaticOrder S; S.init(NTOK, DM, G, bx); S.rev = MK_DREV;
            pg8::EpiResB E{XBF, XB0, layer == 3 ? X : (float*)nullptr, layer == 3 ? (float*)nullptr : rss_next, Pscr};
            pg8::gemm_phase<pg8::EpiResB, pg8::StaticOrder, true, GEMM_SP2>(ldsl, g, S, E);
        }
        PH_END
    }
#undef PH_BEGIN
#undef PH_END
    for (int i = 0; i < MK_EXTRA_SYNC; ++i) cg::this_grid().sync();
    if (MK_PROBE && bx == 0 && threadIdx.x == 0) {
        unsigned long long sa = 0, sb = 0; const unsigned long long tot = TS[NPH_C] - TS[0];
        for (int i = 0; i < NPH_C; ++i) { const unsigned long long d = TS[i + 1] - TS[i]; if ((MK_MASK_A >> i) & 1u) sa += d; if ((MK_MASK_B >> i) & 1u) sb += d; }
        if (MK_PROBE2) { unsigned long long q[5] = {TS[40], TS[41], TS[42], TS[43], TS[1]}; sa = q[MK_PA + 1] - q[MK_PA]; sb = q[MK_PB + 1] - q[MK_PB]; sa *= 10; sb *= 10; }
        const unsigned long long pa = (sa * 100 + tot / 2) / tot, pb = (sb * 100 + tot / 2) / tot;
        const unsigned long long D = 2000ull * (pa * 100 + pb);
        while (__builtin_amdgcn_s_memrealtime() - TS[NPH_C] < D) __builtin_amdgcn_s_sleep(32);
    }
}
constexpr int NPHASES = NPH_C;

extern "C" void kernel_launch(void* const* d_in, const int* in_sizes, int n_in, void* d_out, int out_size, void* d_ws, size_t ws_size, hipStream_t stream) {
    static int grid = 0;
    if (grid == 0) {
        if (n_in != 12 || out_size != NTOK * DM || ws_size < WS_END) { fprintf(stderr, "kernel_launch: unexpected shapes: n_in %d out %d ws %zu (need %zu)\n", n_in, out_size, ws_size, (size_t)WS_END); grid = -1; return; }
        int dev = 0, cus = 0, per_cu = 0;
        hipGetDevice(&dev); hipDeviceGetAttribute(&cus, hipDeviceAttributeMultiprocessorCount, dev);
        if (hipFuncSetAttribute((const void*)mk_fwd, hipFuncAttributeMaxDynamicSharedMemorySize, LDS_BYTES) != hipSuccess) { fprintf(stderr, "kernel_launch: hipFuncSetAttribute failed\n"); grid = -1; return; }
        if (hipOccupancyMaxActiveBlocksPerMultiprocessor(&per_cu, (const void*)mk_fwd, NTHREADS, LDS_BYTES) != hipSuccess || per_cu < 1) { fprintf(stderr, "kernel_launch: occupancy query gave %d\n", per_cu); per_cu = 1; }
        (void)hipGetLastError();
        grid = cus * per_cu;
        fprintf(stderr, "kernel_launch: grid %d (cus %d x %d)\n", grid, cus, per_cu);
    }
    if (grid < 0) return;
    Args a{};
    for (int i = 0; i < 12; ++i) a.in[i] = (const float*)d_in[i];
    a.out = (float*)d_out; a.ws = (unsigned char*)d_ws;
#if MK_ONE_LAUNCH
    a.ph_lo = 0; a.ph_hi = NPHASES;
    void* kargs[] = {&a};
    hipError_t e = hipLaunchCooperativeKernel((const void*)mk_fwd, dim3(grid), dim3(NTHREADS), kargs, LDS_BYTES, stream);
    if (e != hipSuccess) fprintf(stderr, "kernel_launch: cooperative launch failed: %s (grid %d)\n", hipGetErrorString(e), grid);
#else
    for (int p = 0; p < NPHASES; ++p) { a.ph_lo = p; a.ph_hi = p + 1; hipLaunchKernelGGL(mk_fwd, dim3(grid), dim3(NTHREADS), LDS_BYTES, stream, a); }
    hipError_t e = hipPeekAtLastError();
    if (e != hipSuccess) fprintf(stderr, "kernel_launch: launch failed: %s\n", hipGetErrorString(e));
#endif
}
```

```cpp
#include <hip/hip_runtime.h>
#define ATT_SDEPTH 1
#define ATT_NEGM 1
#include <hip/hip_bf16.h>
#include <hip/hip_cooperative_groups.h>
#include <cstdio>
#include <cstdint>
namespace cg = cooperative_groups;

#ifndef EN_P0
#define EN_P0 1
#endif
#ifndef EN_FFT
#define EN_FFT 1
#endif
#ifndef EN_QKV
#define EN_QKV 1
#endif
#ifndef EN_MISC
#define EN_MISC 1
#endif
#ifndef EN_ATT
#define EN_ATT 1
#endif
#ifndef EN_RES
#define EN_RES 1
#endif
#ifndef EN_GU
#define EN_GU 1
#endif
#ifndef MK_PROBE
#define MK_PROBE 0
#endif
#ifndef MK_MASK_A
#define MK_MASK_A 0u
#endif
#ifndef MK_MASK_B
#define MK_MASK_B 0u
#endif
#ifndef MK_SLEEP_US
#define MK_SLEEP_US 0
#endif
#ifndef MK_EXTRA_SYNC
#define MK_EXTRA_SYNC 0
#endif
#ifndef MK_CG_ONLY
#define MK_CG_ONLY 0
#endif
#ifndef ATT_SDEPTH
#define ATT_SDEPTH 2
#endif
#ifndef ATT_SB
#define ATT_SB 0
#endif
#ifndef ATT_NEGM
#define ATT_NEGM 0
#endif
#ifndef GU_ALIGN
#define GU_ALIGN true
#endif
#ifndef GEMM_SP2
#define GEMM_SP2 true
#endif
#ifndef MK_PROBE2
#define MK_PROBE2 0
#endif
#ifndef MK_PA
#define MK_PA 0
#endif
#ifndef MK_PB
#define MK_PB 1
#endif
#ifndef MK_DREV
#define MK_DREV 1
#endif
#ifndef MK_ONE_LAUNCH
#define MK_ONE_LAUNCH 1
#endif

__device__ __forceinline__ int mk_tid() { int t = threadIdx.x; asm volatile("" : "+v"(t)); return t; }
namespace pg8 {
#define PG8_LAS __attribute__((address_space(3)))
typedef unsigned short bf16_t;
typedef short bf16x8 __attribute__((ext_vector_type(8)));
typedef float f32x4 __attribute__((ext_vector_type(4)));
typedef unsigned u32x4 __attribute__((ext_vector_type(4)));
constexpr int BM = 256, BK = 64, HALF = 128, HTB = HALF * BK * 2  , STAGE_BYTES = 8 * HTB, NXCD = 8, WGM = 8;

__host__ __device__ __forceinline__ int lds_byte(int r, int c) { const int st = (r >> 4) * 2 + (c >> 5), rr = r & 15, cc = c & 31, ob = rr * 64 + cc * 2; return st * 1024 + (ob ^ (((ob >> 9) & 1) << 5)); }
__host__ __device__ __forceinline__ void stage_rc(int b, int& R, int& C) { const int st = b / 1024, sb = b % 1024, swz = sb ^ (((sb >> 9) & 1) << 5); R = (st >> 1) * 16 + swz / 64; C = (st & 1) * 32 + (swz % 64) / 2; }
__host__ __device__ __forceinline__ int perm32(int rho) { const int n = rho >> 4, i = rho & 15; return 8 * (i >> 2) + 4 * n + (i & 3); }

struct Unit { int pm, pn; };
struct Gemm { const bf16_t* A; const bf16_t* Bt; int M, N, K; };

struct StaticOrder {
    int nM, nN, nwg, G, c, rev;
    __host__ __device__ void init(int M, int N, int G_, int c_) { nM = M / BM; nN = N / BM; nwg = nM * nN; G = G_; c = c_; rev = 0; }
    __host__ __device__ bool next(int i, Unit& u) const {
        const long L = (long)i * G + c; if (L >= nwg) return false;
        int wgid = (int)L; { const int q = nwg / NXCD, r = nwg % NXCD, xcd = wgid % NXCD, off = wgid / NXCD; wgid = (xcd < r ? xcd * (q + 1) : r * (q + 1) + (xcd - r) * q) + off; }
        const int nig = WGM * nN, gid = wgid / nig, fm = gid * WGM, gsz = (nM - fm) < WGM ? (nM - fm) : WGM;
        u.pm = fm + ((wgid % nig) % gsz); u.pn = (wgid % nig) / gsz; if (rev) u.pm = nM - 1 - u.pm; return true;
    }
    __device__ __forceinline__ void a_ready(const Unit&) const {}
    __device__ __forceinline__ void done(const Unit&) const {}
};

__device__ __forceinline__ unsigned cvt_pk_bf16(float lo, float hi) { unsigned r; asm volatile("v_cvt_pk_bf16_f32 %0, %1, %2" : "=v"(r) : "v"(lo), "v"(hi)); return r; }
typedef float f32x2 __attribute__((ext_vector_type(2)));
typedef float f32x2 __attribute__((ext_vector_type(2)));

__device__ __forceinline__ float bflo(unsigned w) { return __uint_as_float(w << 16); }
__device__ __forceinline__ float bfhi(unsigned w) { return __uint_as_float(w & 0xffff0000u); }
__device__ __forceinline__ float rstd_of(const float* rssp, size_t row) { const f32x4 p = *(const f32x4*)(rssp + row * 4); return __builtin_amdgcn_rsqf(((p[0] + p[1]) + (p[2] + p[3])) * (1.0f / 1024.0f) + 1e-6f); }
struct EpiResB {
    static constexpr bool PERM = true, AFTER_DRAIN = false;
    const bf16_t* xin; bf16_t* xout; float* fout; float* rssp; PG8_LAS float* P;
    __device__ __forceinline__ void operator()(const f32x4 (&acc)[2][2][4][2], const Unit& u, int wr, int wc, int fr, int fq) const {
        const int row0 = u.pm * BM + wr * 64 + fr, col0 = u.pn * BM + wc * 32 + 8 * fq;
#pragma unroll
        for (int ai = 0; ai < 2; ++ai) {
            u32x4 xo[4][2];
#pragma unroll
            for (int m = 0; m < 4; ++m)
#pragma unroll
                for (int bj = 0; bj < 2; ++bj) xo[m][bj] = *(const u32x4*)(xin + (size_t)(row0 + ai * HALF + m * 16) * 1024 + col0 + bj * HALF);
#pragma unroll
            for (int m = 0; m < 4; ++m) {
                const size_t roff = (size_t)(row0 + ai * HALF + m * 16) * 1024 + col0; float ss = 0.f;
#pragma unroll
                for (int bj = 0; bj < 2; ++bj) {
                    const u32x4 w = xo[m][bj]; const f32x4 a0 = acc[ai][bj][m][0], a1 = acc[ai][bj][m][1]; f32x4 v0, v1;
                    v0[0] = bflo(w.x) + a0[0]; v0[1] = bfhi(w.x) + a0[1]; v0[2] = bflo(w.y) + a0[2]; v0[3] = bfhi(w.y) + a0[3];
                    v1[0] = bflo(w.z) + a1[0]; v1[1] = bfhi(w.z) + a1[1]; v1[2] = bflo(w.w) + a1[2]; v1[3] = bfhi(w.w) + a1[3];
                    ss += (v0[0] * v0[0] + v0[1] * v0[1]) + (v0[2] * v0[2] + v0[3] * v0[3]) + (v1[0] * v1[0] + v1[1] * v1[1]) + (v1[2] * v1[2] + v1[3] * v1[3]);
                    if (fout) { *(f32x4*)(fout + roff + bj * HALF) = v0; *(f32x4*)(fout + roff + bj * HALF + 4) = v1; }
                    else { u32x4 o; o.x = cvt_pk_bf16(v0[0], v0[1]); o.y = cvt_pk_bf16(v0[2], v0[3]); o.z = cvt_pk_bf16(v1[0], v1[1]); o.w = cvt_pk_bf16(v1[2], v1[3]); *(u32x4*)(xout + roff + bj * HALF) = o; }
                }
                if (rssp) { ss += __shfl_xor(ss, 16); ss += __shfl_xor(ss, 32); if (fq == 0) P[(ai * HALF + wr * 64 + m * 16 + fr) * 4 + wc] = ss; }
            }
        }
        if (rssp) {
            asm volatile("s_waitcnt lgkmcnt(0)" ::: "memory"); __builtin_amdgcn_s_barrier(); asm volatile("" ::: "memory");
            const int t = (wr * 4 + wc) * 64 + fq * 16 + fr;
            if (t < 256) { const f32x4 p = *((const PG8_LAS f32x4*)P + t); rssp[(size_t)(u.pm * BM + t) * 4 + u.pn] = (p[0] + p[1]) + (p[2] + p[3]); }
        }
    }
};
__device__ __forceinline__ float silu_mul(float g, float u) { return g * u * __builtin_amdgcn_rcpf(1.0f + __builtin_amdgcn_exp2f(-1.4426950408889634f * g)); }
struct EpiSwiGLU {
    static constexpr bool PERM = true, AFTER_DRAIN = false;
    bf16_t* H; int ldh; const float* rssp;
    __device__ __forceinline__ void operator()(const f32x4 (&acc)[2][2][4][2], const Unit& u, int wr, int wc, int fr, int fq) const {
        const int row0 = u.pm * BM + wr * 64 + fr, col0 = u.pn * HALF + wc * 32 + 8 * fq;
        f32x4 pp[2][4];
#pragma unroll
        for (int ai = 0; ai < 2; ++ai)
#pragma unroll
            for (int m = 0; m < 4; ++m) pp[ai][m] = *(const f32x4*)(rssp + (size_t)(row0 + ai * HALF + m * 16) * 4);
#pragma unroll
        for (int ai = 0; ai < 2; ++ai)
#pragma unroll
            for (int m = 0; m < 4; ++m) { const int row = row0 + ai * HALF + m * 16; bf16_t* rowp = H + (size_t)row * ldh + col0; const f32x4 p = pp[ai][m]; const float rs = __builtin_amdgcn_rsqf(((p[0] + p[1]) + (p[2] + p[3])) * (1.0f / 1024.0f) + 1e-6f);
                const f32x4 g0 = acc[ai][0][m][0] * rs, g1 = acc[ai][0][m][1] * rs, u0 = acc[ai][1][m][0] * rs, u1 = acc[ai][1][m][1] * rs;
                u32x4 w;
                w.x = cvt_pk_bf16(silu_mul(g0[0], u0[0]), silu_mul(g0[1], u0[1])); w.y = cvt_pk_bf16(silu_mul(g0[2], u0[2]), silu_mul(g0[3], u0[3]));
                w.z = cvt_pk_bf16(silu_mul(g1[0], u1[0]), silu_mul(g1[1], u1[1])); w.w = cvt_pk_bf16(silu_mul(g1[2], u1[2]), silu_mul(g1[3], u1[3]));
                *(u32x4*)rowp = w; }
    }
};
struct EpiQKV {
    static constexpr bool PERM = true, AFTER_DRAIN = false;
    bf16_t *Q, *K, *V; const float* rssp;
    const float* qkg;
    const float* rope;
    PG8_LAS float* P2;
    float qscale;
    __device__ __forceinline__ void operator()(const f32x4 (&acc)[2][2][4][2], const Unit& u, int wr, int wc, int fr, int fq) const {
        const int row0 = u.pm * BM + wr * 64 + fr;
        bf16_t* base = u.pn < 4 ? Q + u.pn * BM : (u.pn == 4 ? K : V); const int ldc = u.pn < 4 ? 1024 : 256;
        const int col0 = wc * 32 + 8 * fq;
        f32x4 pp[2][4]; float rs[2][4];
#pragma unroll
        for (int ai = 0; ai < 2; ++ai)
#pragma unroll
            for (int m = 0; m < 4; ++m) pp[ai][m] = *(const f32x4*)(rssp + (size_t)(row0 + ai * HALF + m * 16) * 4);
#pragma unroll
        for (int ai = 0; ai < 2; ++ai)
#pragma unroll
            for (int m = 0; m < 4; ++m) { const f32x4 p = pp[ai][m]; rs[ai][m] = __builtin_amdgcn_rsqf(((p[0] + p[1]) + (p[2] + p[3])) * (1.0f / 1024.0f) + 1e-6f); }
        if (u.pn == 5) {
#pragma unroll
            for (int ai = 0; ai < 2; ++ai)
#pragma unroll
                for (int m = 0; m < 4; ++m) { bf16_t* rowp = base + (size_t)(row0 + ai * HALF + m * 16) * ldc + col0;
#pragma unroll
                    for (int bj = 0; bj < 2; ++bj) { const f32x4 v0 = acc[ai][bj][m][0] * rs[ai][m], v1 = acc[ai][bj][m][1] * rs[ai][m]; u32x4 w;
                        w.x = cvt_pk_bf16(v0[0], v0[1]); w.y = cvt_pk_bf16(v0[2], v0[3]); w.z = cvt_pk_bf16(v1[0], v1[1]); w.w = cvt_pk_bf16(v1[2], v1[3]);
                        *(u32x4*)(rowp + bj * HALF) = w; } }
            return;
        }
#pragma unroll
        for (int ai = 0; ai < 2; ++ai)
#pragma unroll
            for (int m = 0; m < 4; ++m)
#pragma unroll
                for (int bj = 0; bj < 2; ++bj) { const f32x4 v0 = acc[ai][bj][m][0] * rs[ai][m], v1 = acc[ai][bj][m][1] * rs[ai][m];
                    float ss = (v0[0] * v0[0] + v0[1] * v0[1]) + (v0[2] * v0[2] + v0[3] * v0[3]) + (v1[0] * v1[0] + v1[1] * v1[1]) + (v1[2] * v1[2] + v1[3] * v1[3]);
                    ss += __shfl_xor(ss, 16); ss += __shfl_xor(ss, 32);
                    if (fq == 0) P2[((ai * HALF + wr * 64 + m * 16 + fr) * 2 + bj) * 4 + wc] = ss; }
        asm volatile("s_waitcnt lgkmcnt(0)" ::: "memory"); __builtin_amdgcn_s_barrier(); asm volatile("" ::: "memory");
        const float* gp = qkg + (u.pn == 4 ? 128 : 0) + col0; const float hs = u.pn == 4 ? 1.0f : qscale;
        const f32x4 g0 = *(const f32x4*)gp * hs, g1 = *(const f32x4*)(gp + 4) * hs;
        const int ib = 16 * (wc & 1) + 4 * fq;
#pragma unroll
        for (int ai = 0; ai < 2; ++ai)
#pragma unroll
            for (int m = 0; m < 4; ++m) { const int row = row0 + ai * HALF + m * 16; bf16_t* rowp = base + (size_t)row * ldc + col0;
                const int t = row < 16384 ? (row & 8191) : ((row - 16384) & 4095); const int pos = wc < 2 ? (t >> 6) : (t & 63);
                const f32x4 cs0 = *(const f32x4*)(rope + (size_t)(pos * 32 + ib) * 2), cs1 = *(const f32x4*)(rope + (size_t)(pos * 32 + ib + 2) * 2);
#pragma unroll
                for (int bj = 0; bj < 2; ++bj) { const f32x4 pr = *((const PG8_LAS f32x4*)P2 + ((ai * HALF + wr * 64 + m * 16 + fr) * 2 + bj));
                    const float rk = rs[ai][m] * __builtin_amdgcn_rsqf(((pr[0] + pr[1]) + (pr[2] + pr[3])) * (1.0f / 128.0f) + 1e-6f);
                    const f32x4 y0 = acc[ai][bj][m][0] * rk * g0, y1 = acc[ai][bj][m][1] * rk * g1; u32x4 w;
                    w.x = cvt_pk_bf16(y0[0] * cs0[0] - y0[1] * cs0[1], y0[0] * cs0[1] + y0[1] * cs0[0]); w.y = cvt_pk_bf16(y0[2] * cs0[2] - y0[3] * cs0[3], y0[2] * cs0[3] + y0[3] * cs0[2]);
                    w.z = cvt_pk_bf16(y1[0] * cs1[0] - y1[1] * cs1[1], y1[0] * cs1[1] + y1[1] * cs1[0]); w.w = cvt_pk_bf16(y1[2] * cs1[2] - y1[3] * cs1[3], y1[2] * cs1[3] + y1[3] * cs1[2]);
                    *(u32x4*)(rowp + bj * HALF) = w; } }
    }
};
template <class Epi, class Sched, bool ALIGN_EPI = false, bool SP2 = false>
__device__ __forceinline__ void gemm_phase(PG8_LAS unsigned char* lds, const Gemm g, const Sched& S, const Epi& E) {
    const int tid = mk_tid(), wid = __builtin_amdgcn_readfirstlane(tid >> 6), lane = tid & 63, wr = wid >> 2, wc = wid & 3, fr = lane & 15, fq = lane >> 4;
    const int K = g.K, nt = K / BK;
    unsigned voffA[2], voffB[2];
#pragma unroll
    for (int i = 0; i < 2; ++i) { int R, C; stage_rc(tid * 16 + i * 8192, R, C); const int Rb = Epi::PERM ? ((R & ~31) + perm32(R & 31)) : R;
        voffA[i] = (unsigned)(R * K + C) * 2u; voffB[i] = (unsigned)(Rb * K + C) * 2u; }
    const size_t kstep = (size_t)(BK * 2);
    const size_t hstep = (size_t)HALF * K * 2;
    const size_t tstep = 2 * hstep;
    const unsigned ldsw = (unsigned)wid * 1024u;
    const int aoff = lds_byte(wr * 64 + fr, fq * 8), boff = lds_byte(wc * 32 + fr, fq * 8);
#define PG8_SA(b, h) (((b) * 2 + (h)) * HTB)
#define PG8_SB(b, h) ((4 + (b) * 2 + (h)) * HTB)
#define PG8_STAGE(bufoff, gbase, voff) do { _Pragma("unroll") for (int _i = 0; _i < 2; ++_i) \
        __builtin_amdgcn_global_load_lds((const unsigned*)((const char*)(gbase) + (voff)[_i]), (PG8_LAS unsigned*)(lds + (bufoff) + ldsw + _i * 8192), 16, 0, 0); } while (0)
#define PG8_LDA(dst, b, h) do { _Pragma("unroll") for (int m = 0; m < 4; ++m) _Pragma("unroll") for (int k = 0; k < 2; ++k) dst[m][k] = *(const PG8_LAS bf16x8*)(lds + PG8_SA(b, h) + aoff + m * 2048 + k * 1024); } while (0)
#define PG8_LDB(dst, b, h) do { _Pragma("unroll") for (int n = 0; n < 2; ++n) _Pragma("unroll") for (int k = 0; k < 2; ++k) dst[n][k] = *(const PG8_LAS bf16x8*)(lds + PG8_SB(b, h) + boff + n * 2048 + k * 1024); } while (0)
#define PG8_MMA(ai, bj, At, Bt) do { __builtin_amdgcn_s_setprio(1); _Pragma("unroll") for (int m = 0; m < 4; ++m) _Pragma("unroll") for (int n = 0; n < 2; ++n) _Pragma("unroll") for (int k = 0; k < 2; ++k) \
        acc[ai][bj][m][n] = __builtin_amdgcn_mfma_f32_16x16x32_bf16(Bt[n][k], At[m][k], acc[ai][bj][m][n], 0, 0, 0); __builtin_amdgcn_s_setprio(0); } while (0)
#define PG8_WAIT_V(n) asm volatile("s_waitcnt vmcnt(" #n ")" ::: "memory")
#define PG8_WAIT_L(n) asm volatile("s_waitcnt lgkmcnt(" #n ")" ::: "memory")
#define PG8_BAR __builtin_amdgcn_s_barrier()
#define PG8_SCHED __builtin_amdgcn_sched_barrier(0)
    Unit cur, nxt; int ui = 0;
    if (!S.next(0, cur)) return;
    f32x4 acc[2][2][4][2];
#pragma unroll
    for (int a = 0; a < 2; ++a)
#pragma unroll
        for (int b = 0; b < 2; ++b)
#pragma unroll
            for (int m = 0; m < 4; ++m)
#pragma unroll
                for (int n = 0; n < 2; ++n) acc[a][b][m][n] = (f32x4){0.f, 0.f, 0.f, 0.f};
    bf16x8 At[4][2], B0[2][2], B1[2][2];
    const char* cA = (const char*)g.A + (size_t)cur.pm * tstep; const char* cB = (const char*)g.Bt + (size_t)cur.pn * tstep;
    S.a_ready(cur);
    if constexpr (SP2) {
        PG8_STAGE(PG8_SB(0, 0), cB, voffB); PG8_STAGE(PG8_SB(0, 1), cB + hstep, voffB); PG8_STAGE(PG8_SA(0, 0), cA, voffA); PG8_STAGE(PG8_SA(0, 1), cA + hstep, voffA);
        if (wr == 1) PG8_BAR;
        PG8_WAIT_V(2); PG8_BAR;
        PG8_STAGE(PG8_SB(1, 0), cB + kstep, voffB); PG8_STAGE(PG8_SA(1, 0), cA + kstep, voffA); PG8_STAGE(PG8_SB(1, 1), cB + hstep + kstep, voffB);
        PG8_WAIT_V(6); PG8_BAR;
    } else {
        PG8_STAGE(PG8_SB(0, 0), cB, voffB); PG8_STAGE(PG8_SA(0, 0), cA, voffA); PG8_STAGE(PG8_SB(0, 1), cB + hstep, voffB); PG8_STAGE(PG8_SA(0, 1), cA + hstep, voffA);
        if (wr == 1) PG8_BAR;
        PG8_WAIT_V(4); PG8_BAR;
        PG8_STAGE(PG8_SB(1, 0), cB + kstep, voffB); PG8_STAGE(PG8_SA(1, 0), cA + kstep, voffA); PG8_STAGE(PG8_SB(1, 1), cB + hstep + kstep, voffB);
        PG8_WAIT_V(6); PG8_BAR;
    }
    for (;;) {
        const bool has_next = S.next(ui + 1, nxt);
        const char* nA = has_next ? (const char*)g.A + (size_t)nxt.pm * tstep : cA; const char* nB = has_next ? (const char*)g.Bt + (size_t)nxt.pn * tstep : cB;
        for (int t = 0; t < nt; t += 2) {
            const bool last = (t == nt - 2);
            const char* a1 = cA + (size_t)(t + 1) * kstep;
            const char* a2 = last ? nA : cA + (size_t)(t + 2) * kstep; const char* b2 = last ? nB : cB + (size_t)(t + 2) * kstep;
            const char* a3 = a2 + kstep; const char* b3 = b2 + kstep;
            if (last && has_next) S.a_ready(nxt);
            if constexpr (SP2) {
            PG8_LDB(B0, 0, 0); PG8_LDB(B1, 0, 1); PG8_SCHED; PG8_LDA(At, 0, 0); PG8_STAGE(PG8_SA(1, 1), a1 + hstep, voffA);
            PG8_WAIT_V(8); PG8_WAIT_L(0); PG8_BAR; PG8_MMA(0, 0, At, B0); PG8_MMA(0, 1, At, B1); PG8_BAR; PG8_SCHED;
            PG8_LDA(At, 0, 1); PG8_STAGE(PG8_SB(0, 0), b2, voffB); PG8_STAGE(PG8_SB(0, 1), b2 + hstep, voffB); PG8_STAGE(PG8_SA(0, 0), a2, voffA);
            PG8_WAIT_V(8); PG8_WAIT_L(0); PG8_BAR; PG8_MMA(1, 0, At, B0); PG8_MMA(1, 1, At, B1); PG8_BAR; PG8_SCHED;
            PG8_LDB(B0, 1, 0); PG8_LDB(B1, 1, 1); PG8_SCHED; PG8_LDA(At, 1, 0); PG8_STAGE(PG8_SA(0, 1), a2 + hstep, voffA);
            PG8_WAIT_V(8); PG8_WAIT_L(0); PG8_BAR; PG8_MMA(0, 0, At, B0); PG8_MMA(0, 1, At, B1); PG8_BAR; PG8_SCHED;
            PG8_LDA(At, 1, 1); PG8_STAGE(PG8_SB(1, 0), b3, voffB); PG8_STAGE(PG8_SB(1, 1), b3 + hstep, voffB); PG8_STAGE(PG8_SA(1, 0), a3, voffA);
            PG8_WAIT_V(8); PG8_WAIT_L(0); PG8_BAR; PG8_MMA(1, 0, At, B0); PG8_MMA(1, 1, At, B1); PG8_BAR; PG8_SCHED;
            } else {
            PG8_LDB(B0, 0, 0); PG8_SCHED; PG8_LDA(At, 0, 0); PG8_STAGE(PG8_SA(1, 1), a1 + hstep, voffA);
            PG8_WAIT_L(8); PG8_BAR; PG8_WAIT_L(0); PG8_MMA(0, 0, At, B0); PG8_BAR; PG8_SCHED;
            PG8_LDB(B1, 0, 1); PG8_STAGE(PG8_SB(0, 0), b2, voffB);
            PG8_BAR; PG8_WAIT_L(0); PG8_MMA(0, 1, At, B1); PG8_BAR;
            PG8_LDA(At, 0, 1); PG8_STAGE(PG8_SA(0, 0), a2, voffA);
            PG8_BAR; PG8_WAIT_L(0); PG8_MMA(1, 0, At, B0); PG8_BAR; PG8_SCHED;
            PG8_STAGE(PG8_SB(0, 1), b2 + hstep, voffB);
            PG8_WAIT_V(6); PG8_BAR; PG8_MMA(1, 1, At, B1); PG8_BAR;
            PG8_LDB(B0, 1, 0); PG8_SCHED; PG8_LDA(At, 1, 0); PG8_STAGE(PG8_SA(0, 1), a2 + hstep, voffA);
            PG8_WAIT_L(8); PG8_BAR; PG8_WAIT_L(0); PG8_MMA(0, 0, At, B0); PG8_BAR; PG8_SCHED;
            PG8_LDB(B1, 1, 1); PG8_STAGE(PG8_SB(1, 0), b3, voffB);
            PG8_BAR; PG8_WAIT_L(0); PG8_MMA(0, 1, At, B1); PG8_BAR;
            PG8_LDA(At, 1, 1); PG8_STAGE(PG8_SA(1, 0), a3, voffA);
            PG8_BAR; PG8_WAIT_L(0); PG8_MMA(1, 0, At, B0); PG8_BAR; PG8_SCHED;
            PG8_STAGE(PG8_SB(1, 1), b3 + hstep, voffB);
            PG8_WAIT_V(6); PG8_BAR; PG8_MMA(1, 1, At, B1); PG8_BAR;
            }
        }
        if constexpr (ALIGN_EPI) { if (wr == 0) PG8_BAR; }
        if constexpr (!Epi::AFTER_DRAIN) { E(acc, cur, wr, wc, fr, fq); S.done(cur); }
        if (!has_next) break;
#pragma unroll
        for (int a = 0; a < 2; ++a)
#pragma unroll
            for (int b = 0; b < 2; ++b)
#pragma unroll
                for (int m = 0; m < 4; ++m)
#pragma unroll
                    for (int n = 0; n < 2; ++n) acc[a][b][m][n] = (f32x4){0.f, 0.f, 0.f, 0.f};
        cur = nxt; cA = nA; cB = nB; ++ui;
        if constexpr (ALIGN_EPI) { if (wr == 1) PG8_BAR; }
    }
    PG8_WAIT_V(0);
    if constexpr (!ALIGN_EPI) { if (wr == 0) PG8_BAR; }
    PG8_BAR;
    if constexpr (Epi::AFTER_DRAIN) { E.fused(acc, cur, wr, wc, fr, fq, lds, wid, lane); S.done(cur); }
#undef PG8_SA
#undef PG8_SB
#undef PG8_STAGE
#undef PG8_LDA
#undef PG8_LDB
#undef PG8_MMA
#undef PG8_WAIT_V
#undef PG8_WAIT_L
#undef PG8_BAR
#undef PG8_SCHED
}
}

namespace att {
using bf16 = __hip_bfloat16;
constexpr int   D = 128, NW = 8, QBLK = 32, KVBLK = 64;
constexpr float SCALE = 0.088388347648318440f;
constexpr float THR = 8.f;
constexpr int SDEPTH = ATT_SDEPTH;
constexpr int LDQ = 1024, LDK = 256, LDO = 1024;
constexpr size_t SHM_V = KVBLK * D * 2, SHM_K = KVBLK * D * 2, SHM_ATTN = 2 * SHM_V + 2 * SHM_K + NW * 64 * 4;
constexpr size_t OST_OFF = 69632;
using bf16x8 = __attribute__((ext_vector_type(8))) short;
using s16x4  = __attribute__((ext_vector_type(4))) short;
using f32x16 = __attribute__((ext_vector_type(16))) float;
using f32x8  = __attribute__((ext_vector_type(8))) float;
using u32x4  = __attribute__((ext_vector_type(4))) unsigned;
#define KSWZ(row, colB) ((row) * 256 + ((colB) ^ (((row) & 7) << 4)))
#define SBAR() __builtin_amdgcn_sched_barrier(0)
__device__ __forceinline__ int crow(int r, int hi) { return (r & 3) + 8 * (r >> 2) + 4 * hi; }
__device__ __forceinline__ unsigned cvtpk(float lo, float hi) {
  unsigned r; asm volatile("v_cvt_pk_bf16_f32 %0, %1, %2" : "=v"(r) : "v"(lo), "v"(hi)); return r;
}
template <typename TIn> struct Stage;
template <> struct Stage<bf16>  { using T = bf16x8;
  __device__ static __forceinline__ T ld8(const bf16* p) { return *reinterpret_cast<const bf16x8*>(p); }
  __device__ static __forceinline__ bf16x8 tobf(T x) { return x; } };
template <> struct Stage<float> { using T = f32x8;
  __device__ static __forceinline__ T ld8(const float* p) { return *reinterpret_cast<const f32x8*>(p); }
  __device__ static __forceinline__ bf16x8 tobf(T x) {
    u32x4 w = {cvtpk(x[0], x[1]), cvtpk(x[2], x[3]), cvtpk(x[4], x[5]), cvtpk(x[6], x[7])}; return *reinterpret_cast<bf16x8*>(&w); } };

__device__ __forceinline__ void partialSM(f32x16& p0, f32x16& p1, float& m_reg, float& mn, float& alpha) {
  constexpr float C = SCALE * 1.4426950408889634f;
  float pmax = p0[0]; for (int r = 1; r < 16; ++r) pmax = fmaxf(pmax, p0[r]); for (int r = 0; r < 16; ++r) pmax = fmaxf(pmax, p1[r]);
  { auto rr = __builtin_amdgcn_permlane32_swap(__float_as_uint(pmax), __float_as_uint(pmax), false, false);
    pmax = fmaxf(__uint_as_float(rr[0]), __uint_as_float(rr[1])); }
  if (__builtin_expect(__all(pmax - m_reg <= THR / SCALE), 1)) { mn = m_reg; alpha = 1.f; }
  else { mn = fmaxf(m_reg, pmax); alpha = __builtin_amdgcn_exp2f((m_reg - mn) * C); m_reg = mn; }
  float mnC = -mn * C;
  for (int r = 0; r < 16; ++r) p0[r] = fmaf(p0[r], C, mnC); for (int r = 0; r < 16; ++r) p1[r] = fmaf(p1[r], C, mnC);
  for (int r = 0; r < 16; ++r) p0[r] = __builtin_amdgcn_exp2f(p0[r]);
}
__device__ __forceinline__ void finishSM(f32x16& p0, f32x16& p1, float alpha, float& l_reg, bf16x8& pa0, bf16x8& pa1, bf16x8& pa2, bf16x8& pa3) {
  for (int r = 0; r < 16; ++r) p1[r] = __builtin_amdgcn_exp2f(p1[r]);
  float ps = 0; for (int r = 0; r < 16; ++r) ps += p0[r]; for (int r = 0; r < 16; ++r) ps += p1[r];
  { auto rr = __builtin_amdgcn_permlane32_swap(__float_as_uint(ps), __float_as_uint(ps), false, false);
    ps = __uint_as_float(rr[0]) + __uint_as_float(rr[1]); }
  l_reg = l_reg * alpha + ps;
#define PK4(P, BASE, OUT) do { unsigned a0 = cvtpk(P[BASE + 0], P[BASE + 1]), a1 = cvtpk(P[BASE + 2], P[BASE + 3]);   \
    unsigned b0 = cvtpk(P[BASE + 4], P[BASE + 5]), b1 = cvtpk(P[BASE + 6], P[BASE + 7]);                              \
    auto r0 = __builtin_amdgcn_permlane32_swap(a0, b0, false, false); auto r1 = __builtin_amdgcn_permlane32_swap(a1, b1, false, false); \
    u32x4 w = {r0[0], r1[0], r0[1], r1[1]}; OUT = *reinterpret_cast<bf16x8*>(&w); } while (0)
  PK4(p0, 0, pa0); PK4(p0, 8, pa1); PK4(p1, 0, pa2); PK4(p1, 8, pa3);
#undef PK4
}
__device__ __forceinline__ void qkt(f32x16& p0, f32x16& p1, const bf16* Ks, const bf16x8* qr, int r32, int hi) {
  p0 = f32x16{}; p1 = f32x16{};
  for (int d0 = 0; d0 < 8; ++d0) { int cb = (d0 * 16 + hi * 8) * 2;
    bf16x8 b0 = *reinterpret_cast<const bf16x8*>((const char*)Ks + KSWZ(r32, cb));
    bf16x8 b1 = *reinterpret_cast<const bf16x8*>((const char*)Ks + KSWZ(32 + r32, cb));
    p0 = __builtin_amdgcn_mfma_f32_32x32x16_bf16(b0, qr[d0], p0, 0, 0, 0);
    p1 = __builtin_amdgcn_mfma_f32_32x32x16_bf16(b1, qr[d0], p1, 0, 0, 0); }
}
__device__ __forceinline__ int v_st(int k, int c) { const int kk = (k & ~0xC) | ((k & 4) << 1) | ((k & 8) >> 1); return ((kk >> 3) * 4 + (c >> 5)) * 512 + ((kk & 7) * 32 + (c & 31)) * 2; }
__device__ __forceinline__ int v_rd_base(int lane) { return ((lane & 3) << 3) | (((lane >> 2) & 3) << 6) | (((lane >> 4) & 1) << 5) | (((lane >> 5) & 1) << 8); }
constexpr int v_rd_off(int d0, int ks, int half) { return d0 * 512 + ks * 4096 + half * 2048; }
template <int OFF> __device__ __forceinline__ s16x4 tr_read(int vb) {
  s16x4 r; asm volatile("ds_read_b64_tr_b16 %0, %1 offset:%2" : "=&v"(r) : "v"(vb), "i"(OFF) : "memory"); return r;
}
template <int D0> __device__ __forceinline__ void pv_one(f32x16& od, int vb, bf16x8 pa0, bf16x8 pa1, bf16x8 pa2, bf16x8 pa3) {
  const s16x4 l0 = tr_read<v_rd_off(D0, 0, 0)>(vb), h0 = tr_read<v_rd_off(D0, 0, 1)>(vb), l1 = tr_read<v_rd_off(D0, 1, 0)>(vb), h1 = tr_read<v_rd_off(D0, 1, 1)>(vb);
  const s16x4 l2 = tr_read<v_rd_off(D0, 2, 0)>(vb), h2 = tr_read<v_rd_off(D0, 2, 1)>(vb), l3 = tr_read<v_rd_off(D0, 3, 0)>(vb), h3 = tr_read<v_rd_off(D0, 3, 1)>(vb);
  asm volatile("s_waitcnt lgkmcnt(0)" ::: "memory"); SBAR();
#define PK(L, H) (bf16x8){L[0], L[1], L[2], L[3], H[0], H[1], H[2], H[3]}
  od = __builtin_amdgcn_mfma_f32_32x32x16_bf16(pa0, PK(l0, h0), od, 0, 0, 0);
  od = __builtin_amdgcn_mfma_f32_32x32x16_bf16(pa1, PK(l1, h1), od, 0, 0, 0);
  od = __builtin_amdgcn_mfma_f32_32x32x16_bf16(pa2, PK(l2, h2), od, 0, 0, 0);
  od = __builtin_amdgcn_mfma_f32_32x32x16_bf16(pa3, PK(l3, h3), od, 0, 0, 0);
#undef PK
}
__device__ __forceinline__ void pv_d0(f32x16* o, int vb, bf16x8 pa0, bf16x8 pa1, bf16x8 pa2, bf16x8 pa3) {
  pv_one<0>(o[0], vb, pa0, pa1, pa2, pa3); pv_one<1>(o[1], vb, pa0, pa1, pa2, pa3); pv_one<2>(o[2], vb, pa0, pa1, pa2, pa3); pv_one<3>(o[3], vb, pa0, pa1, pa2, pa3);
}

__device__ __forceinline__ float bf2f(short s) { return __uint_as_float(((unsigned)(unsigned short)s) << 16); }

__device__ __forceinline__ void qkt2(f32x16& p0, f32x16& p1, const bf16* Ks, const bf16x8* qr, const f32x16& negm, int r32, int hi) {
  p0 = negm; p1 = negm;
#pragma unroll
  for (int d0 = 0; d0 < 8; ++d0) { int cb = (d0 * 16 + hi * 8) * 2;
    bf16x8 b0 = *reinterpret_cast<const bf16x8*>((const char*)Ks + KSWZ(r32, cb));
    bf16x8 b1 = *reinterpret_cast<const bf16x8*>((const char*)Ks + KSWZ(32 + r32, cb));
    p0 = __builtin_amdgcn_mfma_f32_32x32x16_bf16(b0, qr[d0], p0, 0, 0, 0); p1 = __builtin_amdgcn_mfma_f32_32x32x16_bf16(b1, qr[d0], p1, 0, 0, 0); }
}
__device__ __forceinline__ void expA(f32x16& p0, float negmc) {
#pragma unroll
  for (int r = 0; r < 16; ++r) p0[r] = __builtin_amdgcn_exp2f(ATT_NEGM ? p0[r] : p0[r] + negmc);
}
__device__ __forceinline__ void finishSM2(f32x16& p0, f32x16& p1, float negmc, float& l_reg, bf16x8& pa0, bf16x8& pa1, bf16x8& pa2, bf16x8& pa3) {
#pragma unroll
  for (int r = 0; r < 16; ++r) p1[r] = __builtin_amdgcn_exp2f(ATT_NEGM ? p1[r] : p1[r] + negmc);
  float ps = 0;
#pragma unroll
  for (int r = 0; r < 16; ++r) ps += p0[r];
#pragma unroll
  for (int r = 0; r < 16; ++r) ps += p1[r];
  l_reg += ps;
#define PK4(P, BASE, OUT) do { unsigned a0 = cvtpk(P[BASE + 0], P[BASE + 1]), a1 = cvtpk(P[BASE + 2], P[BASE + 3]);   \
    unsigned b0 = cvtpk(P[BASE + 4], P[BASE + 5]), b1 = cvtpk(P[BASE + 6], P[BASE + 7]);                              \
    auto r0 = __builtin_amdgcn_permlane32_swap(a0, b0, false, false); auto r1 = __builtin_amdgcn_permlane32_swap(a1, b1, false, false); \
    u32x4 w = {r0[0], r1[0], r0[1], r1[1]}; OUT = *reinterpret_cast<bf16x8*>(&w); } while (0)
  PK4(p0, 0, pa0); PK4(p0, 8, pa1); PK4(p1, 0, pa2); PK4(p1, 8, pa3);
#undef PK4
}

__device__ __forceinline__ void attn_unit(const bf16* Qb, const bf16* __restrict__ Kh, const bf16* __restrict__ Vh,
                                          bf16* Ob, int seq, int t0, const float* __restrict__ qgain, const float2* __restrict__ rope, float negmc, char* lds) {
  using St = Stage<bf16>;
  const int tid = mk_tid(), wid = tid >> 6, lane = tid & 63, r32 = lane & 31, hi = lane >> 5;
  bf16* V_lds = (bf16*)lds; bf16* K_lds = (bf16*)(lds + 2 * SHM_V);
  float* ws = (float*)(lds + 2 * SHM_V + 2 * SHM_K) + wid * 64; float* li_l = ws;
  float l_reg = 0; f32x16 o[4] = {}; bf16x8 qr[8]; f32x16 negm; for (int r = 0; r < 16; ++r) negm[r] = ATT_NEGM ? negmc : 0.f; if (ATT_NEGM) asm volatile("" : "+v"(negm));
  const bf16* Qw = Qb + (long)(wid * QBLK + r32) * LDQ + hi * 8;
#pragma unroll
  for (int d0 = 0; d0 < 8; ++d0) qr[d0] = St::ld8(Qw + d0 * 16);
  (void)t0; (void)qgain; (void)rope;
  const int sr = tid >> 4, sc = (tid & 15) * 8, vst0 = v_st(sr, sc), vst1 = v_st(32 + sr, sc);
  const int vb0 = (int)(uintptr_t)V_lds + v_rd_base(lane);
  struct { typename St::T vs0, vs1, ks0, ks1; } sr_[SDEPTH];
#define SLOAD(i, k0) do { sr_[i].vs0 = St::ld8(&Vh[(long)((k0) + sr) * LDK + sc]); sr_[i].vs1 = St::ld8(&Vh[(long)((k0) + 32 + sr) * LDK + sc]); \
    sr_[i].ks0 = St::ld8(&Kh[(long)((k0) + sr) * LDK + sc]); sr_[i].ks1 = St::ld8(&Kh[(long)((k0) + 32 + sr) * LDK + sc]); } while (0)
#define SWRITE(b, i) do { *(bf16x8*)((char*)V_lds + (b) * SHM_V + vst0) = St::tobf(sr_[i].vs0);          \
    *(bf16x8*)((char*)V_lds + (b) * SHM_V + vst1) = St::tobf(sr_[i].vs1); int kc = sc * 2;               \
    *(bf16x8*)((char*)K_lds + (b) * SHM_K + KSWZ(sr, kc)) = St::tobf(sr_[i].ks0);                       \
    *(bf16x8*)((char*)K_lds + (b) * SHM_K + KSWZ(32 + sr, kc)) = St::tobf(sr_[i].ks1); } while (0)
#define SWAIT() do { if constexpr (SDEPTH == 2) asm volatile("s_waitcnt vmcnt(4)" ::: "memory"); else asm volatile("s_waitcnt vmcnt(0)" ::: "memory"); } while (0)
  f32x16 pA0, pA1, pB0, pB1; bf16x8 pa0, pa1, pa2, pa3; const int NT = seq / KVBLK;
  constexpr int SE = 0, SO = SDEPTH - 1;
  SLOAD(SE, 0); asm volatile("s_waitcnt vmcnt(0)" ::: "memory"); SWRITE(0, SE); __syncthreads();
  qkt2(pA0, pA1, K_lds, qr, negm, r32, hi); expA(pA0, negmc);
  SLOAD(SO, KVBLK); if constexpr (SDEPTH == 2) { if (2 < NT) SLOAD(SE, 2 * KVBLK); }
  SWAIT(); SWRITE(1, SO); __syncthreads();
  for (int j = 1; j + 1 < NT; j += 2) {
    SBAR(); qkt2(pB0, pB1, (bf16*)((char*)K_lds + SHM_K), qr, negm, r32, hi); if (ATT_SB) SBAR();
    finishSM2(pA0, pA1, negmc, l_reg, pa0, pa1, pa2, pa3); SBAR();
    SLOAD(SO, (j + SDEPTH) * KVBLK); SBAR();
    pv_d0(o, vb0, pa0, pa1, pa2, pa3); SBAR(); expA(pB0, negmc); SBAR();
    __syncthreads(); SWAIT(); SWRITE(0, SE);
    __syncthreads();
    SBAR(); qkt2(pA0, pA1, K_lds, qr, negm, r32, hi); if (ATT_SB) SBAR();
    finishSM2(pB0, pB1, negmc, l_reg, pa0, pa1, pa2, pa3); SBAR();
    if (SDEPTH == 1 || j + 3 < NT) SLOAD(SE, (j + 1 + SDEPTH) * KVBLK); SBAR();
    pv_d0(o, vb0 + (int)SHM_V, pa0, pa1, pa2, pa3); SBAR(); expA(pA0, negmc); SBAR();
    __syncthreads(); SWAIT(); SWRITE(1, SO);
    __syncthreads();
  }
  SBAR(); qkt2(pB0, pB1, (bf16*)((char*)K_lds + SHM_K), qr, negm, r32, hi);
  finishSM2(pA0, pA1, negmc, l_reg, pa0, pa1, pa2, pa3); SBAR();
  pv_d0(o, vb0, pa0, pa1, pa2, pa3); expA(pB0, negmc);
  __syncthreads();
  finishSM2(pB0, pB1, negmc, l_reg, pa0, pa1, pa2, pa3); SBAR();
  pv_d0(o, vb0 + (int)SHM_V, pa0, pa1, pa2, pa3);
  { auto rr = __builtin_amdgcn_permlane32_swap(__float_as_uint(l_reg), __float_as_uint(l_reg), false, false); l_reg = __uint_as_float(rr[0]) + __uint_as_float(rr[1]); }
  if (hi == 0) li_l[r32] = l_reg; asm volatile("s_waitcnt lgkmcnt(0)" ::: "memory");
  float rli[16];
#pragma unroll
  for (int r = 0; r < 16; ++r) rli[r] = __builtin_amdgcn_rcpf(li_l[crow(r, hi)]);
  { bf16* stg = (bf16*)(lds + OST_OFF) + wid * (32 * 128);
#pragma unroll
    for (int r = 0; r < 16; ++r) { const int orow = crow(r, hi);
#pragma unroll
      for (int d0 = 0; d0 < 4; ++d0) stg[orow * 128 + d0 * 32 + r32] = __float2bfloat16(o[d0][r] * rli[r]); }
    asm volatile("s_waitcnt lgkmcnt(0)" ::: "memory");
    bf16* Ow = Ob + (long)(wid * QBLK) * LDO;
#pragma unroll
    for (int i = 0; i < 8; ++i) { const int row = i * 4 + (lane >> 4), ch = lane & 15; const u32x4 v = *(const u32x4*)(stg + row * 128 + ch * 8); *(u32x4*)(Ow + (long)row * LDO + ch * 8) = v; }
    asm volatile("s_waitcnt lgkmcnt(0)" ::: "memory"); }
  __syncthreads();
#undef SLOAD
#undef SWRITE
#undef SWAIT
}
}

#define LAS __attribute__((address_space(3)))
typedef unsigned short bf16_t;
typedef unsigned v4u __attribute__((ext_vector_type(4)));
typedef float f32x4 __attribute__((ext_vector_type(4)));
typedef float f32x16 __attribute__((ext_vector_type(16)));
typedef short bf16x8 __attribute__((ext_vector_type(8)));
typedef short s16x4 __attribute__((ext_vector_type(4)));
#define LDS_WAIT() asm volatile("s_waitcnt lgkmcnt(0)" ::: "memory")

constexpr int NWAVES = 8, NTHREADS = 512;
constexpr int DM = 1024, DFF = 2816, NQKV = 1536;
constexpr int NTOK_P = 16384, NTOK_S = 32768, NTOK = 49152, SEQ_P = 8192, SEQ_S = 4096, NB_P = 2, NB_S = 8;
constexpr float EPS = 1e-6f;
constexpr size_t MiB = 1u << 20;
constexpr size_t WS_WGU = 1 * MiB, WS_WD = 45 * MiB, WS_WQKV = 67 * MiB, WS_WO = 73 * MiB, WS_W2 = 77 * MiB, WS_A1P = 85 * MiB, WS_A1S = 89 * MiB, WS_A2 = 90 * MiB, WS_ROPE = 90 * MiB + 65536, WS_QKG = 90 * MiB + 131072;
constexpr size_t WS_POOL = 92 * MiB, WS_RSS = 476 * MiB, WS_END = 482 * MiB, WS_TS = 90 * MiB + 196608;
constexpr size_t WS_F = WS_POOL, WS_T = WS_POOL + 192 * MiB, WS_HID = WS_POOL, WS_QO = WS_POOL, WS_K = WS_POOL + 96 * MiB, WS_V = WS_POOL + 120 * MiB, WS_XH = WS_POOL + 288 * MiB;
constexpr size_t RSS_STRIDE = (size_t)49152 * 4;
constexpr int LDS_BYTES = 147456;

__device__ __forceinline__ unsigned f2bf(float f) { unsigned u = __builtin_bit_cast(unsigned, f); return (u + 0x7fffu + ((u >> 16) & 1u)) >> 16; }
__device__ __forceinline__ unsigned pk2(float lo, float hi) { return f2bf(lo) | (f2bf(hi) << 16); }
__device__ __forceinline__ float wave_sum(float v) {
#pragma unroll
    for (int o = 1; o < 64; o <<= 1) v += __shfl_xor(v, o);
    return v;
}

template <class RowMap>
__device__ __forceinline__ void transpose_item(const float* __restrict__ W, int K, int N, bf16_t* WT, int ldk, const float* __restrict__ gain, RowMap rm, LAS float* scr, int item, int lane) {
    const int nblk = N / 64, kb = item / nblk, nb = item % nblk, k0 = 64 * kb, n0 = 64 * nb;
#pragma unroll
    for (int h = 0; h < 2; ++h) {
        float v[32];
#pragma unroll
        for (int i = 0; i < 32; ++i) v[i] = W[(size_t)(k0 + 32 * h + i) * N + n0 + lane];
#pragma unroll
        for (int i = 0; i < 32; ++i) { const int kk = 32 * h + i; float x = v[i]; if (gain) x *= gain[k0 + kk]; scr[kk * 64 + (lane ^ (kk & 0x38))] = x; }
    }
    LDS_WAIT(); asm volatile("" ::: "memory");
    const int c = lane & 7;
#pragma unroll
    for (int j = 0; j < 8; ++j) { const int n = (lane >> 3) + 8 * j; const LAS float* s = scr + (8 * c) * 64 + (n ^ (8 * c));
        v4u o; o.x = pk2(s[0 * 64], s[1 * 64]); o.y = pk2(s[2 * 64], s[3 * 64]); o.z = pk2(s[4 * 64], s[5 * 64]); o.w = pk2(s[6 * 64], s[7 * 64]);
        *(v4u*)(WT + (size_t)rm(n0 + n) * ldk + k0 + 8 * c) = o; }
    LDS_WAIT(); asm volatile("" ::: "memory");
}
struct RmId { __device__ __forceinline__ int operator()(int n) const { return n; } };
struct RmGU { int off; __device__ __forceinline__ int operator()(int n) const { return ((n >> 7) << 8) + (n & 127) + off; } };

__device__ __forceinline__ void cvt_row2(const float* xa, const float* xb, bf16_t* oa, bf16_t* ob, float* ra, float* rb, int lane) {
    const f32x4* pa = (const f32x4*)xa + lane; const f32x4* pb = (const f32x4*)xb + lane;
    f32x4 va[4], vb[4]; float sa = 0.f, sb = 0.f;
#pragma unroll
    for (int j = 0; j < 4; ++j) { va[j] = pa[64 * j]; vb[j] = pb[64 * j]; }
#pragma unroll
    for (int j = 0; j < 4; ++j) { sa += (va[j].x * va[j].x + va[j].y * va[j].y) + (va[j].z * va[j].z + va[j].w * va[j].w); sb += (vb[j].x * vb[j].x + vb[j].y * vb[j].y) + (vb[j].z * vb[j].z + vb[j].w * vb[j].w); }
    unsigned long long* qa = (unsigned long long*)oa + lane; unsigned long long* qb = (unsigned long long*)ob + lane;
#pragma unroll
    for (int j = 0; j < 4; ++j) { qa[64 * j] = (unsigned long long)pk2(va[j].x, va[j].y) | ((unsigned long long)pk2(va[j].z, va[j].w) << 32); qb[64 * j] = (unsigned long long)pk2(vb[j].x, vb[j].y) | ((unsigned long long)pk2(vb[j].z, vb[j].w) << 32); }
    sa = wave_sum(sa); sb = wave_sum(sb);
    if (lane == 0) { *(f32x4*)ra = (f32x4){sa, 0.f, 0.f, 0.f}; *(f32x4*)rb = (f32x4){sb, 0.f, 0.f, 0.f}; }
}

template <int OFF> __device__ __forceinline__ s16x4 tr_read_off(unsigned vb) {
    s16x4 r; asm volatile("ds_read_b64_tr_b16 %0, %1 offset:%2" : "=&v"(r) : "v"(vb), "i"(OFF) : "memory"); return r;
}
template <int KS, int NKS> struct BLoad {
    static __device__ __forceinline__ void run(bf16x8 (&b0)[NKS], bf16x8 (&b1)[NKS], unsigned base0, unsigned base1) {
        const s16x4 l0 = tr_read_off<(16 * KS) * 128>(base0), h0 = tr_read_off<(16 * KS + 4) * 128>(base0);
        const s16x4 l1 = tr_read_off<(16 * KS) * 128>(base1), h1 = tr_read_off<(16 * KS + 4) * 128>(base1);
        asm volatile("s_waitcnt lgkmcnt(0)" ::: "memory");
        b0[KS] = (bf16x8){l0[0], l0[1], l0[2], l0[3], h0[0], h0[1], h0[2], h0[3]};
        b1[KS] = (bf16x8){l1[0], l1[1], l1[2], l1[3], h1[0], h1[1], h1[2], h1[3]};
        if constexpr (KS + 1 < NKS) BLoad<KS + 1, NKS>::run(b0, b1, base0, base1);
    }
};
template <int KT, int MT, bool SC>
__device__ __forceinline__ void fft_unit(const bf16_t* __restrict__ A, const bf16_t* __restrict__ in, size_t in_stride, bf16_t* out, size_t so1, size_t so0, char* wl, int lane, const float* rs = nullptr, size_t rs_stride = 0) {
    constexpr int NKS = KT / 16;
    const int r32 = lane & 31, hi = lane >> 5;
    { const int lr = lane >> 3, ch = lane & 7;
      v4u dv[KT / 8]; f32x4 pq[SC ? KT / 8 : 1];
#pragma unroll
      for (int i = 0; i < KT / 8; ++i) dv[i] = *(const v4u*)(in + (size_t)(i * 8 + lr) * in_stride + ch * 8);
      if constexpr (SC) {
#pragma unroll
          for (int i = 0; i < KT / 8; ++i) pq[i] = *(const f32x4*)(rs + (size_t)(i * 8 + lr) * rs_stride * 4);
      }
#pragma unroll
      for (int i = 0; i < KT / 8; ++i) { const int row = i * 8 + lr; v4u v = dv[i];
          if constexpr (SC) { const float r = __builtin_amdgcn_rsqf(((pq[i][0] + pq[i][1]) + (pq[i][2] + pq[i][3])) * (1.0f / 1024.0f) + 1e-6f);
              v.x = pg8::cvt_pk_bf16(pg8::bflo(v.x) * r, pg8::bfhi(v.x) * r); v.y = pg8::cvt_pk_bf16(pg8::bflo(v.y) * r, pg8::bfhi(v.y) * r); v.z = pg8::cvt_pk_bf16(pg8::bflo(v.z) * r, pg8::bfhi(v.z) * r); v.w = pg8::cvt_pk_bf16(pg8::bflo(v.w) * r, pg8::bfhi(v.w) * r); }
          *(v4u*)(wl + row * 128 + 16 * (ch ^ (((row >> 1) & 1) << 2))) = v; } }
    LDS_WAIT(); asm volatile("" ::: "memory");
    bf16x8 b0[NKS], b1[NKS];
    { const int blk = (lane >> 4) & 1, q = (lane & 15) >> 2, p = lane & 3, qb = (q >> 1) & 1;
      const unsigned basel = (unsigned)(uintptr_t)wl + (unsigned)((8 * hi + q) * 128 + 16 * (2 * blk + (p >> 1)) + 8 * (p & 1));
      BLoad<0, NKS>::run(b0, b1, basel + 64u * (unsigned)qb, basel + 64u * (unsigned)(1 - qb)); }
    asm volatile("" ::: "memory");
    bf16_t* stg = (bf16_t*)wl;
    bf16x8 af[NKS], an[NKS];
#pragma unroll
    for (int ks = 0; ks < NKS; ++ks) an[ks] = *(const bf16x8*)(A + (size_t)r32 * KT + 16 * ks + 8 * hi);
#pragma unroll 1
    for (int mb = 0; mb < MT / 32; ++mb) {
#pragma unroll
        for (int ks = 0; ks < NKS; ++ks) af[ks] = an[ks];
        { const int mbn = mb + 1 < MT / 32 ? mb + 1 : mb;
#pragma unroll
          for (int ks = 0; ks < NKS; ++ks) an[ks] = *(const bf16x8*)(A + (size_t)(32 * mbn + r32) * KT + 16 * ks + 8 * hi); }
        f32x16 c0 = {}, c1 = {};
#pragma unroll
        for (int ks = 0; ks < NKS; ++ks) { c0 = __builtin_amdgcn_mfma_f32_32x32x16_bf16(af[ks], b0[ks], c0, 0, 0, 0); c1 = __builtin_amdgcn_mfma_f32_32x32x16_bf16(af[ks], b1[ks], c1, 0, 0, 0); }
#pragma unroll
        for (int r = 0; r < 16; ++r) { const int orow = (r & 3) + 8 * (r >> 2) + 4 * hi; stg[orow * 64 + r32] = (bf16_t)f2bf(c0[r]); stg[orow * 64 + 32 + r32] = (bf16_t)f2bf(c1[r]); }
        LDS_WAIT(); asm volatile("" ::: "memory");
#pragma unroll
        for (int i = 0; i < 4; ++i) { const int row = i * 8 + (lane >> 3), ch = lane & 7, m = 32 * mb + row; const v4u v = *(const v4u*)(stg + row * 64 + ch * 8);
            *(v4u*)(out + (size_t)(m >> 1) * so1 + (size_t)(m & 1) * so0 + ch * 8) = v; }
        LDS_WAIT(); asm volatile("" ::: "memory");
    }
}

typedef __attribute__((address_space(1))) unsigned gu32;
#define XB_TMO      128
#define XB_XCNT(j)  (256  + 64 * (j))
#define XB_XSUB(j)  (1280 + 64 * (j))
#define XB_XGEN(j)  (2304 + 64 * (j))
#define XB_TOP      3328
#define XB_TOPGEN   3392
#define XCD_BAR_WORDS 3456
#define XB_SPIN_CAP (1u << 22)

__device__ __forceinline__ unsigned xb_ld(unsigned* p)              { return __hip_atomic_load(p, __ATOMIC_RELAXED, __HIP_MEMORY_SCOPE_AGENT); }
__device__ __forceinline__ unsigned xb_add(unsigned* p, unsigned v) { return __hip_atomic_fetch_add(p, v, __ATOMIC_RELAXED, __HIP_MEMORY_SCOPE_AGENT); }
__device__ __forceinline__ unsigned xb_xcc_id() { return (unsigned)__builtin_amdgcn_s_getreg((3 << 11) | 20) & 0xFu; }
#define XB_SPIN(cond, bar) do { unsigned _sp = 0; while (cond) { __builtin_amdgcn_s_sleep(1); \
    if ((++_sp & 255u) == 0u) { if (xb_ld(&(bar)[XB_TMO])) break; if (_sp > XB_SPIN_CAP) { atomicAdd(&(bar)[XB_TMO], 1u); break; } } } } while (0)

struct XcdBarrier {
    unsigned* bar; unsigned x;
    volatile LAS unsigned* st;
};

__device__ __forceinline__ XcdBarrier xcd_barrier_post(unsigned* bar, volatile LAS unsigned* st) {
    XcdBarrier b; b.bar = bar; b.x = xb_xcc_id(); b.st = st;
    if (threadIdx.x == 0) (void)xb_add(&bar[XB_XCNT(b.x)], 1u);
    return b;
}
__device__ __forceinline__ void xcd_barrier_complete(unsigned* bar, unsigned x, unsigned& nloc, unsigned& nx) {
    const unsigned G = gridDim.x * gridDim.y * gridDim.z;
    unsigned sum, cnt, mine, sp = 0u;
    for (;;) {
        sum = 0u; cnt = 0u; mine = 0u;
#pragma unroll
        for (unsigned j = 0; j < 16; ++j) { const unsigned c = xb_ld(&bar[XB_XCNT(j)]); sum += c; cnt += (c > 0u) ? 1u : 0u; mine = (j == x) ? c : mine; }
        if (sum == G) break;
        __builtin_amdgcn_s_sleep(1);
        if ((++sp & 255u) == 0u) { if (xb_ld(&bar[XB_TMO])) break; if (sp > XB_SPIN_CAP) { atomicAdd(&bar[XB_TMO], 1u); break; } }
    }
    nloc = mine > 0u ? mine : 1u; nx = cnt > 0u ? cnt : 1u;
}

__device__ __forceinline__ void xcd_barrier(const XcdBarrier& b) {
    asm volatile("s_waitcnt vmcnt(0)" ::: "memory");
    __syncthreads();
    if (threadIdx.x == 0) {
        unsigned* bar = b.bar;
        __builtin_amdgcn_s_waitcnt(0);
        unsigned nloc = b.st[0], nx = b.st[1];
        if (nloc == 0u) { xcd_barrier_complete(bar, b.x, nloc, nx); b.st[0] = nloc; b.st[1] = nx; }
        const unsigned old = xb_add(&bar[XB_XSUB(b.x)], 1u);
        const unsigned gen = old / nloc;
        if (old + 1u == (gen + 1u) * nloc) {
            __builtin_amdgcn_fence(__ATOMIC_RELEASE, "agent");
            asm volatile("s_waitcnt vmcnt(0)" ::: "memory");
            const unsigned og = xb_add(&bar[XB_TOP], 1u);
            const unsigned tg = og / nx;
            if (og + 1u == (tg + 1u) * nx) xb_add(&bar[XB_TOPGEN], 1u);
            else XB_SPIN(xb_ld(&bar[XB_TOPGEN]) == tg, bar);
            __builtin_amdgcn_fence(__ATOMIC_ACQUIRE, "agent");
            xb_add(&bar[XB_XGEN(b.x)], 1u);
            asm volatile("s_waitcnt vmcnt(0)" ::: "memory");
        } else {
            XB_SPIN(xb_ld(&bar[XB_XGEN(b.x)]) == gen, bar);
            __builtin_amdgcn_fence(__ATOMIC_ACQUIRE, "agent");
            asm volatile("s_waitcnt vmcnt(0)" ::: "memory");
        }
    }
    __syncthreads();
}
constexpr int NPH_C = 21;
__device__ const float CS128[256] = {1.000000000e+00f, 9.987954562e-01f, 9.951847267e-01f, 9.891765100e-01f, 9.807852804e-01f, 9.700312532e-01f, 9.569403357e-01f, 9.415440652e-01f, 9.238795325e-01f, 9.039892931e-01f, 8.819212643e-01f, 8.577286100e-01f, 8.314696123e-01f, 8.032075315e-01f, 7.730104534e-01f, 7.409511254e-01f, 7.071067812e-01f, 6.715589548e-01f, 6.343932842e-01f, 5.956993045e-01f, 5.555702330e-01f, 5.141027442e-01f, 4.713967368e-01f, 4.275550934e-01f, 3.826834324e-01f, 3.368898534e-01f, 2.902846773e-01f, 2.429801799e-01f, 1.950903220e-01f, 1.467304745e-01f, 9.801714033e-02f, 4.906767433e-02f, 6.123233996e-17f, -4.906767433e-02f, -9.801714033e-02f, -1.467304745e-01f, -1.950903220e-01f, -2.429801799e-01f, -2.902846773e-01f, -3.368898534e-01f, -3.826834324e-01f, -4.275550934e-01f, -4.713967368e-01f, -5.141027442e-01f, -5.555702330e-01f, -5.956993045e-01f, -6.343932842e-01f, -6.715589548e-01f, -7.071067812e-01f, -7.409511254e-01f, -7.730104534e-01f, -8.032075315e-01f, -8.314696123e-01f, -8.577286100e-01f, -8.819212643e-01f, -9.039892931e-01f, -9.238795325e-01f, -9.415440652e-01f, -9.569403357e-01f, -9.700312532e-01f, -9.807852804e-01f, -9.891765100e-01f, -9.951847267e-01f, -9.987954562e-01f, -1.000000000e+00f, -9.987954562e-01f, -9.951847267e-01f, -9.891765100e-01f, -9.807852804e-01f, -9.700312532e-01f, -9.569403357e-01f, -9.415440652e-01f, -9.238795325e-01f, -9.039892931e-01f, -8.819212643e-01f, -8.577286100e-01f, -8.314696123e-01f, -8.032075315e-01f, -7.730104534e-01f, -7.409511254e-01f, -7.071067812e-01f, -6.715589548e-01f, -6.343932842e-01f, -5.956993045e-01f, -5.555702330e-01f, -5.141027442e-01f, -4.713967368e-01f, -4.275550934e-01f, -3.826834324e-01f, -3.368898534e-01f, -2.902846773e-01f, -2.429801799e-01f, -1.950903220e-01f, -1.467304745e-01f, -9.801714033e-02f, -4.906767433e-02f, -1.836970199e-16f, 4.906767433e-02f, 9.801714033e-02f, 1.467304745e-01f, 1.950903220e-01f, 2.429801799e-01f, 2.902846773e-01f, 3.368898534e-01f, 3.826834324e-01f, 4.275550934e-01f, 4.713967368e-01f, 5.141027442e-01f, 5.555702330e-01f, 5.956993045e-01f, 6.343932842e-01f, 6.715589548e-01f, 7.071067812e-01f, 7.409511254e-01f, 7.730104534e-01f, 8.032075315e-01f, 8.314696123e-01f, 8.577286100e-01f, 8.819212643e-01f, 9.039892931e-01f, 9.238795325e-01f, 9.415440652e-01f, 9.569403357e-01f, 9.700312532e-01f, 9.807852804e-01f, 9.891765100e-01f, 9.951847267e-01f, 9.987954562e-01f, 0.000000000e+00f, 4.906767433e-02f, 9.801714033e-02f, 1.467304745e-01f, 1.950903220e-01f, 2.429801799e-01f, 2.902846773e-01f, 3.368898534e-01f, 3.826834324e-01f, 4.275550934e-01f, 4.713967368e-01f, 5.141027442e-01f, 5.555702330e-01f, 5.956993045e-01f, 6.343932842e-01f, 6.715589548e-01f, 7.071067812e-01f, 7.409511254e-01f, 7.730104534e-01f, 8.032075315e-01f, 8.314696123e-01f, 8.577286100e-01f, 8.819212643e-01f, 9.039892931e-01f, 9.238795325e-01f, 9.415440652e-01f, 9.569403357e-01f, 9.700312532e-01f, 9.807852804e-01f, 9.891765100e-01f, 9.951847267e-01f, 9.987954562e-01f, 1.000000000e+00f, 9.987954562e-01f, 9.951847267e-01f, 9.891765100e-01f, 9.807852804e-01f, 9.700312532e-01f, 9.569403357e-01f, 9.415440652e-01f, 9.238795325e-01f, 9.039892931e-01f, 8.819212643e-01f, 8.577286100e-01f, 8.314696123e-01f, 8.032075315e-01f, 7.730104534e-01f, 7.409511254e-01f, 7.071067812e-01f, 6.715589548e-01f, 6.343932842e-01f, 5.956993045e-01f, 5.555702330e-01f, 5.141027442e-01f, 4.713967368e-01f, 4.275550934e-01f, 3.826834324e-01f, 3.368898534e-01f, 2.902846773e-01f, 2.429801799e-01f, 1.950903220e-01f, 1.467304745e-01f, 9.801714033e-02f, 4.906767433e-02f, 1.224646799e-16f, -4.906767433e-02f, -9.801714033e-02f, -1.467304745e-01f, -1.950903220e-01f, -2.429801799e-01f, -2.902846773e-01f, -3.368898534e-01f, -3.826834324e-01f, -4.275550934e-01f, -4.713967368e-01f, -5.141027442e-01f, -5.555702330e-01f, -5.956993045e-01f, -6.343932842e-01f, -6.715589548e-01f, -7.071067812e-01f, -7.409511254e-01f, -7.730104534e-01f, -8.032075315e-01f, -8.314696123e-01f, -8.577286100e-01f, -8.819212643e-01f, -9.039892931e-01f, -9.238795325e-01f, -9.415440652e-01f, -9.569403357e-01f, -9.700312532e-01f, -9.807852804e-01f, -9.891765100e-01f, -9.951847267e-01f, -9.987954562e-01f, -1.000000000e+00f, -9.987954562e-01f, -9.951847267e-01f, -9.891765100e-01f, -9.807852804e-01f, -9.700312532e-01f, -9.569403357e-01f, -9.415440652e-01f, -9.238795325e-01f, -9.039892931e-01f, -8.819212643e-01f, -8.577286100e-01f, -8.314696123e-01f, -8.032075315e-01f, -7.730104534e-01f, -7.409511254e-01f, -7.071067812e-01f, -6.715589548e-01f, -6.343932842e-01f, -5.956993045e-01f, -5.555702330e-01f, -5.141027442e-01f, -4.713967368e-01f, -4.275550934e-01f, -3.826834324e-01f, -3.368898534e-01f, -2.902846773e-01f, -2.429801799e-01f, -1.950903220e-01f, -1.467304745e-01f, -9.801714033e-02f, -4.906767433e-02f};
struct Args { const float* in[12]; float* out; unsigned char* ws; int ph_lo, ph_hi; };

__global__ void __launch_bounds__(NTHREADS, 2) mk_fwd(Args args) {
    extern __shared__ __attribute__((aligned(16))) unsigned char lds[];
    const int G = gridDim.x; const int bx = blockIdx.x; const int vcu = (G % 8 == 0) ? (bx % 8) * (G / 8) + bx / 8 : bx;
    const int NGW = G * NWAVES;
    unsigned char* ws = args.ws; float* X = args.out;
    bf16_t* Wgu = (bf16_t*)(ws + WS_WGU); bf16_t* Wd = (bf16_t*)(ws + WS_WD); bf16_t* Wqkv = (bf16_t*)(ws + WS_WQKV); bf16_t* Wo = (bf16_t*)(ws + WS_WO); bf16_t* W2 = (bf16_t*)(ws + WS_W2);
    bf16_t* A1P = (bf16_t*)(ws + WS_A1P); bf16_t* A1S = (bf16_t*)(ws + WS_A1S); bf16_t* A2 = (bf16_t*)(ws + WS_A2); bf16_t* A2M = (bf16_t*)(ws + WS_A2 + 32768); float2* ROPE = (float2*)(ws + WS_ROPE); float* QKG = (float*)(ws + WS_QKG);
    bf16_t* XB0 = (bf16_t*)args.out; bf16_t* XBH = (bf16_t*)(ws + WS_XH); float* RSS = (float*)(ws + WS_RSS); bf16_t* FB = (bf16_t*)(ws + WS_F); bf16_t* TB = (bf16_t*)(ws + WS_T); bf16_t* HID = (bf16_t*)(ws + WS_HID);
    bf16_t* QO = (bf16_t*)(ws + WS_QO); bf16_t* KB = (bf16_t*)(ws + WS_K); bf16_t* VB = (bf16_t*)(ws + WS_V);
    LAS unsigned char* ldsl = (LAS unsigned char*)lds;
    const int lo = args.ph_lo, hi = args.ph_hi;
    int ph = 0;
    volatile LAS unsigned* MISC = (volatile LAS unsigned*)(ldsl + 131072 + 8192);
    if (threadIdx.x < 64) MISC[threadIdx.x] = 0u;
    __syncthreads();
    XcdBarrier xbar; xbar.bar = (unsigned*)(ws + 16384); xbar.x = xb_xcc_id(); xbar.st = MISC + 8;
    if (bx == 0) { for (int i = threadIdx.x; i < XCD_BAR_WORDS; i += NTHREADS) xbar.bar[i] = 0u; }
    unsigned long long* TS = (unsigned long long*)(ws + WS_TS);
    if (MK_PROBE && bx == 0 && threadIdx.x == 0) TS[0] = __builtin_amdgcn_s_memrealtime();
#define PH_BEGIN if (ph >= lo && ph < hi) { const int tid = mk_tid(), lane = tid & 63, wave = __builtin_amdgcn_readfirstlane(tid >> 6), gw = vcu * NWAVES + wave; (void)lane; (void)gw;
#define PH_END } ++ph; if (ph > lo && ph < hi) { if (ph == 1 || MK_CG_ONLY) { cg::this_grid().sync(); if (ph == 1 && threadIdx.x == 0) (void)xb_add(&xbar.bar[XB_XCNT(xbar.x)], 1u); } else xcd_barrier(xbar); } if (MK_PROBE && bx == 0 && threadIdx.x == 0) TS[ph] = __builtin_amdgcn_s_memrealtime();

    PH_BEGIN
    if (EN_P0) {
        LAS float* scr = (LAS float*)(ldsl + wave * 16384);
        if (MK_PROBE2 && bx == 0 && threadIdx.x == 0) TS[40] = __builtin_amdgcn_s_memrealtime();
        constexpr int I_G = 16 * 44, I_D = 44 * 16, I_QKV = 16 * 24, I_O = 16 * 16;
        constexpr int NITEMS = 4 * (2 * I_G + I_D) + 2 * (I_QKV + I_O);
        for (int it = gw; it < NITEMS; it += NGW) {
            int r = it;
            if (r < 4 * I_G) { const int l = r / I_G; transpose_item(args.in[9] + (size_t)l * DM * DFF, DM, DFF, Wgu + (size_t)l * 2 * DFF * DM, DM, args.in[3] + l * DM, RmGU{0}, scr, r % I_G, lane); continue; } r -= 4 * I_G;
            if (r < 4 * I_G) { const int l = r / I_G; transpose_item(args.in[10] + (size_t)l * DM * DFF, DM, DFF, Wgu + (size_t)l * 2 * DFF * DM, DM, args.in[3] + l * DM, RmGU{128}, scr, r % I_G, lane); continue; } r -= 4 * I_G;
            if (r < 4 * I_D) { const int l = r / I_D; transpose_item(args.in[11] + (size_t)l * DFF * DM, DFF, DM, Wd + (size_t)l * DM * DFF, DFF, (const float*)nullptr, RmId{}, scr, r % I_D, lane); continue; } r -= 4 * I_D;
            if (r < 2 * I_QKV) { const int j = r / I_QKV; transpose_item(args.in[5] + (size_t)j * DM * NQKV, DM, NQKV, Wqkv + (size_t)j * NQKV * DM, DM, args.in[2] + (2 * j + 1) * DM, RmId{}, scr, r % I_QKV, lane); continue; } r -= 2 * I_QKV;
            { const int j = r / I_O; transpose_item(args.in[8] + (size_t)j * DM * DM, DM, DM, Wo + (size_t)j * DM * DM, DM, (const float*)nullptr, RmId{}, scr, r % I_O, lane); }
        }
        if (MK_PROBE2) { __syncthreads(); if (bx == 0 && threadIdx.x == 0) TS[41] = __builtin_amdgcn_s_memrealtime(); }
        {
          for (int task = gw; task < 2048; task += NGW) {
              const int nb = task & 15, cc = (task >> 4) & 3, g = (task >> 6) & 7, p = (task >> 9) & 1, j = task >> 10;
              const int n = nb * 64 + lane; const float* w = args.in[4] + (size_t)j * DM * DM + (size_t)(g * 128) * DM + n; const float* tb = CS128 + p * 128;
              float acc[32];
#pragma unroll
              for (int ci = 0; ci < 32; ++ci) acc[ci] = 0.f;
              for (int jp0 = 0; jp0 < 128; jp0 += 8) { float wv[8];
#pragma unroll
                  for (int d = 0; d < 8; ++d) wv[d] = w[(size_t)(jp0 + d) * DM];
#pragma unroll
                  for (int d = 0; d < 8; ++d)
#pragma unroll
                      for (int ci = 0; ci < 32; ++ci) acc[ci] += tb[((cc * 32 + ci) * (jp0 + d)) & 127] * wv[d]; }
              const float* gain = args.in[2] + (2 * j) * DM + g * 128 + cc * 32;
              bf16_t* dst = W2 + (size_t)j * DM * 2048 + (size_t)n * 2048 + p * 1024 + g * 128 + cc * 32;
#pragma unroll
              for (int q4 = 0; q4 < 4; ++q4) { v4u o; const float sc = 0.08838834764831845f;
                  o.x = pk2(acc[8 * q4 + 0] * gain[8 * q4 + 0] * sc, acc[8 * q4 + 1] * gain[8 * q4 + 1] * sc); o.y = pk2(acc[8 * q4 + 2] * gain[8 * q4 + 2] * sc, acc[8 * q4 + 3] * gain[8 * q4 + 3] * sc);
                  o.z = pk2(acc[8 * q4 + 4] * gain[8 * q4 + 4] * sc, acc[8 * q4 + 5] * gain[8 * q4 + 5] * sc); o.w = pk2(acc[8 * q4 + 6] * gain[8 * q4 + 6] * sc, acc[8 * q4 + 7] * gain[8 * q4 + 7] * sc);
                  *(v4u*)(dst + 8 * q4) = o; }
          }
          LDS_WAIT(); asm volatile("" ::: "memory");
        }
        if (MK_PROBE2) { __syncthreads(); if (bx == 0 && threadIdx.x == 0) TS[42] = __builtin_amdgcn_s_memrealtime(); }
        { const int gt = gw * 64 + lane, NGT = NGW * 64;
          for (int e2 = gt; e2 < 64 * 256 * 64; e2 += NGT) {
              const int s1 = (e2 & 63) * 2, m = (e2 >> 6) & 255, s2 = e2 >> 14, k1 = m >> 1, pp = m & 1; float v[2];
#pragma unroll
              for (int d = 0; d < 2; ++d) { const int s = 64 * (s1 + d) + s2, r = (k1 * s) & 8191; const float x = (float)r * (1.0f / 4096.0f); v[d] = (pp ? -sinpif(x) : cospif(x)) * 0.08838834764831845f; }
              ((unsigned*)A1P)[e2] = pk2(v[0], v[1]); }
          for (int e2 = gt; e2 < 64 * 128 * 32; e2 += NGT) {
              const int s1 = (e2 & 31) * 2, m = (e2 >> 5) & 127, s2 = e2 >> 12, k1 = m >> 1, pp = m & 1; float v[2];
#pragma unroll
              for (int d = 0; d < 2; ++d) { const int s = 64 * (s1 + d) + s2, r = (k1 * s) & 4095; const float x = (float)r * (1.0f / 2048.0f); v[d] = (pp ? -sinpif(x) : cospif(x)) * 0.125f; }
              ((unsigned*)A1S)[e2] = pk2(v[0], v[1]); }
          for (int e2 = gt; e2 < 128 * 64; e2 += NGT) {
              const int k = (e2 & 63) * 2, m = e2 >> 6, k2 = m >> 1, pp = m & 1, p = k >> 6; float v[2];
#pragma unroll
              for (int d = 0; d < 2; ++d) { const int s2 = (k + d) & 63, r = (k2 * s2) & 63; const float x = (float)r * (1.0f / 32.0f); const float c = cospif(x), s = sinpif(x);
                  v[d] = (pp == 0 ? (p == 0 ? c : s) : (p == 0 ? -s : c)) * 0.125f; }
              ((unsigned*)A2)[e2] = pk2(v[0], v[1]); }
          for (int e2 = gt; e2 < 128 * 64; e2 += NGT) {
              const int k = (e2 & 63) * 2, m = e2 >> 6, k2 = m >> 1, pp = m & 1, p = k >> 6; float v[2];
#pragma unroll
              for (int d = 0; d < 2; ++d) { const int s2 = (k + d) & 63, r = ((k2 + 1) * s2) & 63; const float x = (float)r * (1.0f / 32.0f); const float c = cospif(x), s = sinpif(x);
                  v[d] = (pp == 0 ? (p == 0 ? c : -s) : (p == 0 ? -s : -c)) * 0.125f; }
              ((unsigned*)A2M)[e2] = pk2(v[0], v[1]); }
          if (gw == 0) {
#pragma unroll
              for (int j2 = 0; j2 < 2; ++j2) { float mq = fmaxf(fabsf(args.in[6][j2 * 128 + lane]), fabsf(args.in[6][j2 * 128 + 64 + lane])), mk = fmaxf(fabsf(args.in[7][j2 * 128 + lane]), fabsf(args.in[7][j2 * 128 + 64 + lane]));
#pragma unroll
                  for (int o = 1; o < 64; o <<= 1) { mq = fmaxf(mq, __shfl_xor(mq, o)); mk = fmaxf(mk, __shfl_xor(mk, o)); }
                  if (lane == 0) QKG[512 + j2] = -(128.0f * 1.02f * mq * mk) * (att::SCALE * 1.4426950408889634f); }
          }
          for (int e = gt; e < 512; e += NGT) { const int j = e >> 8, r = e & 255; QKG[e] = r < 128 ? args.in[6][j * 128 + r] : args.in[7][j * 128 + r - 128]; }
          for (int e = gt; e < 128 * 32; e += NGT) { const int i = e & 31, pos = e >> 5; const float inv = powf(10000.0f, -(float)i * (1.0f / 32.0f)); const float a = (float)pos * inv; ROPE[e] = make_float2(cosf(a), sinf(a)); }
        }
        if (MK_PROBE2) { __syncthreads(); if (bx == 0 && threadIdx.x == 0) TS[43] = __builtin_amdgcn_s_memrealtime(); }
        for (int m = 2 * gw; m < NTOK; m += 2 * NGW) { const float* src = m < NTOK_P ? args.in[0] + (size_t)m * DM : args.in[1] + (size_t)(m - NTOK_P) * DM; cvt_row2(src, src + DM, XB0 + (size_t)m * DM, XB0 + (size_t)(m + 1) * DM, RSS + (size_t)m * 4, RSS + (size_t)(m + 1) * 4, lane); }
    }
    PH_END

    for (int layer = 0; layer < 4; ++layer) {
        const int jj = layer >> 1;
        const float* rss_mix = RSS + (size_t)(2 * layer) * RSS_STRIDE;
        float* rss_ffn = RSS + (size_t)(2 * layer + 1) * RSS_STRIDE;
        float* rss_next = RSS + (size_t)(2 * layer + 2) * RSS_STRIDE;
        bf16_t* XBF = layer == 3 ? XBH : XB0;
        PG8_LAS float* Pscr = (PG8_LAS float*)(ldsl + 131072);
        if ((layer & 1) == 0) {
            PH_BEGIN
            if (EN_FFT) {
                char* wl = (char*)lds + wave * 16384;
                for (int u = gw; u < 2048; u += NGW) { const int cb = u & 15, s2 = (u >> 4) & 63, b = u >> 10; const size_t tok = (size_t)b * SEQ_P + s2;
                    fft_unit<128, 160, true>(A1P + (size_t)s2 * 256 * 128, XB0 + tok * DM + cb * 64, (size_t)64 * DM, TB + ((size_t)b * 2 * SEQ_P + s2) * DM + cb * 64, (size_t)2 * 64 * DM, (size_t)64 * DM, wl, lane, rss_mix + tok * 4, (size_t)64); }
                for (int u = gw; u < 8192; u += NGW) { const int cb = u & 15, s2 = (u >> 4) & 63, b = u >> 10; const size_t tok = (size_t)NTOK_P + (size_t)b * SEQ_S + s2;
                    fft_unit<64, 96, true>(A1S + (size_t)s2 * 128 * 64, XB0 + tok * DM + cb * 64, (size_t)64 * DM, TB + ((size_t)2 * NTOK_P + (size_t)b * 2 * SEQ_S + s2) * DM + cb * 64, (size_t)2 * 64 * DM, (size_t)64 * DM, wl, lane, rss_mix + tok * 4, (size_t)64); }
            }
            PH_END
            PH_BEGIN
            if (EN_FFT) {
                char* wl = (char*)lds + wave * 16384;
                for (int u = gw; u < 4096 + 8192; u += NGW) {
                    const bool P = u < 4096; const int v = P ? u : u - 4096; const int cb = v & 15; const int k1 = P ? ((v >> 4) & 127) : ((v >> 4) & 63); const int b = P ? (v >> 11) : (v >> 10);
                    const int N1h = P ? 64 : 32; const bool mir = k1 > N1h; const int k1s = mir ? 2 * N1h - k1 : k1;
                    const size_t trow = P ? ((size_t)b * 2 * SEQ_P + (size_t)k1s * 128) : ((size_t)2 * NTOK_P + (size_t)b * 2 * SEQ_S + (size_t)k1s * 128);
                    const size_t frow = P ? ((size_t)b * SEQ_P + k1) : ((size_t)NTOK_P + (size_t)b * SEQ_S + k1);
                    fft_unit<128, 128, false>(mir ? A2M : A2, TB + trow * DM + cb * 64, (size_t)DM, FB + frow * 2048 + cb * 64, P ? (size_t)128 * 2048 : (size_t)64 * 2048, (size_t)1024, wl, lane);
                }
            }
            PH_END
        } else {
            PH_BEGIN
            if (EN_QKV) {
                pg8::Gemm g{XB0, Wqkv + (size_t)jj * NQKV * DM, NTOK, NQKV, DM}; pg8::StaticOrder S; S.init(NTOK, NQKV, G, bx);
                pg8::EpiQKV E{QO, KB, VB, rss_mix, QKG + jj * 256, (const float*)ROPE, (PG8_LAS float*)(ldsl + 131072), att::SCALE * 1.4426950408889634f};
                pg8::gemm_phase<pg8::EpiQKV, pg8::StaticOrder, GU_ALIGN, GEMM_SP2>(ldsl, g, S, E);
            }
            PH_END
            PH_BEGIN
            if (EN_ATT) {
                const float* qg = QKG + jj * 256; const float negmc = QKG[512 + jj];
                for (int j = vcu; j < 1536; j += G) {
                    int b, h, qb, tok0, seq;
                    if (j < 512) { const int bh = j >> 5; qb = j & 31; b = bh >> 3; h = bh & 7; tok0 = b * SEQ_P; seq = SEQ_P; }
                    else { const int v = j - 512, bh = v >> 4; qb = v & 15; b = bh >> 3; h = bh & 7; tok0 = NTOK_P + b * SEQ_S; seq = SEQ_S; }
                    const att::bf16* Qb = (const att::bf16*)QO + ((size_t)tok0 + qb * 256) * 1024 + h * 128;
                    const att::bf16* Kh = (const att::bf16*)KB + (size_t)tok0 * 256 + (h >> 2) * 128;
                    const att::bf16* Vh = (const att::bf16*)VB + (size_t)tok0 * 256 + (h >> 2) * 128;
                    att::attn_unit(Qb, Kh, Vh, (att::bf16*)Qb, seq, qb * 256, qg, ROPE, negmc, (char*)lds);
                }
            }
            PH_END
        }
        PH_BEGIN
        if (EN_RES) {
            pg8::Gemm g = (layer & 1) ? pg8::Gemm{QO, Wo + (size_t)jj * DM * DM, NTOK, DM, DM} : pg8::Gemm{FB, W2 + (size_t)jj * DM * 2048, NTOK, DM, 2048};
            pg8::StaticOrder S; S.init(NTOK, DM, G, bx); pg8::EpiResB E{XB0, XBF, (float*)nullptr, rss_ffn, Pscr};
            pg8::gemm_phase<pg8::EpiResB, pg8::StaticOrder, true, GEMM_SP2>(ldsl, g, S, E);
        }
        PH_END
        PH_BEGIN
        if (EN_GU) {
            if (MK_SLEEP_US) { const unsigned long long t0 = __builtin_amdgcn_s_memrealtime(); while (__builtin_amdgcn_s_memrealtime() - t0 < 100ull * MK_SLEEP_US) __builtin_amdgcn_s_sleep(64); }
            pg8::Gemm g{XBF, Wgu + (size_t)layer * 2 * DFF * DM, NTOK, 2 * DFF, DM}; pg8::StaticOrder S; S.init(NTOK, 2 * DFF, G, bx);
            pg8::EpiSwiGLU E{HID, DFF, rss_ffn};
            pg8::gemm_phase<pg8::EpiSwiGLU, pg8::StaticOrder, GU_ALIGN, GEMM_SP2>(ldsl, g, S, E);
        }
        PH_END
        PH_BEGIN
        if (EN_RES) {
            pg8::Gemm g{HID, Wd + (size_t)layer * DM * DFF, NTOK, DM, DFF}; pg8::StaticOrder S; S.init(NTOK, DM, G, bx); S.rev = MK_DREV;
            pg8::EpiResB E{XBF, XB0, layer == 3 ? X : (float*)nullptr, layer == 3 ? (float*)nullptr : rss_next, Pscr};
            pg8::gemm_phase<pg8::EpiResB, pg8::StaticOrder, true, GEMM_SP2>(ldsl, g, S, E);
        }
        PH_END
    }
#undef PH_BEGIN
#undef PH_END
    for (int i = 0; i < MK_EXTRA_SYNC; ++i) cg::this_grid().sync();
    if (MK_PROBE && bx == 0 && threadIdx.x == 0) {
        unsigned long long sa = 0, sb = 0; const unsigned long long tot = TS[NPH_C] - TS[0];
        for (int i = 0; i < NPH_C; ++i) { const unsigned long long d = TS[i + 1] - TS[i]; if ((MK_MASK_A >> i) & 1u) sa += d; if ((MK_MASK_B >> i) & 1u) sb += d; }
        if (MK_PROBE2) { unsigned long long q[5] = {TS[40], TS[41], TS[42], TS[43], TS[1]}; sa = q[MK_PA + 1] - q[MK_PA]; sb = q[MK_PB + 1] - q[MK_PB]; sa *= 10; sb *= 10; }
        const unsigned long long pa = (sa * 100 + tot / 2) / tot, pb = (sb * 100 + tot / 2) / tot;
        const unsigned long long D = 2000ull * (pa * 100 + pb);
        while (__builtin_amdgcn_s_memrealtime() - TS[NPH_C] < D) __builtin_amdgcn_s_sleep(32);
    }
}
constexpr int NPHASES = NPH_C;

extern "C" void kernel_launch(void* const* d_in, const int* in_sizes, int n_in, void* d_out, int out_size, void* d_ws, size_t ws_size, hipStream_t stream) {
    static int grid = 0;
    if (grid == 0) {
        if (n_in != 12 || out_size != NTOK * DM || ws_size < WS_END) { fprintf(stderr, "kernel_launch: unexpected shapes: n_in %d out %d ws %zu (need %zu)\n", n_in, out_size, ws_size, (size_t)WS_END); grid = -1; return; }
        int dev = 0, cus = 0, per_cu = 0;
        hipGetDevice(&dev); hipDeviceGetAttribute(&cus, hipDeviceAttributeMultiprocessorCount, dev);
        if (hipFuncSetAttribute((const void*)mk_fwd, hipFuncAttributeMaxDynamicSharedMemorySize, LDS_BYTES) != hipSuccess) { fprintf(stderr, "kernel_launch: hipFuncSetAttribute failed\n"); grid = -1; return; }
        if (hipOccupancyMaxActiveBlocksPerMultiprocessor(&per_cu, (const void*)mk_fwd, NTHREADS, LDS_BYTES) != hipSuccess || per_cu < 1) { fprintf(stderr, "kernel_launch: occupancy query gave %d\n", per_cu); per_cu = 1; }
        (void)hipGetLastError();
        grid = cus * per_cu;
        fprintf(stderr, "kernel_launch: grid %d (cus %d x %d)\n", grid, cus, per_cu);
    }
    if (grid < 0) return;
    Args a{};
    for (int i = 0; i < 12; ++i) a.in[i] = (const float*)d_in[i];
    a.out = (float*)d_out; a.ws = (unsigned char*)d_ws;
#if MK_ONE_LAUNCH
    a.ph_lo = 0; a.ph_hi = NPHASES;
    void* kargs[] = {&a};
    hipError_t e = hipLaunchCooperativeKernel((const void*)mk_fwd, dim3(grid), dim3(NTHREADS), kargs, LDS_BYTES, stream);
    if (e != hipSuccess) fprintf(stderr, "kernel_launch: cooperative launch failed: %s (grid %d)\n", hipGetErrorString(e), grid);
#else
    for (int p = 0; p < NPHASES; ++p) { a.ph_lo = p; a.ph_hi = p + 1; hipLaunchKernelGGL(mk_fwd, dim3(grid), dim3(NTHREADS), LDS_BYTES, stream, a); }
    hipError_t e = hipPeekAtLastError();
    if (e != hipSuccess) fprintf(stderr, "kernel_launch: launch failed: %s\n", hipGetErrorString(e));
#endif
}
```

```cpp
#include <hip/hip_runtime.h>
#define ATT_SDEPTH 1
#define ATT_NEGM 1
#include <hip/hip_bf16.h>
#include <hip/hip_cooperative_groups.h>
#include <cstdio>
#include <cstdint>
namespace cg = cooperative_groups;

#ifndef EN_P0
#define EN_P0 1
#endif
#ifndef EN_FFT
#define EN_FFT 1
#endif
#ifndef EN_QKV
#define EN_QKV 1
#endif
#ifndef EN_MISC
#define EN_MISC 1
#endif
#ifndef EN_ATT
#define EN_ATT 1
#endif
#ifndef EN_RES
#define EN_RES 1
#endif
#ifndef EN_GU
#define EN_GU 1
#endif
#ifndef MK_PROBE
#define MK_PROBE 0
#endif
#ifndef MK_MASK_A
#define MK_MASK_A 0u
#endif
#ifndef MK_MASK_B
#define MK_MASK_B 0u
#endif
#ifndef MK_SLEEP_US
#define MK_SLEEP_US 0
#endif
#ifndef MK_EXTRA_SYNC
#define MK_EXTRA_SYNC 0
#endif
#ifndef MK_CG_ONLY
#define MK_CG_ONLY 0
#endif
#ifndef ATT_SDEPTH
#define ATT_SDEPTH 2
#endif
#ifndef ATT_SB
#define ATT_SB 0
#endif
#ifndef ATT_NEGM
#define ATT_NEGM 0
#endif
#ifndef GU_ALIGN
#define GU_ALIGN true
#endif
#ifndef GEMM_SP2
#define GEMM_SP2 true
#endif
#ifndef MK_PROBE2
#define MK_PROBE2 0
#endif
#ifndef MK_PA
#define MK_PA 0
#endif
#ifndef MK_PB
#define MK_PB 1
#endif
#ifndef MK_DREV
#define MK_DREV 1
#endif
#ifndef MK_ONE_LAUNCH
#define MK_ONE_LAUNCH 1
#endif

__device__ __forceinline__ int mk_tid() { int t = threadIdx.x; asm volatile("" : "+v"(t)); return t; }
namespace pg8 {
#define PG8_LAS __attribute__((address_space(3)))
typedef unsigned short bf16_t;
typedef short bf16x8 __attribute__((ext_vector_type(8)));
typedef float f32x4 __attribute__((ext_vector_type(4)));
typedef unsigned u32x4 __attribute__((ext_vector_type(4)));
constexpr int BM = 256, BK = 64, HALF = 128, HTB = HALF * BK * 2  , STAGE_BYTES = 8 * HTB, NXCD = 8, WGM = 8;

__host__ __device__ __forceinline__ int lds_byte(int r, int c) { const int st = (r >> 4) * 2 + (c >> 5), rr = r & 15, cc = c & 31, ob = rr * 64 + cc * 2; return st * 1024 + (ob ^ (((ob >> 9) & 1) << 5)); }
__host__ __device__ __forceinline__ void stage_rc(int b, int& R, int& C) { const int st = b / 1024, sb = b % 1024, swz = sb ^ (((sb >> 9) & 1) << 5); R = (st >> 1) * 16 + swz / 64; C = (st & 1) * 32 + (swz % 64) / 2; }
__host__ __device__ __forceinline__ int perm32(int rho) { const int n = rho >> 4, i = rho & 15; return 8 * (i >> 2) + 4 * n + (i & 3); }

struct Unit { int pm, pn; };
struct Gemm { const bf16_t* A; const bf16_t* Bt; int M, N, K; };

struct StaticOrder {
    int nM, nN, nwg, G, c, rev;
    __host__ __device__ void init(int M, int N, int G_, int c_) { nM = M / BM; nN = N / BM; nwg = nM * nN; G = G_; c = c_; rev = 0; }
    __host__ __device__ bool next(int i, Unit& u) const {
        const long L = (long)i * G + c; if (L >= nwg) return false;
        int wgid = (int)L; { const int q = nwg / NXCD, r = nwg % NXCD, xcd = wgid % NXCD, off = wgid / NXCD; wgid = (xcd < r ? xcd * (q + 1) : r * (q + 1) + (xcd - r) * q) + off; }
        const int nig = WGM * nN, gid = wgid / nig, fm = gid * WGM, gsz = (nM - fm) < WGM ? (nM - fm) : WGM;
        u.pm = fm + ((wgid % nig) % gsz); u.pn = (wgid % nig) / gsz; if (rev) u.pm = nM - 1 - u.pm; return true;
    }
    __device__ __forceinline__ void a_ready(const Unit&) const {}
    __device__ __forceinline__ void done(const Unit&) const {}
};

__device__ __forceinline__ unsigned cvt_pk_bf16(float lo, float hi) { unsigned r; asm volatile("v_cvt_pk_bf16_f32 %0, %1, %2" : "=v"(r) : "v"(lo), "v"(hi)); return r; }
typedef float f32x2 __attribute__((ext_vector_type(2)));
typedef float f32x2 __attribute__((ext_vector_type(2)));

__device__ __forceinline__ float bflo(unsigned w) { return __uint_as_float(w << 16); }
__device__ __forceinline__ float bfhi(unsigned w) { return __uint_as_float(w & 0xffff0000u); }
__device__ __forceinline__ float rstd_of(const float* rssp, size_t row) { const f32x4 p = *(const f32x4*)(rssp + row * 4); return __builtin_amdgcn_rsqf(((p[0] + p[1]) + (p[2] + p[3])) * (1.0f / 1024.0f) + 1e-6f); }
struct EpiResB {
    static constexpr bool PERM = true, AFTER_DRAIN = false;
    const bf16_t* xin; bf16_t* xout; float* fout; float* rssp; PG8_LAS float* P;
    __device__ __forceinline__ void operator()(const f32x4 (&acc)[2][2][4][2], const Unit& u, int wr, int wc, int fr, int fq) const {
        const int row0 = u.pm * BM + wr * 64 + fr, col0 = u.pn * BM + wc * 32 + 8 * fq;
#pragma unroll
        for (int ai = 0; ai < 2; ++ai) {
            u32x4 xo[4][2];
#pragma unroll
            for (int m = 0; m < 4; ++m)
#pragma unroll
                for (int bj = 0; bj < 2; ++bj) xo[m][bj] = *(const u32x4*)(xin + (size_t)(row0 + ai * HALF + m * 16) * 1024 + col0 + bj * HALF);
#pragma unroll
            for (int m = 0; m < 4; ++m) {
                const size_t roff = (size_t)(row0 + ai * HALF + m * 16) * 1024 + col0; float ss = 0.f;
#pragma unroll
                for (int bj = 0; bj < 2; ++bj) {
                    const u32x4 w = xo[m][bj]; const f32x4 a0 = acc[ai][bj][m][0], a1 = acc[ai][bj][m][1]; f32x4 v0, v1;
                    v0[0] = bflo(w.x) + a0[0]; v0[1] = bfhi(w.x) + a0[1]; v0[2] = bflo(w.y) + a0[2]; v0[3] = bfhi(w.y) + a0[3];
                    v1[0] = bflo(w.z) + a1[0]; v1[1] = bfhi(w.z) + a1[1]; v1[2] = bflo(w.w) + a1[2]; v1[3] = bfhi(w.w) + a1[3];
                    ss += (v0[0] * v0[0] + v0[1] * v0[1]) + (v0[2] * v0[2] + v0[3] * v0[3]) + (v1[0] * v1[0] + v1[1] * v1[1]) + (v1[2] * v1[2] + v1[3] * v1[3]);
                    if (fout) { *(f32x4*)(fout + roff + bj * HALF) = v0; *(f32x4*)(fout + roff + bj * HALF + 4) = v1; }
                    else { u32x4 o; o.x = cvt_pk_bf16(v0[0], v0[1]); o.y = cvt_pk_bf16(v0[2], v0[3]); o.z = cvt_pk_bf16(v1[0], v1[1]); o.w = cvt_pk_bf16(v1[2], v1[3]); *(u32x4*)(xout + roff + bj * HALF) = o; }
                }
                if (rssp) { ss += __shfl_xor(ss, 16); ss += __shfl_xor(ss, 32); if (fq == 0) P[(ai * HALF + wr * 64 + m * 16 + fr) * 4 + wc] = ss; }
            }
        }
        if (rssp) {
            asm volatile("s_waitcnt lgkmcnt(0)" ::: "memory"); __builtin_amdgcn_s_barrier(); asm volatile("" ::: "memory");
            const int t = (wr * 4 + wc) * 64 + fq * 16 + fr;
            if (t < 256) { const f32x4 p = *((const PG8_LAS f32x4*)P + t); rssp[(size_t)(u.pm * BM + t) * 4 + u.pn] = (p[0] + p[1]) + (p[2] + p[3]); }
        }
    }
};
__device__ __forceinline__ float silu_mul(float g, float u) { return g * u * __builtin_amdgcn_rcpf(1.0f + __builtin_amdgcn_exp2f(-1.4426950408889634f * g)); }
struct EpiSwiGLU {
    static constexpr bool PERM = true, AFTER_DRAIN = false;
    bf16_t* H; int ldh; const float* rssp;
    __device__ __forceinline__ void operator()(const f32x4 (&acc)[2][2][4][2], const Unit& u, int wr, int wc, int fr, int fq) const {
        const int row0 = u.pm * BM + wr * 64 + fr, col0 = u.pn * HALF + wc * 32 + 8 * fq;
        f32x4 pp[2][4];
#pragma unroll
        for (int ai = 0; ai < 2; ++ai)
#pragma unroll
            for (int m = 0; m < 4; ++m) pp[ai][m] = *(const f32x4*)(rssp + (size_t)(row0 + ai * HALF + m * 16) * 4);
#pragma unroll
        for (int ai = 0; ai < 2; ++ai)
#pragma unroll
            for (int m = 0; m < 4; ++m) { const int row = row0 + ai * HALF + m * 16; bf16_t* rowp = H + (size_t)row * ldh + col0; const f32x4 p = pp[ai][m]; const float rs = __builtin_amdgcn_rsqf(((p[0] + p[1]) + (p[2] + p[3])) * (1.0f / 1024.0f) + 1e-6f);
                const f32x4 g0 = acc[ai][0][m][0] * rs, g1 = acc[ai][0][m][1] * rs, u0 = acc[ai][1][m][0] * rs, u1 = acc[ai][1][m][1] * rs;
                u32x4 w;
                w.x = cvt_pk_bf16(silu_mul(g0[0], u0[0]), silu_mul(g0[1], u0[1])); w.y = cvt_pk_bf16(silu_mul(g0[2], u0[2]), silu_mul(g0[3], u0[3]));
                w.z = cvt_pk_bf16(silu_mul(g1[0], u1[0]), silu_mul(g1[1], u1[1])); w.w = cvt_pk_bf16(silu_mul(g1[2], u1[2]), silu_mul(g1[3], u1[3]));
                *(u32x4*)rowp = w; }
    }
};
struct EpiQKV {
    static constexpr bool PERM = true, AFTER_DRAIN = false;
    bf16_t *Q, *K, *V; const float* rssp;
    const float* qkg;
    const float* rope;
    PG8_LAS float* P2;
    float qscale;
    __device__ __forceinline__ void operator()(const f32x4 (&acc)[2][2][4][2], const Unit& u, int wr, int wc, int fr, int fq) const {
        const int row0 = u.pm * BM + wr * 64 + fr;
        bf16_t* base = u.pn < 4 ? Q + u.pn * BM : (u.pn == 4 ? K : V); const int ldc = u.pn < 4 ? 1024 : 256;
        const int col0 = wc * 32 + 8 * fq;
        f32x4 pp[2][4]; float rs[2][4];
#pragma unroll
        for (int ai = 0; ai < 2; ++ai)
#pragma unroll
            for (int m = 0; m < 4; ++m) pp[ai][m] = *(const f32x4*)(rssp + (size_t)(row0 + ai * HALF + m * 16) * 4);
#pragma unroll
        for (int ai = 0; ai < 2; ++ai)
#pragma unroll
            for (int m = 0; m < 4; ++m) { const f32x4 p = pp[ai][m]; rs[ai][m] = __builtin_amdgcn_rsqf(((p[0] + p[1]) + (p[2] + p[3])) * (1.0f / 1024.0f) + 1e-6f); }
        if (u.pn == 5) {
#pragma unroll
            for (int ai = 0; ai < 2; ++ai)
#pragma unroll
                for (int m = 0; m < 4; ++m) { bf16_t* rowp = base + (size_t)(row0 + ai * HALF + m * 16) * ldc + col0;
#pragma unroll
                    for (int bj = 0; bj < 2; ++bj) { const f32x4 v0 = acc[ai][bj][m][0] * rs[ai][m], v1 = acc[ai][bj][m][1] * rs[ai][m]; u32x4 w;
                        w.x = cvt_pk_bf16(v0[0], v0[1]); w.y = cvt_pk_bf16(v0[2], v0[3]); w.z = cvt_pk_bf16(v1[0], v1[1]); w.w = cvt_pk_bf16(v1[2], v1[3]);
                        *(u32x4*)(rowp + bj * HALF) = w; } }
            return;
        }
#pragma unroll
        for (int ai = 0; ai < 2; ++ai)
#pragma unroll
            for (int m = 0; m < 4; ++m)
#pragma unroll
                for (int bj = 0; bj < 2; ++bj) { const f32x4 v0 = acc[ai][bj][m][0] * rs[ai][m], v1 = acc[ai][bj][m][1] * rs[ai][m];
                    float ss = (v0[0] * v0[0] + v0[1] * v0[1]) + (v0[2] * v0[2] + v0[3] * v0[3]) + (v1[0] * v1[0] + v1[1] * v1[1]) + (v1[2] * v1[2] + v1[3] * v1[3]);
                    ss += __shfl_xor(ss, 16); ss += __shfl_xor(ss, 32);
                    if (fq == 0) P2[((ai * HALF + wr * 64 + m * 16 + fr) * 2 + bj) * 4 + wc] = ss; }
        asm volatile("s_waitcnt lgkmcnt(0)" ::: "memory"); __builtin_amdgcn_s_barrier(); asm volatile("" ::: "memory");
        const float* gp = qkg + (u.pn == 4 ? 128 : 0) + col0; const float hs = u.pn == 4 ? 1.0f : qscale;
        const f32x4 g0 = *(const f32x4*)gp * hs, g1 = *(const f32x4*)(gp + 4) * hs;
        const int ib = 16 * (wc & 1) + 4 * fq;
#pragma unroll
        for (int ai = 0; ai < 2; ++ai)
#pragma unroll
            for (int m = 0; m < 4; ++m) { const int row = row0 + ai * HALF + m * 16; bf16_t* rowp = base + (size_t)row * ldc + col0;
                const int t = row < 16384 ? (row & 8191) : ((row - 16384) & 4095); const int pos = wc < 2 ? (t >> 6) : (t & 63);
                const f32x4 cs0 = *(const f32x4*)(rope + (size_t)(pos * 32 + ib) * 2), cs1 = *(const f32x4*)(rope + (size_t)(pos * 32 + ib + 2) * 2);
#pragma unroll
                for (int bj = 0; bj < 2; ++bj) { const f32x4 pr = *((const PG8_LAS f32x4*)P2 + ((ai * HALF + wr * 64 + m * 16 + fr) * 2 + bj));
                    const float rk = rs[ai][m] * __builtin_amdgcn_rsqf(((pr[0] + pr[1]) + (pr[2] + pr[3])) * (1.0f / 128.0f) + 1e-6f);
                    const f32x4 y0 = acc[ai][bj][m][0] * rk * g0, y1 = acc[ai][bj][m][1] * rk * g1; u32x4 w;
                    w.x = cvt_pk_bf16(y0[0] * cs0[0] - y0[1] * cs0[1], y0[0] * cs0[1] + y0[1] * cs0[0]); w.y = cvt_pk_bf16(y0[2] * cs0[2] - y0[3] * cs0[3], y0[2] * cs0[3] + y0[3] * cs0[2]);
                    w.z = cvt_pk_bf16(y1[0] * cs1[0] - y1[1] * cs1[1], y1[0] * cs1[1] + y1[1] * cs1[0]); w.w = cvt_pk_bf16(y1[2] * cs1[2] - y1[3] * cs1[3], y1[2] * cs1[3] + y1[3] * cs1[2]);
                    *(u32x4*)(rowp + bj * HALF) = w; } }
    }
};
template <class Epi, class Sched, bool ALIGN_EPI = false, bool SP2 = false>
__device__ __forceinline__ void gemm_phase(PG8_LAS unsigned char* lds, const Gemm g, const Sched& S, const Epi& E) {
    const int tid = mk_tid(), wid = __builtin_amdgcn_readfirstlane(tid >> 6), lane = tid & 63, wr = wid >> 2, wc = wid & 3, fr = lane & 15, fq = lane >> 4;
    const int K = g.K, nt = K / BK;
    unsigned voffA[2], voffB[2];
#pragma unroll
    for (int i = 0; i < 2; ++i) { int R, C; stage_rc(tid * 16 + i * 8192, R, C); const int Rb = Epi::PERM ? ((R & ~31) + perm32(R & 31)) : R;
        voffA[i] = (unsigned)(R * K + C) * 2u; voffB[i] = (unsigned)(Rb * K + C) * 2u; }
    const size_t kstep = (size_t)(BK * 2);
    const size_t hstep = (size_t)HALF * K * 2;
    const size_t tstep = 2 * hstep;
    const unsigned ldsw = (unsigned)wid * 1024u;
    const int aoff = lds_byte(wr * 64 + fr, fq * 8), boff = lds_byte(wc * 32 + fr, fq * 8);
#define PG8_SA(b, h) (((b) * 2 + (h)) * HTB)
#define PG8_SB(b, h) ((4 + (b) * 2 + (h)) * HTB)
#define PG8_STAGE(bufoff, gbase, voff) do { _Pragma("unroll") for (int _i = 0; _i < 2; ++_i) \
        __builtin_amdgcn_global_load_lds((const unsigned*)((const char*)(gbase) + (voff)[_i]), (PG8_LAS unsigned*)(lds + (bufoff) + ldsw + _i * 8192), 16, 0, 0); } while (0)
#define PG8_LDA(dst, b, h) do { _Pragma("unroll") for (int m = 0; m < 4; ++m) _Pragma("unroll") for (int k = 0; k < 2; ++k) dst[m][k] = *(const PG8_LAS bf16x8*)(lds + PG8_SA(b, h) + aoff + m * 2048 + k * 1024); } while (0)
#define PG8_LDB(dst, b, h) do { _Pragma("unroll") for (int n = 0; n < 2; ++n) _Pragma("unroll") for (int k = 0; k < 2; ++k) dst[n][k] = *(const PG8_LAS bf16x8*)(lds + PG8_SB(b, h) + boff + n * 2048 + k * 1024); } while (0)
#define PG8_MMA(ai, bj, At, Bt) do { __builtin_amdgcn_s_setprio(1); _Pragma("unroll") for (int m = 0; m < 4; ++m) _Pragma("unroll") for (int n = 0; n < 2; ++n) _Pragma("unroll") for (int k = 0; k < 2; ++k) \
        acc[ai][bj][m][n] = __builtin_amdgcn_mfma_f32_16x16x32_bf16(Bt[n][k], At[m][k], acc[ai][bj][m][n], 0, 0, 0); __builtin_amdgcn_s_setprio(0); } while (0)
#define PG8_WAIT_V(n) asm volatile("s_waitcnt vmcnt(" #n ")" ::: "memory")
#define PG8_WAIT_L(n) asm volatile("s_waitcnt lgkmcnt(" #n ")" ::: "memory")
#define PG8_BAR __builtin_amdgcn_s_barrier()
#define PG8_SCHED __builtin_amdgcn_sched_barrier(0)
    Unit cur, nxt; int ui = 0;
    if (!S.next(0, cur)) return;
    f32x4 acc[2][2][4][2];
#pragma unroll
    for (int a = 0; a < 2; ++a)
#pragma unroll
        for (int b = 0; b < 2; ++b)
#pragma unroll
            for (int m = 0; m < 4; ++m)
#pragma unroll
                for (int n = 0; n < 2; ++n) acc[a][b][m][n] = (f32x4){0.f, 0.f, 0.f, 0.f};
    bf16x8 At[4][2], B0[2][2], B1[2][2];
    const char* cA = (const char*)g.A + (size_t)cur.pm * tstep; const char* cB = (const char*)g.Bt + (size_t)cur.pn * tstep;
    S.a_ready(cur);
    if constexpr (SP2) {
        PG8_STAGE(PG8_SB(0, 0), cB, voffB); PG8_STAGE(PG8_SB(0, 1), cB + hstep, voffB); PG8_STAGE(PG8_SA(0, 0), cA, voffA); PG8_STAGE(PG8_SA(0, 1), cA + hstep, voffA);
        if (wr == 1) PG8_BAR;
        PG8_WAIT_V(2); PG8_BAR;
        PG8_STAGE(PG8_SB(1, 0), cB + kstep, voffB); PG8_STAGE(PG8_SA(1, 0), cA + kstep, voffA); PG8_STAGE(PG8_SB(1, 1), cB + hstep + kstep, voffB);
        PG8_WAIT_V(6); PG8_BAR;
    } else {
        PG8_STAGE(PG8_SB(0, 0), cB, voffB); PG8_STAGE(PG8_SA(0, 0), cA, voffA); PG8_STAGE(PG8_SB(0, 1), cB + hstep, voffB); PG8_STAGE(PG8_SA(0, 1), cA + hstep, voffA);
        if (wr == 1) PG8_BAR;
        PG8_WAIT_V(4); PG8_BAR;
        PG8_STAGE(PG8_SB(1, 0), cB + kstep, voffB); PG8_STAGE(PG8_SA(1, 0), cA + kstep, voffA); PG8_STAGE(PG8_SB(1, 1), cB + hstep + kstep, voffB);
        PG8_WAIT_V(6); PG8_BAR;
    }
    for (;;) {
        const bool has_next = S.next(ui + 1, nxt);
        const char* nA = has_next ? (const char*)g.A + (size_t)nxt.pm * tstep : cA; const char* nB = has_next ? (const char*)g.Bt + (size_t)nxt.pn * tstep : cB;
        for (int t = 0; t < nt; t += 2) {
            const bool last = (t == nt - 2);
            const char* a1 = cA + (size_t)(t + 1) * kstep;
            const char* a2 = last ? nA : cA + (size_t)(t + 2) * kstep; const char* b2 = last ? nB : cB + (size_t)(t + 2) * kstep;
            const char* a3 = a2 + kstep; const char* b3 = b2 + kstep;
            if (last && has_next) S.a_ready(nxt);
            if constexpr (SP2) {
            PG8_LDB(B0, 0, 0); PG8_LDB(B1, 0, 1); PG8_SCHED; PG8_LDA(At, 0, 0); PG8_STAGE(PG8_SA(1, 1), a1 + hstep, voffA);
            PG8_WAIT_V(8); PG8_WAIT_L(0); PG8_BAR; PG8_MMA(0, 0, At, B0); PG8_MMA(0, 1, At, B1); PG8_BAR; PG8_SCHED;
            PG8_LDA(At, 0, 1); PG8_STAGE(PG8_SB(0, 0), b2, voffB); PG8_STAGE(PG8_SB(0, 1), b2 + hstep, voffB); PG8_STAGE(PG8_SA(0, 0), a2, voffA);
            PG8_WAIT_V(8); PG8_WAIT_L(0); PG8_BAR; PG8_MMA(1, 0, At, B0); PG8_MMA(1, 1, At, B1); PG8_BAR; PG8_SCHED;
            PG8_LDB(B0, 1, 0); PG8_LDB(B1, 1, 1); PG8_SCHED; PG8_LDA(At, 1, 0); PG8_STAGE(PG8_SA(0, 1), a2 + hstep, voffA);
            PG8_WAIT_V(8); PG8_WAIT_L(0); PG8_BAR; PG8_MMA(0, 0, At, B0); PG8_MMA(0, 1, At, B1); PG8_BAR; PG8_SCHED;
            PG8_LDA(At, 1, 1); PG8_STAGE(PG8_SB(1, 0), b3, voffB); PG8_STAGE(PG8_SB(1, 1), b3 + hstep, voffB); PG8_STAGE(PG8_SA(1, 0), a3, voffA);
            PG8_WAIT_V(8); PG8_WAIT_L(0); PG8_BAR; PG8_MMA(1, 0, At, B0); PG8_MMA(1, 1, At, B1); PG8_BAR; PG8_SCHED;
            } else {
            PG8_LDB(B0, 0, 0); PG8_SCHED; PG8_LDA(At, 0, 0); PG8_STAGE(PG8_SA(1, 1), a1 + hstep, voffA);
            PG8_WAIT_L(8); PG8_BAR; PG8_WAIT_L(0); PG8_MMA(0, 0, At, B0); PG8_BAR; PG8_SCHED;
            PG8_LDB(B1, 0, 1); PG8_STAGE(PG8_SB(0, 0), b2, voffB);
            PG8_BAR; PG8_WAIT_L(0); PG8_MMA(0, 1, At, B1); PG8_BAR;
            PG8_LDA(At, 0, 1); PG8_STAGE(PG8_SA(0, 0), a2, voffA);
            PG8_BAR; PG8_WAIT_L(0); PG8_MMA(1, 0, At, B0); PG8_BAR; PG8_SCHED;
            PG8_STAGE(PG8_SB(0, 1), b2 + hstep, voffB);
            PG8_WAIT_V(6); PG8_BAR; PG8_MMA(1, 1, At, B1); PG8_BAR;
            PG8_LDB(B0, 1, 0); PG8_SCHED; PG8_LDA(At, 1, 0); PG8_STAGE(PG8_SA(0, 1), a2 + hstep, voffA);
            PG8_WAIT_L(8); PG8_BAR; PG8_WAIT_L(0); PG8_MMA(0, 0, At, B0); PG8_BAR; PG8_SCHED;
            PG8_LDB(B1, 1, 1); PG8_STAGE(PG8_SB(1, 0), b3, voffB);
            PG8_BAR; PG8_WAIT_L(0); PG8_MMA(0, 1, At, B1); PG8_BAR;
            PG8_LDA(At, 1, 1); PG8_STAGE(PG8_SA(1, 0), a3, voffA);
            PG8_BAR; PG8_WAIT_L(0); PG8_MMA(1, 0, At, B0); PG8_BAR; PG8_SCHED;
            PG8_STAGE(PG8_SB(1, 1), b3 + hstep, voffB);
            PG8_WAIT_V(6); PG8_BAR; PG8_MMA(1, 1, At, B1); PG8_BAR;
            }
        }
        if constexpr (ALIGN_EPI) { if (wr == 0) PG8_BAR; }
        if constexpr (!Epi::AFTER_DRAIN) { E(acc, cur, wr, wc, fr, fq); S.done(cur); }
        if (!has_next) break;
#pragma unroll
        for (int a = 0; a < 2; ++a)
#pragma unroll
            for (int b = 0; b < 2; ++b)
#pragma unroll
                for (int m = 0; m < 4; ++m)
#pragma unroll
                    for (int n = 0; n < 2; ++n) acc[a][b][m][n] = (f32x4){0.f, 0.f, 0.f, 0.f};
        cur = nxt; cA = nA; cB = nB; ++ui;
        if constexpr (ALIGN_EPI) { if (wr == 1) PG8_BAR; }
    }
    PG8_WAIT_V(0);
    if constexpr (!ALIGN_EPI) { if (wr == 0) PG8_BAR; }
    PG8_BAR;
    if constexpr (Epi::AFTER_DRAIN) { E.fused(acc, cur, wr, wc, fr, fq, lds, wid, lane); S.done(cur); }
#undef PG8_SA
#undef PG8_SB
#undef PG8_STAGE
#undef PG8_LDA
#undef PG8_LDB
#undef PG8_MMA
#undef PG8_WAIT_V
#undef PG8_WAIT_L
#undef PG8_BAR
#undef PG8_SCHED
}
}

namespace att {
using bf16 = __hip_bfloat16;
constexpr int   D = 128, NW = 8, QBLK = 32, KVBLK = 64;
constexpr float SCALE = 0.088388347648318440f;
constexpr float THR = 8.f;
constexpr int SDEPTH = ATT_SDEPTH;
constexpr int LDQ = 1024, LDK = 256, LDO = 1024;
constexpr size_t SHM_V = KVBLK * D * 2, SHM_K = KVBLK * D * 2, SHM_ATTN = 2 * SHM_V + 2 * SHM_K + NW * 64 * 4;
constexpr size_t OST_OFF = 69632;
using bf16x8 = __attribute__((ext_vector_type(8))) short;
using s16x4  = __attribute__((ext_vector_type(4))) short;
using f32x16 = __attribute__((ext_vector_type(16))) float;
using f32x8  = __attribute__((ext_vector_type(8))) float;
using u32x4  = __attribute__((ext_vector_type(4))) unsigned;
#define KSWZ(row, colB) ((row) * 256 + ((colB) ^ (((row) & 7) << 4)))
#define SBAR() __builtin_amdgcn_sched_barrier(0)
__device__ __forceinline__ int crow(int r, int hi) { return (r & 3) + 8 * (r >> 2) + 4 * hi; }
__device__ __forceinline__ unsigned cvtpk(float lo, float hi) {
  unsigned r; asm volatile("v_cvt_pk_bf16_f32 %0, %1, %2" : "=v"(r) : "v"(lo), "v"(hi)); return r;
}
template <typename TIn> struct Stage;
template <> struct Stage<bf16>  { using T = bf16x8;
  __device__ static __forceinline__ T ld8(const bf16* p) { return *reinterpret_cast<const bf16x8*>(p); }
  __device__ static __forceinline__ bf16x8 tobf(T x) { return x; } };
template <> struct Stage<float> { using T = f32x8;
  __device__ static __forceinline__ T ld8(const float* p) { return *reinterpret_cast<const f32x8*>(p); }
  __device__ static __forceinline__ bf16x8 tobf(T x) {
    u32x4 w = {cvtpk(x[0], x[1]), cvtpk(x[2], x[3]), cvtpk(x[4], x[5]), cvtpk(x[6], x[7])}; return *reinterpret_cast<bf16x8*>(&w); } };

__device__ __forceinline__ void partialSM(f32x16& p0, f32x16& p1, float& m_reg, float& mn, float& alpha) {
  constexpr float C = SCALE * 1.4426950408889634f;
  float pmax = p0[0]; for (int r = 1; r < 16; ++r) pmax = fmaxf(pmax, p0[r]); for (int r = 0; r < 16; ++r) pmax = fmaxf(pmax, p1[r]);
  { auto rr = __builtin_amdgcn_permlane32_swap(__float_as_uint(pmax), __float_as_uint(pmax), false, false);
    pmax = fmaxf(__uint_as_float(rr[0]), __uint_as_float(rr[1])); }
  if (__builtin_expect(__all(pmax - m_reg <= THR / SCALE), 1)) { mn = m_reg; alpha = 1.f; }
  else { mn = fmaxf(m_reg, pmax); alpha = __builtin_amdgcn_exp2f((m_reg - mn) * C); m_reg = mn; }
  float mnC = -mn * C;
  for (int r = 0; r < 16; ++r) p0[r] = fmaf(p0[r], C, mnC); for (int r = 0; r < 16; ++r) p1[r] = fmaf(p1[r], C, mnC);
  for (int r = 0; r < 16; ++r) p0[r] = __builtin_amdgcn_exp2f(p0[r]);
}
__device__ __forceinline__ void finishSM(f32x16& p0, f32x16& p1, float alpha, float& l_reg, bf16x8& pa0, bf16x8& pa1, bf16x8& pa2, bf16x8& pa3) {
  for (int r = 0; r < 16; ++r) p1[r] = __builtin_amdgcn_exp2f(p1[r]);
  float ps = 0; for (int r = 0; r < 16; ++r) ps += p0[r]; for (int r = 0; r < 16; ++r) ps += p1[r];
  { auto rr = __builtin_amdgcn_permlane32_swap(__float_as_uint(ps), __float_as_uint(ps), false, false);
    ps = __uint_as_float(rr[0]) + __uint_as_float(rr[1]); }
  l_reg = l_reg * alpha + ps;
#define PK4(P, BASE, OUT) do { unsigned a0 = cvtpk(P[BASE + 0], P[BASE + 1]), a1 = cvtpk(P[BASE + 2], P[BASE + 3]);   \
    unsigned b0 = cvtpk(P[BASE + 4], P[BASE + 5]), b1 = cvtpk(P[BASE + 6], P[BASE + 7]);                              \
    auto r0 = __builtin_amdgcn_permlane32_swap(a0, b0, false, false); auto r1 = __builtin_amdgcn_permlane32_swap(a1, b1, false, false); \
    u32x4 w = {r0[0], r1[0], r0[1], r1[1]}; OUT = *reinterpret_cast<bf16x8*>(&w); } while (0)
  PK4(p0, 0, pa0); PK4(p0, 8, pa1); PK4(p1, 0, pa2); PK4(p1, 8, pa3);
#undef PK4
}
__device__ __forceinline__ void qkt(f32x16& p0, f32x16& p1, const bf16* Ks, const bf16x8* qr, int r32, int hi) {
  p0 = f32x16{}; p1 = f32x16{};
  for (int d0 = 0; d0 < 8; ++d0) { int cb = (d0 * 16 + hi * 8) * 2;
    bf16x8 b0 = *reinterpret_cast<const bf16x8*>((const char*)Ks + KSWZ(r32, cb));
    bf16x8 b1 = *reinterpret_cast<const bf16x8*>((const char*)Ks + KSWZ(32 + r32, cb));
    p0 = __builtin_amdgcn_mfma_f32_32x32x16_bf16(b0, qr[d0], p0, 0, 0, 0);
    p1 = __builtin_amdgcn_mfma_f32_32x32x16_bf16(b1, qr[d0], p1, 0, 0, 0); }
}
__device__ __forceinline__ int v_st(int k, int c) { const int kk = (k & ~0xC) | ((k & 4) << 1) | ((k & 8) >> 1); return ((kk >> 3) * 4 + (c >> 5)) * 512 + ((kk & 7) * 32 + (c & 31)) * 2; }
__device__ __forceinline__ int v_rd_base(int lane) { return ((lane & 3) << 3) | (((lane >> 2) & 3) << 6) | (((lane >> 4) & 1) << 5) | (((lane >> 5) & 1) << 8); }
constexpr int v_rd_off(int d0, int ks, int half) { return d0 * 512 + ks * 4096 + half * 2048; }
template <int OFF> __device__ __forceinline__ s16x4 tr_read(int vb) {
  s16x4 r; asm volatile("ds_read_b64_tr_b16 %0, %1 offset:%2" : "=&v"(r) : "v"(vb), "i"(OFF) : "memory"); return r;
}
template <int D0> __device__ __forceinline__ void pv_one(f32x16& od, int vb, bf16x8 pa0, bf16x8 pa1, bf16x8 pa2, bf16x8 pa3) {
  const s16x4 l0 = tr_read<v_rd_off(D0, 0, 0)>(vb), h0 = tr_read<v_rd_off(D0, 0, 1)>(vb), l1 = tr_read<v_rd_off(D0, 1, 0)>(vb), h1 = tr_read<v_rd_off(D0, 1, 1)>(vb);
  const s16x4 l2 = tr_read<v_rd_off(D0, 2, 0)>(vb), h2 = tr_read<v_rd_off(D0, 2, 1)>(vb), l3 = tr_read<v_rd_off(D0, 3, 0)>(vb), h3 = tr_read<v_rd_off(D0, 3, 1)>(vb);
  asm volatile("s_waitcnt lgkmcnt(0)" ::: "memory"); SBAR();
#define PK(L, H) (bf16x8){L[0], L[1], L[2], L[3], H[0], H[1], H[2], H[3]}
  od = __builtin_amdgcn_mfma_f32_32x32x16_bf16(pa0, PK(l0, h0), od, 0, 0, 0);
  od = __builtin_amdgcn_mfma_f32_32x32x16_bf16(pa1, PK(l1, h1), od, 0, 0, 0);
  od = __builtin_amdgcn_mfma_f32_32x32x16_bf16(pa2, PK(l2, h2), od, 0, 0, 0);
  od = __builtin_amdgcn_mfma_f32_32x32x16_bf16(pa3, PK(l3, h3), od, 0, 0, 0);
#undef PK
}
__device__ __forceinline__ void pv_d0(f32x16* o, int vb, bf16x8 pa0, bf16x8 pa1, bf16x8 pa2, bf16x8 pa3) {
  pv_one<0>(o[0], vb, pa0, pa1, pa2, pa3); pv_one<1>(o[1], vb, pa0, pa1, pa2, pa3); pv_one<2>(o[2], vb, pa0, pa1, pa2, pa3); pv_one<3>(o[3], vb, pa0, pa1, pa2, pa3);
}

__device__ __forceinline__ float bf2f(short s) { return __uint_as_float(((unsigned)(unsigned short)s) << 16); }

__device__ __forceinline__ void qkt2(f32x16& p0, f32x16& p1, const bf16* Ks, const bf16x8* qr, const f32x16& negm, int r32, int hi) {
  p0 = negm; p1 = negm;
#pragma unroll
  for (int d0 = 0; d0 < 8; ++d0) { int cb = (d0 * 16 + hi * 8) * 2;
    bf16x8 b0 = *reinterpret_cast<const bf16x8*>((const char*)Ks + KSWZ(r32, cb));
    bf16x8 b1 = *reinterpret_cast<const bf16x8*>((const char*)Ks + KSWZ(32 + r32, cb));
    p0 = __builtin_amdgcn_mfma_f32_32x32x16_bf16(b0, qr[d0], p0, 0, 0, 0); p1 = __builtin_amdgcn_mfma_f32_32x32x16_bf16(b1, qr[d0], p1, 0, 0, 0); }
}
__device__ __forceinline__ void expA(f32x16& p0, float negmc) {
#pragma unroll
  for (int r = 0; r < 16; ++r) p0[r] = __builtin_amdgcn_exp2f(ATT_NEGM ? p0[r] : p0[r] + negmc);
}
__device__ __forceinline__ void finishSM2(f32x16& p0, f32x16& p1, float negmc, float& l_reg, bf16x8& pa0, bf16x8& pa1, bf16x8& pa2, bf16x8& pa3) {
#pragma unroll
  for (int r = 0; r < 16; ++r) p1[r] = __builtin_amdgcn_exp2f(ATT_NEGM ? p1[r] : p1[r] + negmc);
  float ps = 0;
#pragma unroll
  for (int r = 0; r < 16; ++r) ps += p0[r];
#pragma unroll
  for (int r = 0; r < 16; ++r) ps += p1[r];
  l_reg += ps;
#define PK4(P, BASE, OUT) do { unsigned a0 = cvtpk(P[BASE + 0], P[BASE + 1]), a1 = cvtpk(P[BASE + 2], P[BASE + 3]);   \
    unsigned b0 = cvtpk(P[BASE + 4], P[BASE + 5]), b1 = cvtpk(P[BASE + 6], P[BASE + 7]);                              \
    auto r0 = __builtin_amdgcn_permlane32_swap(a0, b0, false, false); auto r1 = __builtin_amdgcn_permlane32_swap(a1, b1, false, false); \
    u32x4 w = {r0[0], r1[0], r0[1], r1[1]}; OUT = *reinterpret_cast<bf16x8*>(&w); } while (0)
  PK4(p0, 0, pa0); PK4(p0, 8, pa1); PK4(p1, 0, pa2); PK4(p1, 8, pa3);
#undef PK4
}

__device__ __forceinline__ void attn_unit(const bf16* Qb, const bf16* __restrict__ Kh, const bf16* __restrict__ Vh,
                                          bf16* Ob, int seq, int t0, const float* __restrict__ qgain, const float2* __restrict__ rope, float negmc, char* lds) {
  using St = Stage<bf16>;
  const int tid = mk_tid(), wid = tid >> 6, lane = tid & 63, r32 = lane & 31, hi = lane >> 5;
  bf16* V_lds = (bf16*)lds; bf16* K_lds = (bf16*)(lds + 2 * SHM_V);
  float* ws = (float*)(lds + 2 * SHM_V + 2 * SHM_K) + wid * 64; float* li_l = ws;
  float l_reg = 0; f32x16 o[4] = {}; bf16x8 qr[8]; f32x16 negm; for (int r = 0; r < 16; ++r) negm[r] = ATT_NEGM ? negmc : 0.f; if (ATT_NEGM) asm volatile("" : "+v"(negm));
  const bf16* Qw = Qb + (long)(wid * QBLK + r32) * LDQ + hi * 8;
#pragma unroll
  for (int d0 = 0; d0 < 8; ++d0) qr[d0] = St::ld8(Qw + d0 * 16);
  (void)t0; (void)qgain; (void)rope;
  const int sr = tid >> 4, sc = (tid & 15) * 8, vst0 = v_st(sr, sc), vst1 = v_st(32 + sr, sc);
  const int vb0 = (int)(uintptr_t)V_lds + v_rd_base(lane);
  struct { typename St::T vs0, vs1, ks0, ks1; } sr_[SDEPTH];
#define SLOAD(i, k0) do { sr_[i].vs0 = St::ld8(&Vh[(long)((k0) + sr) * LDK + sc]); sr_[i].vs1 = St::ld8(&Vh[(long)((k0) + 32 + sr) * LDK + sc]); \
    sr_[i].ks0 = St::ld8(&Kh[(long)((k0) + sr) * LDK + sc]); sr_[i].ks1 = St::ld8(&Kh[(long)((k0) + 32 + sr) * LDK + sc]); } while (0)
#define SWRITE(b, i) do { *(bf16x8*)((char*)V_lds + (b) * SHM_V + vst0) = St::tobf(sr_[i].vs0);          \
    *(bf16x8*)((char*)V_lds + (b) * SHM_V + vst1) = St::tobf(sr_[i].vs1); int kc = sc * 2;               \
    *(bf16x8*)((char*)K_lds + (b) * SHM_K + KSWZ(sr, kc)) = St::tobf(sr_[i].ks0);                       \
    *(bf16x8*)((char*)K_lds + (b) * SHM_K + KSWZ(32 + sr, kc)) = St::tobf(sr_[i].ks1); } while (0)
#define SWAIT() do { if constexpr (SDEPTH == 2) asm volatile("s_waitcnt vmcnt(4)" ::: "memory"); else asm volatile("s_waitcnt vmcnt(0)" ::: "memory"); } while (0)
  f32x16 pA0, pA1, pB0, pB1; bf16x8 pa0, pa1, pa2, pa3; const int NT = seq / KVBLK;
  constexpr int SE = 0, SO = SDEPTH - 1;
  SLOAD(SE, 0); asm volatile("s_waitcnt vmcnt(0)" ::: "memory"); SWRITE(0, SE); __syncthreads();
  qkt2(pA0, pA1, K_lds, qr, negm, r32, hi); expA(pA0, negmc);
  SLOAD(SO, KVBLK); if constexpr (SDEPTH == 2) { if (2 < NT) SLOAD(SE, 2 * KVBLK); }
  SWAIT(); SWRITE(1, SO); __syncthreads();
  for (int j = 1; j + 1 < NT; j += 2) {
    SBAR(); qkt2(pB0, pB1, (bf16*)((char*)K_lds + SHM_K), qr, negm, r32, hi); if (ATT_SB) SBAR();
    finishSM2(pA0, pA1, negmc, l_reg, pa0, pa1, pa2, pa3); SBAR();
    SLOAD(SO, (j + SDEPTH) * KVBLK); SBAR();
    pv_d0(o, vb0, pa0, pa1, pa2, pa3); SBAR(); expA(pB0, negmc); SBAR();
    __syncthreads(); SWAIT(); SWRITE(0, SE);
    __syncthreads();
    SBAR(); qkt2(pA0, pA1, K_lds, qr, negm, r32, hi); if (ATT_SB) SBAR();
    finishSM2(pB0, pB1, negmc, l_reg, pa0, pa1, pa2, pa3); SBAR();
    if (SDEPTH == 1 || j + 3 < NT) SLOAD(SE, (j + 1 + SDEPTH) * KVBLK); SBAR();
    pv_d0(o, vb0 + (int)SHM_V, pa0, pa1, pa2, pa3); SBAR(); expA(pA0, negmc); SBAR();
    __syncthreads(); SWAIT(); SWRITE(1, SO);
    __syncthreads();
  }
  SBAR(); qkt2(pB0, pB1, (bf16*)((char*)K_lds + SHM_K), qr, negm, r32, hi);
  finishSM2(pA0, pA1, negmc, l_reg, pa0, pa1, pa2, pa3); SBAR();
  pv_d0(o, vb0, pa0, pa1, pa2, pa3); expA(pB0, negmc);
  __syncthreads();
  finishSM2(pB0, pB1, negmc, l_reg, pa0, pa1, pa2, pa3); SBAR();
  pv_d0(o, vb0 + (int)SHM_V, pa0, pa1, pa2, pa3);
  { auto rr = __builtin_amdgcn_permlane32_swap(__float_as_uint(l_reg), __float_as_uint(l_reg), false, false); l_reg = __uint_as_float(rr[0]) + __uint_as_float(rr[1]); }
  if (hi == 0) li_l[r32] = l_reg; asm volatile("s_waitcnt lgkmcnt(0)" ::: "memory");
  float rli[16];
#pragma unroll
  for (int r = 0; r < 16; ++r) rli[r] = __builtin_amdgcn_rcpf(li_l[crow(r, hi)]);
  { bf16* stg = (bf16*)(lds + OST_OFF) + wid * (32 * 128);
#pragma unroll
    for (int r = 0; r < 16; ++r) { const int orow = crow(r, hi);
#pragma unroll
      for (int d0 = 0; d0 < 4; ++d0) stg[orow * 128 + d0 * 32 + r32] = __float2bfloat16(o[d0][r] * rli[r]); }
    asm volatile("s_waitcnt lgkmcnt(0)" ::: "memory");
    bf16* Ow = Ob + (long)(wid * QBLK) * LDO;
#pragma unroll
    for (int i = 0; i < 8; ++i) { const int row = i * 4 + (lane >> 4), ch = lane & 15; const u32x4 v = *(const u32x4*)(stg + row * 128 + ch * 8); *(u32x4*)(Ow + (long)row * LDO + ch * 8) = v; }
    asm volatile("s_waitcnt lgkmcnt(0)" ::: "memory"); }
  __syncthreads();
#undef SLOAD
#undef SWRITE
#undef SWAIT
}
}

#define LAS __attribute__((address_space(3)))
typedef unsigned short bf16_t;
typedef unsigned v4u __attribute__((ext_vector_type(4)));
typedef float f32x4 __attribute__((ext_vector_type(4)));
typedef float f32x16 __attribute__((ext_vector_type(16)));
typedef short bf16x8 __attribute__((ext_vector_type(8)));
typedef short s16x4 __attribute__((ext_vector_type(4)));
#define LDS_WAIT() asm volatile("s_waitcnt lgkmcnt(0)" ::: "memory")

constexpr int NWAVES = 8, NTHREADS = 512;
constexpr int DM = 1024, DFF = 2816, NQKV = 1536;
constexpr int NTOK_P = 16384, NTOK_S = 32768, NTOK = 49152, SEQ_P = 8192, SEQ_S = 4096, NB_P = 2, NB_S = 8;
constexpr float EPS = 1e-6f;
constexpr size_t MiB = 1u << 20;
constexpr size_t WS_WGU = 1 * MiB, WS_WD = 45 * MiB, WS_WQKV = 67 * MiB, WS_WO = 73 * MiB, WS_W2 = 77 * MiB, WS_A1P = 85 * MiB, WS_A1S = 89 * MiB, WS_A2 = 90 * MiB, WS_ROPE = 90 * MiB + 65536, WS_QKG = 90 * MiB + 131072;
constexpr size_t WS_POOL = 92 * MiB, WS_RSS = 476 * MiB, WS_END = 482 * MiB, WS_TS = 90 * MiB + 196608;
constexpr size_t WS_F = WS_POOL, WS_T = WS_POOL + 192 * MiB, WS_HID = WS_POOL, WS_QO = WS_POOL, WS_K = WS_POOL + 96 * MiB, WS_V = WS_POOL + 120 * MiB, WS_XH = WS_POOL + 288 * MiB;
constexpr size_t RSS_STRIDE = (size_t)49152 * 4;
constexpr int LDS_BYTES = 147456;

__device__ __forceinline__ unsigned f2bf(float f) { unsigned u = __builtin_bit_cast(unsigned, f); return (u + 0x7fffu + ((u >> 16) & 1u)) >> 16; }
__device__ __forceinline__ unsigned pk2(float lo, float hi) { return f2bf(lo) | (f2bf(hi) << 16); }
__device__ __forceinline__ float wave_sum(float v) {
#pragma unroll
    for (int o = 1; o < 64; o <<= 1) v += __shfl_xor(v, o);
    return v;
}

template <class RowMap>
__device__ __forceinline__ void transpose_item(const float* __restrict__ W, int K, int N, bf16_t* WT, int ldk, const float* __restrict__ gain, RowMap rm, LAS float* scr, int item, int lane) {
    const int nblk = N / 64, kb = item / nblk, nb = item % nblk, k0 = 64 * kb, n0 = 64 * nb;
#pragma unroll
    for (int h = 0; h < 2; ++h) {
        float v[32];
#pragma unroll
        for (int i = 0; i < 32; ++i) v[i] = W[(size_t)(k0 + 32 * h + i) * N + n0 + lane];
#pragma unroll
        for (int i = 0; i < 32; ++i) { const int kk = 32 * h + i; float x = v[i]; if (gain) x *= gain[k0 + kk]; scr[kk * 64 + (lane ^ (kk & 0x38))] = x; }
    }
    LDS_WAIT(); asm volatile("" ::: "memory");
    const int c = lane & 7;
#pragma unroll
    for (int j = 0; j < 8; ++j) { const int n = (lane >> 3) + 8 * j; const LAS float* s = scr + (8 * c) * 64 + (n ^ (8 * c));
        v4u o; o.x = pk2(s[0 * 64], s[1 * 64]); o.y = pk2(s[2 * 64], s[3 * 64]); o.z = pk2(s[4 * 64], s[5 * 64]); o.w = pk2(s[6 * 64], s[7 * 64]);
        *(v4u*)(WT + (size_t)rm(n0 + n) * ldk + k0 + 8 * c) = o; }
    LDS_WAIT(); asm volatile("" ::: "memory");
}
struct RmId { __device__ __forceinline__ int operator()(int n) const { return n; } };
struct RmGU { int off; __device__ __forceinline__ int operator()(int n) const { return ((n >> 7) << 8) + (n & 127) + off; } };

__device__ __forceinline__ void cvt_row2(const float* xa, const float* xb, bf16_t* oa, bf16_t* ob, float* ra, float* rb, int lane) {
    const f32x4* pa = (const f32x4*)xa + lane; const f32x4* pb = (const f32x4*)xb + lane;
    f32x4 va[4], vb[4]; float sa = 0.f, sb = 0.f;
#pragma unroll
    for (int j = 0; j < 4; ++j) { va[j] = pa[64 * j]; vb[j] = pb[64 * j]; }
#pragma unroll
    for (int j = 0; j < 4; ++j) { sa += (va[j].x * va[j].x + va[j].y * va[j].y) + (va[j].z * va[j].z + va[j].w * va[j].w); sb += (vb[j].x * vb[j].x + vb[j].y * vb[j].y) + (vb[j].z * vb[j].z + vb[j].w * vb[j].w); }
    unsigned long long* qa = (unsigned long long*)oa + lane; unsigned long long* qb = (unsigned long long*)ob + lane;
#pragma unroll
    for (int j = 0; j < 4; ++j) { qa[64 * j] = (unsigned long long)pk2(va[j].x, va[j].y) | ((unsigned long long)pk2(va[j].z, va[j].w) << 32); qb[64 * j] = (unsigned long long)pk2(vb[j].x, vb[j].y) | ((unsigned long long)pk2(vb[j].z, vb[j].w) << 32); }
    sa = wave_sum(sa); sb = wave_sum(sb);
    if (lane == 0) { *(f32x4*)ra = (f32x4){sa, 0.f, 0.f, 0.f}; *(f32x4*)rb = (f32x4){sb, 0.f, 0.f, 0.f}; }
}

template <int OFF> __device__ __forceinline__ s16x4 tr_read_off(unsigned vb) {
    s16x4 r; asm volatile("ds_read_b64_tr_b16 %0, %1 offset:%2" : "=&v"(r) : "v"(vb), "i"(OFF) : "memory"); return r;
}
template <int KS, int NKS> struct BLoad {
    static __device__ __forceinline__ void run(bf16x8 (&b0)[NKS], bf16x8 (&b1)[NKS], unsigned base0, unsigned base1) {
        const s16x4 l0 = tr_read_off<(16 * KS) * 128>(base0), h0 = tr_read_off<(16 * KS + 4) * 128>(base0);
        const s16x4 l1 = tr_read_off<(16 * KS) * 128>(base1), h1 = tr_read_off<(16 * KS + 4) * 128>(base1);
        asm volatile("s_waitcnt lgkmcnt(0)" ::: "memory");
        b0[KS] = (bf16x8){l0[0], l0[1], l0[2], l0[3], h0[0], h0[1], h0[2], h0[3]};
        b1[KS] = (bf16x8){l1[0], l1[1], l1[2], l1[3], h1[0], h1[1], h1[2], h1[3]};
        if constexpr (KS + 1 < NKS) BLoad<KS + 1, NKS>::run(b0, b1, base0, base1);
    }
};
template <int KT, int MT, bool SC>
__device__ __forceinline__ void fft_unit(const bf16_t* __restrict__ A, const bf16_t* __restrict__ in, size_t in_stride, bf16_t* out, size_t so1, size_t so0, char* wl, int lane, const float* rs = nullptr, size_t rs_stride = 0) {
    constexpr int NKS = KT / 16;
    const int r32 = lane & 31, hi = lane >> 5;
    { const int lr = lane >> 3, ch = lane & 7;
      v4u dv[KT / 8]; f32x4 pq[SC ? KT / 8 : 1];
#pragma unroll
      for (int i = 0; i < KT / 8; ++i) dv[i] = *(const v4u*)(in + (size_t)(i * 8 + lr) * in_stride + ch * 8);
      if constexpr (SC) {
#pragma unroll
          for (int i = 0; i < KT / 8; ++i) pq[i] = *(const f32x4*)(rs + (size_t)(i * 8 + lr) * rs_stride * 4);
      }
#pragma unroll
      for (int i = 0; i < KT / 8; ++i) { const int row = i * 8 + lr; v4u v = dv[i];
          if constexpr (SC) { const float r = __builtin_amdgcn_rsqf(((pq[i][0] + pq[i][1]) + (pq[i][2] + pq[i][3])) * (1.0f / 1024.0f) + 1e-6f);
              v.x = pg8::cvt_pk_bf16(pg8::bflo(v.x) * r, pg8::bfhi(v.x) * r); v.y = pg8::cvt_pk_bf16(pg8::bflo(v.y) * r, pg8::bfhi(v.y) * r); v.z = pg8::cvt_pk_bf16(pg8::bflo(v.z) * r, pg8::bfhi(v.z) * r); v.w = pg8::cvt_pk_bf16(pg8::bflo(v.w) * r, pg8::bfhi(v.w) * r); }
          *(v4u*)(wl + row * 128 + 16 * (ch ^ (((row >> 1) & 1) << 2))) = v; } }
    LDS_WAIT(); asm volatile("" ::: "memory");
    bf16x8 b0[NKS], b1[NKS];
    { const int blk = (lane >> 4) & 1, q = (lane & 15) >> 2, p = lane & 3, qb = (q >> 1) & 1;
      const unsigned basel = (unsigned)(uintptr_t)wl + (unsigned)((8 * hi + q) * 128 + 16 * (2 * blk + (p >> 1)) + 8 * (p & 1));
      BLoad<0, NKS>::run(b0, b1, basel + 64u * (unsigned)qb, basel + 64u * (unsigned)(1 - qb)); }
    asm volatile("" ::: "memory");
    bf16_t* stg = (bf16_t*)wl;
    bf16x8 af[NKS], an[NKS];
#pragma unroll
    for (int ks = 0; ks < NKS; ++ks) an[ks] = *(const bf16x8*)(A + (size_t)r32 * KT + 16 * ks + 8 * hi);
#pragma unroll 1
    for (int mb = 0; mb < MT / 32; ++mb) {
#pragma unroll
        for (int ks = 0; ks < NKS; ++ks) af[ks] = an[ks];
        { const int mbn = mb + 1 < MT / 32 ? mb + 1 : mb;
#pragma unroll
          for (int ks = 0; ks < NKS; ++ks) an[ks] = *(const bf16x8*)(A + (size_t)(32 * mbn + r32) * KT + 16 * ks + 8 * hi); }
        f32x16 c0 = {}, c1 = {};
#pragma unroll
        for (int ks = 0; ks < NKS; ++ks) { c0 = __builtin_amdgcn_mfma_f32_32x32x16_bf16(af[ks], b0[ks], c0, 0, 0, 0); c1 = __builtin_amdgcn_mfma_f32_32x32x16_bf16(af[ks], b1[ks], c1, 0, 0, 0); }
#pragma unroll
        for (int r = 0; r < 16; ++r) { const int orow = (r & 3) + 8 * (r >> 2) + 4 * hi; stg[orow * 64 + r32] = (bf16_t)f2bf(c0[r]); stg[orow * 64 + 32 + r32] = (bf16_t)f2bf(c1[r]); }
        LDS_WAIT(); asm volatile("" ::: "memory");
#pragma unroll
        for (int i = 0; i < 4; ++i) { const int row = i * 8 + (lane >> 3), ch = lane & 7, m = 32 * mb + row; const v4u v = *(const v4u*)(stg + row * 64 + ch * 8);
            *(v4u*)(out + (size_t)(m >> 1) * so1 + (size_t)(m & 1) * so0 + ch * 8) = v; }
        LDS_WAIT(); asm volatile("" ::: "memory");
    }
}

typedef __attribute__((address_space(1))) unsigned gu32;
#define XB_TMO      128
#define XB_XCNT(j)  (256  + 64 * (j))
#define XB_XSUB(j)  (1280 + 64 * (j))
#define XB_XGEN(j)  (2304 + 64 * (j))
#define XB_TOP      3328
#define XB_TOPGEN   3392
#define XCD_BAR_WORDS 3456
#define XB_SPIN_CAP (1u << 22)

__device__ __forceinline__ unsigned xb_ld(unsigned* p)              { return __hip_atomic_load(p, __ATOMIC_RELAXED, __HIP_MEMORY_SCOPE_AGENT); }
__device__ __forceinline__ unsigned xb_add(unsigned* p, unsigned v) { return __hip_atomic_fetch_add(p, v, __ATOMIC_RELAXED, __HIP_MEMORY_SCOPE_AGENT); }
__device__ __forceinline__ unsigned xb_xcc_id() { return (unsigned)__builtin_amdgcn_s_getreg((3 << 11) | 20) & 0xFu; }
#define XB_SPIN(cond, bar) do { unsigned _sp = 0; while (cond) { __builtin_amdgcn_s_sleep(1); \
    if ((++_sp & 255u) == 0u) { if (xb_ld(&(bar)[XB_TMO])) break; if (_sp > XB_SPIN_CAP) { atomicAdd(&(bar)[XB_TMO], 1u); break; } } } } while (0)

struct XcdBarrier {
    unsigned* bar; unsigned x;
    volatile LAS unsigned* st;
};

__device__ __forceinline__ XcdBarrier xcd_barrier_post(unsigned* bar, volatile LAS unsigned* st) {
    XcdBarrier b; b.bar = bar; b.x = xb_xcc_id(); b.st = st;
    if (threadIdx.x == 0) (void)xb_add(&bar[XB_XCNT(b.x)], 1u);
    return b;
}
__device__ __forceinline__ void xcd_barrier_complete(unsigned* bar, unsigned x, unsigned& nloc, unsigned& nx) {
    const unsigned G = gridDim.x * gridDim.y * gridDim.z;
    unsigned sum, cnt, mine, sp = 0u;
    for (;;) {
        sum = 0u; cnt = 0u; mine = 0u;
#pragma unroll
        for (unsigned j = 0; j < 16; ++j) { const unsigned c = xb_ld(&bar[XB_XCNT(j)]); sum += c; cnt += (c > 0u) ? 1u : 0u; mine = (j == x) ? c : mine; }
        if (sum == G) break;
        __builtin_amdgcn_s_sleep(1);
        if ((++sp & 255u) == 0u) { if (xb_ld(&bar[XB_TMO])) break; if (sp > XB_SPIN_CAP) { atomicAdd(&bar[XB_TMO], 1u); break; } }
    }
    nloc = mine > 0u ? mine : 1u; nx = cnt > 0u ? cnt : 1u;
}

__device__ __forceinline__ void xcd_barrier(const XcdBarrier& b) {
    asm volatile("s_waitcnt vmcnt(0)" ::: "memory");
    __syncthreads();
    if (threadIdx.x == 0) {
        unsigned* bar = b.bar;
        __builtin_amdgcn_s_waitcnt(0);
        unsigned nloc = b.st[0], nx = b.st[1];
        if (nloc == 0u) { xcd_barrier_complete(bar, b.x, nloc, nx); b.st[0] = nloc; b.st[1] = nx; }
        const unsigned old = xb_add(&bar[XB_XSUB(b.x)], 1u);
        const unsigned gen = old / nloc;
        if (old + 1u == (gen + 1u) * nloc) {
            __builtin_amdgcn_fence(__ATOMIC_RELEASE, "agent");
            asm volatile("s_waitcnt vmcnt(0)" ::: "memory");
            const unsigned og = xb_add(&bar[XB_TOP], 1u);
            const unsigned tg = og / nx;
            if (og + 1u == (tg + 1u) * nx) xb_add(&bar[XB_TOPGEN], 1u);
            else XB_SPIN(xb_ld(&bar[XB_TOPGEN]) == tg, bar);
            __builtin_amdgcn_fence(__ATOMIC_ACQUIRE, "agent");
            xb_add(&bar[XB_XGEN(b.x)], 1u);
            asm volatile("s_waitcnt vmcnt(0)" ::: "memory");
        } else {
            XB_SPIN(xb_ld(&bar[XB_XGEN(b.x)]) == gen, bar);
            __builtin_amdgcn_fence(__ATOMIC_ACQUIRE, "agent");
            asm volatile("s_waitcnt vmcnt(0)" ::: "memory");
        }
    }
    __syncthreads();
}
constexpr int NPH_C = 21;
__device__ const float CS128[256] = {1.000000000e+00f, 9.987954562e-01f, 9.951847267e-01f, 9.891765100e-01f, 9.807852804e-01f, 9.700312532e-01f, 9.569403357e-01f, 9.415440652e-01f, 9.238795325e-01f, 9.039892931e-01f, 8.819212643e-01f, 8.577286100e-01f, 8.314696123e-01f, 8.032075315e-01f, 7.730104534e-01f, 7.409511254e-01f, 7.071067812e-01f, 6.715589548e-01f, 6.343932842e-01f, 5.956993045e-01f, 5.555702330e-01f, 5.141027442e-01f, 4.713967368e-01f, 4.275550934e-01f, 3.826834324e-01f, 3.368898534e-01f, 2.902846773e-01f, 2.429801799e-01f, 1.950903220e-01f, 1.467304745e-01f, 9.801714033e-02f, 4.906767433e-02f, 6.123233996e-17f, -4.906767433e-02f, -9.801714033e-02f, -1.467304745e-01f, -1.950903220e-01f, -2.429801799e-01f, -2.902846773e-01f, -3.368898534e-01f, -3.826834324e-01f, -4.275550934e-01f, -4.713967368e-01f, -5.141027442e-01f, -5.555702330e-01f, -5.956993045e-01f, -6.343932842e-01f, -6.715589548e-01f, -7.071067812e-01f, -7.409511254e-01f, -7.730104534e-01f, -8.032075315e-01f, -8.314696123e-01f, -8.577286100e-01f, -8.819212643e-01f, -9.039892931e-01f, -9.238795325e-01f, -9.415440652e-01f, -9.569403357e-01f, -9.700312532e-01f, -9.807852804e-01f, -9.891765100e-01f, -9.951847267e-01f, -9.987954562e-01f, -1.000000000e+00f, -9.987954562e-01f, -9.951847267e-01f, -9.891765100e-01f, -9.807852804e-01f, -9.700312532e-01f, -9.569403357e-01f, -9.415440652e-01f, -9.238795325e-01f, -9.039892931e-01f, -8.819212643e-01f, -8.577286100e-01f, -8.314696123e-01f, -8.032075315e-01f, -7.730104534e-01f, -7.409511254e-01f, -7.071067812e-01f, -6.715589548e-01f, -6.343932842e-01f, -5.956993045e-01f, -5.555702330e-01f, -5.141027442e-01f, -4.713967368e-01f, -4.275550934e-01f, -3.826834324e-01f, -3.368898534e-01f, -2.902846773e-01f, -2.429801799e-01f, -1.950903220e-01f, -1.467304745e-01f, -9.801714033e-02f, -4.906767433e-02f, -1.836970199e-16f, 4.906767433e-02f, 9.801714033e-02f, 1.467304745e-01f, 1.950903220e-01f, 2.429801799e-01f, 2.902846773e-01f, 3.368898534e-01f, 3.826834324e-01f, 4.275550934e-01f, 4.713967368e-01f, 5.141027442e-01f, 5.555702330e-01f, 5.956993045e-01f, 6.343932842e-01f, 6.715589548e-01f, 7.071067812e-01f, 7.409511254e-01f, 7.730104534e-01f, 8.032075315e-01f, 8.314696123e-01f, 8.577286100e-01f, 8.819212643e-01f, 9.039892931e-01f, 9.238795325e-01f, 9.415440652e-01f, 9.569403357e-01f, 9.700312532e-01f, 9.807852804e-01f, 9.891765100e-01f, 9.951847267e-01f, 9.987954562e-01f, 0.000000000e+00f, 4.906767433e-02f, 9.801714033e-02f, 1.467304745e-01f, 1.950903220e-01f, 2.429801799e-01f, 2.902846773e-01f, 3.368898534e-01f, 3.826834324e-01f, 4.275550934e-01f, 4.713967368e-01f, 5.141027442e-01f, 5.555702330e-01f, 5.956993045e-01f, 6.343932842e-01f, 6.715589548e-01f, 7.071067812e-01f, 7.409511254e-01f, 7.730104534e-01f, 8.032075315e-01f, 8.314696123e-01f, 8.577286100e-01f, 8.819212643e-01f, 9.039892931e-01f, 9.238795325e-01f, 9.415440652e-01f, 9.569403357e-01f, 9.700312532e-01f, 9.807852804e-01f, 9.891765100e-01f, 9.951847267e-01f, 9.987954562e-01f, 1.000000000e+00f, 9.987954562e-01f, 9.951847267e-01f, 9.891765100e-01f, 9.807852804e-01f, 9.700312532e-01f, 9.569403357e-01f, 9.415440652e-01f, 9.238795325e-01f, 9.039892931e-01f, 8.819212643e-01f, 8.577286100e-01f, 8.314696123e-01f, 8.032075315e-01f, 7.730104534e-01f, 7.409511254e-01f, 7.071067812e-01f, 6.715589548e-01f, 6.343932842e-01f, 5.956993045e-01f, 5.555702330e-01f, 5.141027442e-01f, 4.713967368e-01f, 4.275550934e-01f, 3.826834324e-01f, 3.368898534e-01f, 2.902846773e-01f, 2.429801799e-01f, 1.950903220e-01f, 1.467304745e-01f, 9.801714033e-02f, 4.906767433e-02f, 1.224646799e-16f, -4.906767433e-02f, -9.801714033e-02f, -1.467304745e-01f, -1.950903220e-01f, -2.429801799e-01f, -2.902846773e-01f, -3.368898534e-01f, -3.826834324e-01f, -4.275550934e-01f, -4.713967368e-01f, -5.141027442e-01f, -5.555702330e-01f, -5.956993045e-01f, -6.343932842e-01f, -6.715589548e-01f, -7.071067812e-01f, -7.409511254e-01f, -7.730104534e-01f, -8.032075315e-01f, -8.314696123e-01f, -8.577286100e-01f, -8.819212643e-01f, -9.039892931e-01f, -9.238795325e-01f, -9.415440652e-01f, -9.569403357e-01f, -9.700312532e-01f, -9.807852804e-01f, -9.891765100e-01f, -9.951847267e-01f, -9.987954562e-01f, -1.000000000e+00f, -9.987954562e-01f, -9.951847267e-01f, -9.891765100e-01f, -9.807852804e-01f, -9.700312532e-01f, -9.569403357e-01f, -9.415440652e-01f, -9.238795325e-01f, -9.039892931e-01f, -8.819212643e-01f, -8.577286100e-01f, -8.314696123e-01f, -8.032075315e-01f, -7.730104534e-01f, -7.409511254e-01f, -7.071067812e-01f, -6.715589548e-01f, -6.343932842e-01f, -5.956993045e-01f, -5.555702330e-01f, -5.141027442e-01f, -4.713967368e-01f, -4.275550934e-01f, -3.826834324e-01f, -3.368898534e-01f, -2.902846773e-01f, -2.429801799e-01f, -1.950903220e-01f, -1.467304745e-01f, -9.801714033e-02f, -4.906767433e-02f};
struct Args { const float* in[12]; float* out; unsigned char* ws; int ph_lo, ph_hi; };

__global__ void __launch_bounds__(NTHREADS, 2) mk_fwd(Args args) {
    extern __shared__ __attribute__((aligned(16))) unsigned char lds[];
    const int G = gridDim.x; const int bx = blockIdx.x; const int vcu = (G % 8 == 0) ? (bx % 8) * (G / 8) + bx / 8 : bx;
    const int NGW = G * NWAVES;
    unsigned char* ws = args.ws; float* X = args.out;
    bf16_t* Wgu = (bf16_t*)(ws + WS_WGU); bf16_t* Wd = (bf16_t*)(ws + WS_WD); bf16_t* Wqkv = (bf16_t*)(ws + WS_WQKV); bf16_t* Wo = (bf16_t*)(ws + WS_WO); bf16_t* W2 = (bf16_t*)(ws + WS_W2);
    bf16_t* A1P = (bf16_t*)(ws + WS_A1P); bf16_t* A1S = (bf16_t*)(ws + WS_A1S); bf16_t* A2 = (bf16_t*)(ws + WS_A2); bf16_t* A2M = (bf16_t*)(ws + WS_A2 + 32768); bf16_t* A2Z = (bf16_t*)(ws + WS_A2 + 98304); bf16_t* A2H = (bf16_t*)(ws + WS_A2 + 163840); float2* ROPE = (float2*)(ws + WS_ROPE); float* QKG = (float*)(ws + WS_QKG);
    bf16_t* XB0 = (bf16_t*)args.out; bf16_t* XBH = (bf16_t*)(ws + WS_XH); float* RSS = (float*)(ws + WS_RSS); bf16_t* FB = (bf16_t*)(ws + WS_F); bf16_t* TB = (bf16_t*)(ws + WS_T); bf16_t* HID = (bf16_t*)(ws + WS_HID);
    bf16_t* QO = (bf16_t*)(ws + WS_QO); bf16_t* KB = (bf16_t*)(ws + WS_K); bf16_t* VB = (bf16_t*)(ws + WS_V);
    LAS unsigned char* ldsl = (LAS unsigned char*)lds;
    const int lo = args.ph_lo, hi = args.ph_hi;
    int ph = 0;
    volatile LAS unsigned* MISC = (volatile LAS unsigned*)(ldsl + 131072 + 8192);
    if (threadIdx.x < 64) MISC[threadIdx.x] = 0u;
    __syncthreads();
    XcdBarrier xbar; xbar.bar = (unsigned*)(ws + 16384); xbar.x = xb_xcc_id(); xbar.st = MISC + 8;
    if (bx == 0) { for (int i = threadIdx.x; i < XCD_BAR_WORDS; i += NTHREADS) xbar.bar[i] = 0u; }
    unsigned long long* TS = (unsigned long long*)(ws + WS_TS);
    if (MK_PROBE && bx == 0 && threadIdx.x == 0) TS[0] = __builtin_amdgcn_s_memrealtime();
#define PH_BEGIN if (ph >= lo && ph < hi) { const int tid = mk_tid(), lane = tid & 63, wave = __builtin_amdgcn_readfirstlane(tid >> 6), gw = vcu * NWAVES + wave; (void)lane; (void)gw;
#define PH_END } ++ph; if (ph > lo && ph < hi) { if (ph == 1 || MK_CG_ONLY) { cg::this_grid().sync(); if (ph == 1 && threadIdx.x == 0) (void)xb_add(&xbar.bar[XB_XCNT(xbar.x)], 1u); } else xcd_barrier(xbar); } if (MK_PROBE && bx == 0 && threadIdx.x == 0) TS[ph] = __builtin_amdgcn_s_memrealtime();

    PH_BEGIN
    if (EN_P0) {
        LAS float* scr = (LAS float*)(ldsl + wave * 16384);
        if (MK_PROBE2 && bx == 0 && threadIdx.x == 0) TS[40] = __builtin_amdgcn_s_memrealtime();
        constexpr int I_G = 16 * 44, I_D = 44 * 16, I_QKV = 16 * 24, I_O = 16 * 16;
        constexpr int NITEMS = 4 * (2 * I_G + I_D) + 2 * (I_QKV + I_O);
        for (int it = gw; it < NITEMS; it += NGW) {
            int r = it;
            if (r < 4 * I_G) { const int l = r / I_G; transpose_item(args.in[9] + (size_t)l * DM * DFF, DM, DFF, Wgu + (size_t)l * 2 * DFF * DM, DM, args.in[3] + l * DM, RmGU{0}, scr, r % I_G, lane); continue; } r -= 4 * I_G;
            if (r < 4 * I_G) { const int l = r / I_G; transpose_item(args.in[10] + (size_t)l * DM * DFF, DM, DFF, Wgu + (size_t)l * 2 * DFF * DM, DM, args.in[3] + l * DM, RmGU{128}, scr, r % I_G, lane); continue; } r -= 4 * I_G;
            if (r < 4 * I_D) { const int l = r / I_D; transpose_item(args.in[11] + (size_t)l * DFF * DM, DFF, DM, Wd + (size_t)l * DM * DFF, DFF, (const float*)nullptr, RmId{}, scr, r % I_D, lane); continue; } r -= 4 * I_D;
            if (r < 2 * I_QKV) { const int j = r / I_QKV; transpose_item(args.in[5] + (size_t)j * DM * NQKV, DM, NQKV, Wqkv + (size_t)j * NQKV * DM, DM, args.in[2] + (2 * j + 1) * DM, RmId{}, scr, r % I_QKV, lane); continue; } r -= 2 * I_QKV;
            { const int j = r / I_O; transpose_item(args.in[8] + (size_t)j * DM * DM, DM, DM, Wo + (size_t)j * DM * DM, DM, (const float*)nullptr, RmId{}, scr, r % I_O, lane); }
        }
        if (MK_PROBE2) { __syncthreads(); if (bx == 0 && threadIdx.x == 0) TS[41] = __builtin_amdgcn_s_memrealtime(); }
        {
          for (int task = gw; task < 2048; task += NGW) {
              const int nb = task & 15, cc = (task >> 4) & 3, g = (task >> 6) & 7, p = (task >> 9) & 1, j = task >> 10;
              const int n = nb * 64 + lane; const float* w = args.in[4] + (size_t)j * DM * DM + (size_t)(g * 128) * DM + n; const float* tb = CS128 + p * 128;
              float acc[32];
#pragma unroll
              for (int ci = 0; ci < 32; ++ci) acc[ci] = 0.f;
              for (int jp0 = 0; jp0 < 128; jp0 += 8) { float wv[8];
#pragma unroll
                  for (int d = 0; d < 8; ++d) wv[d] = w[(size_t)(jp0 + d) * DM];
#pragma unroll
                  for (int d = 0; d < 8; ++d)
#pragma unroll
                      for (int ci = 0; ci < 32; ++ci) acc[ci] += tb[((cc * 32 + ci) * (jp0 + d)) & 127] * wv[d]; }
              const float* gain = args.in[2] + (2 * j) * DM + g * 128 + cc * 32;
              bf16_t* dst = W2 + (size_t)j * DM * 2048 + (size_t)n * 2048 + p * 1024 + g * 128 + cc * 32;
#pragma unroll
              for (int q4 = 0; q4 < 4; ++q4) { v4u o; const float sc = 0.08838834764831845f;
                  o.x = pk2(acc[8 * q4 + 0] * gain[8 * q4 + 0] * sc, acc[8 * q4 + 1] * gain[8 * q4 + 1] * sc); o.y = pk2(acc[8 * q4 + 2] * gain[8 * q4 + 2] * sc, acc[8 * q4 + 3] * gain[8 * q4 + 3] * sc);
                  o.z = pk2(acc[8 * q4 + 4] * gain[8 * q4 + 4] * sc, acc[8 * q4 + 5] * gain[8 * q4 + 5] * sc); o.w = pk2(acc[8 * q4 + 6] * gain[8 * q4 + 6] * sc, acc[8 * q4 + 7] * gain[8 * q4 + 7] * sc);
                  *(v4u*)(dst + 8 * q4) = o; }
          }
          LDS_WAIT(); asm volatile("" ::: "memory");
        }
        if (MK_PROBE2) { __syncthreads(); if (bx == 0 && threadIdx.x == 0) TS[42] = __builtin_amdgcn_s_memrealtime(); }
        { const int gt = gw * 64 + lane, NGT = NGW * 64;
          for (int e2 = gt; e2 < 64 * 256 * 64; e2 += NGT) {
              const int s1 = (e2 & 63) * 2, m = (e2 >> 6) & 255, s2 = e2 >> 14, k1 = m >> 1, pp = m & 1; float v[2];
#pragma unroll
              for (int d = 0; d < 2; ++d) { const int s = 64 * (s1 + d) + s2, r = (k1 * s) & 8191; const float x = (float)r * (1.0f / 4096.0f); v[d] = (pp ? -sinpif(x) : cospif(x)) * 0.08838834764831845f; if (m == 1) v[d] = ((s1 + d) & 1) ? -0.08838834764831845f : 0.08838834764831845f; }
              ((unsigned*)A1P)[e2] = pk2(v[0], v[1]); }
          for (int e2 = gt; e2 < 64 * 128 * 32; e2 += NGT) {
              const int s1 = (e2 & 31) * 2, m = (e2 >> 5) & 127, s2 = e2 >> 12, k1 = m >> 1, pp = m & 1; float v[2];
#pragma unroll
              for (int d = 0; d < 2; ++d) { const int s = 64 * (s1 + d) + s2, r = (k1 * s) & 4095; const float x = (float)r * (1.0f / 2048.0f); v[d] = (pp ? -sinpif(x) : cospif(x)) * 0.125f; if (m == 1) v[d] = ((s1 + d) & 1) ? -0.125f : 0.125f; }
              ((unsigned*)A1S)[e2] = pk2(v[0], v[1]); }
          for (int e2 = gt; e2 < 128 * 64; e2 += NGT) {
              const int k = (e2 & 63) * 2, m = e2 >> 6, k2 = m >> 1, pp = m & 1, p = k >> 6; float v[2];
#pragma unroll
              for (int d = 0; d < 2; ++d) { const int s2 = (k + d) & 63, r = (k2 * s2) & 63; const float x = (float)r * (1.0f / 32.0f); const float c = cospif(x), s = sinpif(x);
                  v[d] = (pp == 0 ? (p == 0 ? c : s) : (p == 0 ? -s : c)) * 0.125f; }
              ((unsigned*)A2)[e2] = pk2(v[0], v[1]); }
          for (int e2 = gt; e2 < 128 * 64; e2 += NGT) {
              const int k = (e2 & 63) * 2, m = e2 >> 6, k2 = m >> 1, pp = m & 1, p = k >> 6; float v[2];
#pragma unroll
              for (int d = 0; d < 2; ++d) { const int s2 = (k + d) & 63, r = ((k2 + 1) * s2) & 63; const float x = (float)r * (1.0f / 32.0f); const float c = cospif(x), s = sinpif(x);
                  v[d] = (pp == 0 ? (p == 0 ? c : -s) : (p == 0 ? -s : -c)) * 0.125f; }
              ((unsigned*)A2M)[e2] = pk2(v[0], v[1]); }
          for (int e2 = gt; e2 < 128 * 64; e2 += NGT) {
              const int k = (e2 & 63) * 2, m = e2 >> 6, k2 = m >> 1, pp = m & 1, p = k >> 6; float vz[2], vh[2];
#pragma unroll
              for (int d = 0; d < 2; ++d) { const int s2 = (k + d) & 63; const int r = (k2 * s2) & 63; const float x = (float)r * (1.0f / 32.0f);
                  vz[d] = p == 0 ? (pp == 0 ? cospif(x) : -sinpif(x)) * 0.125f : 0.f;
                  const int rh = (s2 * (2 * k2 + 1)) & 127; const float xh = (float)rh * (1.0f / 64.0f);
                  vh[d] = p == 1 ? (pp == 0 ? cospif(xh) : -sinpif(xh)) * 0.125f : 0.f; }
              ((unsigned*)A2Z)[e2] = pk2(vz[0], vz[1]); ((unsigned*)A2H)[e2] = pk2(vh[0], vh[1]); }
          if (gw == 0) {
#pragma unroll
              for (int j2 = 0; j2 < 2; ++j2) { float mq = fmaxf(fabsf(args.in[6][j2 * 128 + lane]), fabsf(args.in[6][j2 * 128 + 64 + lane])), mk = fmaxf(fabsf(args.in[7][j2 * 128 + lane]), fabsf(args.in[7][j2 * 128 + 64 + lane]));
#pragma unroll
                  for (int o = 1; o < 64; o <<= 1) { mq = fmaxf(mq, __shfl_xor(mq, o)); mk = fmaxf(mk, __shfl_xor(mk, o)); }
                  if (lane == 0) QKG[512 + j2] = -(128.0f * 1.02f * mq * mk) * (att::SCALE * 1.4426950408889634f); }
          }
          for (int e = gt; e < 512; e += NGT) { const int j = e >> 8, r = e & 255; QKG[e] = r < 128 ? args.in[6][j * 128 + r] : args.in[7][j * 128 + r - 128]; }
          for (int e = gt; e < 128 * 32; e += NGT) { const int i = e & 31, pos = e >> 5; const float inv = powf(10000.0f, -(float)i * (1.0f / 32.0f)); const float a = (float)pos * inv; ROPE[e] = make_float2(cosf(a), sinf(a)); }
        }
        if (MK_PROBE2) { __syncthreads(); if (bx == 0 && threadIdx.x == 0) TS[43] = __builtin_amdgcn_s_memrealtime(); }
        for (int m = 2 * gw; m < NTOK; m += 2 * NGW) { const float* src = m < NTOK_P ? args.in[0] + (size_t)m * DM : args.in[1] + (size_t)(m - NTOK_P) * DM; cvt_row2(src, src + DM, XB0 + (size_t)m * DM, XB0 + (size_t)(m + 1) * DM, RSS + (size_t)m * 4, RSS + (size_t)(m + 1) * 4, lane); }
    }
    PH_END

    for (int layer = 0; layer < 4; ++layer) {
        const int jj = layer >> 1;
        const float* rss_mix = RSS + (size_t)(2 * layer) * RSS_STRIDE;
        float* rss_ffn = RSS + (size_t)(2 * layer + 1) * RSS_STRIDE;
        float* rss_next = RSS + (size_t)(2 * layer + 2) * RSS_STRIDE;
        bf16_t* XBF = layer == 3 ? XBH : XB0;
        PG8_LAS float* Pscr = (PG8_LAS float*)(ldsl + 131072);
        if ((layer & 1) == 0) {
            PH_BEGIN
            if (EN_FFT) {
                char* wl = (char*)lds + wave * 16384;
                for (int u = gw; u < 2048; u += NGW) { const int cb = u & 15, s2 = (u >> 4) & 63, b = u >> 10; const size_t tok = (size_t)b * SEQ_P + s2;
                    fft_unit<128, 128, true>(A1P + (size_t)s2 * 256 * 128, XB0 + tok * DM + cb * 64, (size_t)64 * DM, TB + ((size_t)b * 2 * SEQ_P + s2) * DM + cb * 64, (size_t)2 * 64 * DM, (size_t)64 * DM, wl, lane, rss_mix + tok * 4, (size_t)64); }
                for (int u = gw; u < 8192; u += NGW) { const int cb = u & 15, s2 = (u >> 4) & 63, b = u >> 10; const size_t tok = (size_t)NTOK_P + (size_t)b * SEQ_S + s2;
                    fft_unit<64, 64, true>(A1S + (size_t)s2 * 128 * 64, XB0 + tok * DM + cb * 64, (size_t)64 * DM, TB + ((size_t)2 * NTOK_P + (size_t)b * 2 * SEQ_S + s2) * DM + cb * 64, (size_t)2 * 64 * DM, (size_t)64 * DM, wl, lane, rss_mix + tok * 4, (size_t)64); }
            }
            PH_END
            PH_BEGIN
            if (EN_FFT) {
                char* wl = (char*)lds + wave * 16384;
                for (int u = gw; u < 4096 + 8192; u += NGW) {
                    const bool P = u < 4096; const int v = P ? u : u - 4096; const int cb = v & 15; const int k1 = P ? ((v >> 4) & 127) : ((v >> 4) & 63); const int b = P ? (v >> 11) : (v >> 10);
                    const int N1h = P ? 64 : 32; const bool mir = k1 > N1h; const int k1s = mir ? 2 * N1h - k1 : (k1 == N1h ? 0 : k1); const bf16_t* Am = k1 == 0 ? A2Z : (k1 == N1h ? A2H : (mir ? A2M : A2));
                    const size_t trow = P ? ((size_t)b * 2 * SEQ_P + (size_t)k1s * 128) : ((size_t)2 * NTOK_P + (size_t)b * 2 * SEQ_S + (size_t)k1s * 128);
                    const size_t frow = P ? ((size_t)b * SEQ_P + k1) : ((size_t)NTOK_P + (size_t)b * SEQ_S + k1);
                    fft_unit<128, 128, false>(Am, TB + trow * DM + cb * 64, (size_t)DM, FB + frow * 2048 + cb * 64, P ? (size_t)128 * 2048 : (size_t)64 * 2048, (size_t)1024, wl, lane);
                }
            }
            PH_END
        } else {
            PH_BEGIN
            if (EN_QKV) {
                pg8::Gemm g{XB0, Wqkv + (size_t)jj * NQKV * DM, NTOK, NQKV, DM}; pg8::StaticOrder S; S.init(NTOK, NQKV, G, bx);
                pg8::EpiQKV E{QO, KB, VB, rss_mix, QKG + jj * 256, (const float*)ROPE, (PG8_LAS float*)(ldsl + 131072), att::SCALE * 1.4426950408889634f};
                pg8::gemm_phase<pg8::EpiQKV, pg8::StaticOrder, GU_ALIGN, GEMM_SP2>(ldsl, g, S, E);
            }
            PH_END
            PH_BEGIN
            if (EN_ATT) {
                const float* qg = QKG + jj * 256; const float negmc = QKG[512 + jj];
                for (int j = vcu; j < 1536; j += G) {
                    int b, h, qb, tok0, seq;
                    if (j < 512) { const int bh = j >> 5; qb = j & 31; b = bh >> 3; h = bh & 7; tok0 = b * SEQ_P; seq = SEQ_P; }
                    else { const int v = j - 512, bh = v >> 4; qb = v & 15; b = bh >> 3; h = bh & 7; tok0 = NTOK_P + b * SEQ_S; seq = SEQ_S; }
                    const att::bf16* Qb = (const att::bf16*)QO + ((size_t)tok0 + qb * 256) * 1024 + h * 128;
                    const att::bf16* Kh = (const att::bf16*)KB + (size_t)tok0 * 256 + (h >> 2) * 128;
                    const att::bf16* Vh = (const att::bf16*)VB + (size_t)tok0 * 256 + (h >> 2) * 128;
                    att::attn_unit(Qb, Kh, Vh, (att::bf16*)Qb, seq, qb * 256, qg, ROPE, negmc, (char*)lds);
                }
            }
            PH_END
        }
        PH_BEGIN
        if (EN_RES) {
            pg8::Gemm g = (layer & 1) ? pg8::Gemm{QO, Wo + (size_t)jj * DM * DM, NTOK, DM, DM} : pg8::Gemm{FB, W2 + (size_t)jj * DM * 2048, NTOK, DM, 2048};
            pg8::StaticOrder S; S.init(NTOK, DM, G, bx); pg8::EpiResB E{XB0, XBF, (float*)nullptr, rss_ffn, Pscr};
            pg8::gemm_phase<pg8::EpiResB, pg8::StaticOrder, true, GEMM_SP2>(ldsl, g, S, E);
        }
        PH_END
        PH_BEGIN
        if (EN_GU) {
            if (MK_SLEEP_US) { const unsigned long long t0 = __builtin_amdgcn_s_memrealtime(); while (__builtin_amdgcn_s_memrealtime() - t0 < 100ull * MK_SLEEP_US) __builtin_amdgcn_s_sleep(64); }
            pg8::Gemm g{XBF, Wgu + (size_t)layer * 2 * DFF * DM, NTOK, 2 * DFF, DM}; pg8::StaticOrder S; S.init(NTOK, 2 * DFF, G, bx);
            pg8::EpiSwiGLU E{HID, DFF, rss_ffn};
            pg8::gemm_phase<pg8::EpiSwiGLU, pg8::StaticOrder, GU_ALIGN, GEMM_SP2>(ldsl, g, S, E);
        }
        PH_END
        PH_BEGIN
        if (EN_RES) {
            pg8::Gemm g{HID, Wd + (size_t)layer * DM * DFF, NTOK, DM, DFF}; pg8::StaticOrder S; S.init(NTOK, DM, G, bx); S.rev = MK_DREV;
            pg8::EpiResB E{XBF, XB0, layer == 3 ? X : (float*)nullptr, layer == 3 ? (float*)nullptr : rss_next, Pscr};
            pg8::gemm_phase<pg8::EpiResB, pg8::StaticOrder, true, GEMM_SP2>(ldsl, g, S, E);
        }
        PH_END
    }
#undef PH_BEGIN
#undef PH_END
    for (int i = 0; i < MK_EXTRA_SYNC; ++i) cg::this_grid().sync();
    if (MK_PROBE && bx == 0 && threadIdx.x == 0) {
        unsigned long long sa = 0, sb = 0; const unsigned long long tot = TS[NPH_C] - TS[0];
        for (int i = 0; i < NPH_C; ++i) { const unsigned long long d = TS[i + 1] - TS[i]; if ((MK_MASK_A >> i) & 1u) sa += d; if ((MK_MASK_B >> i) & 1u) sb += d; }
        if (MK_PROBE2) { unsigned long long q[5] = {TS[40], TS[41], TS[42], TS[43], TS[1]}; sa = q[MK_PA + 1] - q[MK_PA]; sb = q[MK_PB + 1] - q[MK_PB]; sa *= 10; sb *= 10; }
        const unsigned long long pa = (sa * 100 + tot / 2) / tot, pb = (sb * 100 + tot / 2) / tot;
        const unsigned long long D = 2000ull * (pa * 100 + pb);
        while (__builtin_amdgcn_s_memrealtime() - TS[NPH_C] < D) __builtin_amdgcn_s_sleep(32);
    }
}
constexpr int NPHASES = NPH_C;

extern "C" void kernel_launch(void* const* d_in, const int* in_sizes, int n_in, void* d_out, int out_size, void* d_ws, size_t ws_size, hipStream_t stream) {
    static int grid = 0;
    if (grid == 0) {
        if (n_in != 12 || out_size != NTOK * DM || ws_size < WS_END) { fprintf(stderr, "kernel_launch: unexpected shapes: n_in %d out %d ws %zu (need %zu)\n", n_in, out_size, ws_size, (size_t)WS_END); grid = -1; return; }
        int dev = 0, cus = 0, per_cu = 0;
        hipGetDevice(&dev); hipDeviceGetAttribute(&cus, hipDeviceAttributeMultiprocessorCount, dev);
        if (hipFuncSetAttribute((const void*)mk_fwd, hipFuncAttributeMaxDynamicSharedMemorySize, LDS_BYTES) != hipSuccess) { fprintf(stderr, "kernel_launch: hipFuncSetAttribute failed\n"); grid = -1; return; }
        if (hipOccupancyMaxActiveBlocksPerMultiprocessor(&per_cu, (const void*)mk_fwd, NTHREADS, LDS_BYTES) != hipSuccess || per_cu < 1) { fprintf(stderr, "kernel_launch: occupancy query gave %d\n", per_cu); per_cu = 1; }
        (void)hipGetLastError();
        grid = cus * per_cu;
        fprintf(stderr, "kernel_launch: grid %d (cus %d x %d)\n", grid, cus, per_cu);
    }
    if (grid < 0) return;
    Args a{};
    for (int i = 0; i < 12; ++i) a.in[i] = (const float*)d_in[i];
    a.out = (float*)d_out; a.ws = (unsigned char*)d_ws;
#if MK_ONE_LAUNCH
    a.ph_lo = 0; a.ph_hi = NPHASES;
    void* kargs[] = {&a};
    hipError_t e = hipLaunchCooperativeKernel((const void*)mk_fwd, dim3(grid), dim3(NTHREADS), kargs, LDS_BYTES, stream);
    if (e != hipSuccess) fprintf(stderr, "kernel_launch: cooperative launch failed: %s (grid %d)\n", hipGetErrorString(e), grid);
#else
    for (int p = 0; p < NPHASES; ++p) { a.ph_lo = p; a.ph_hi = p + 1; hipLaunchKernelGGL(mk_fwd, dim3(grid), dim3(NTHREADS), LDS_BYTES, stream, a); }
    hipError_t e = hipPeekAtLastError();
    if (e != hipSuccess) fprintf(stderr, "kernel_launch: launch failed: %s\n", hipGetErrorString(e));
#endif
}
```

```cpp
#include <hip/hip_runtime.h>
#define ATT_SDEPTH 1
#define ATT_NEGM 1
#include <hip/hip_bf16.h>
#include <hip/hip_cooperative_groups.h>
#include <cstdio>
#include <cstdint>
namespace cg = cooperative_groups;

#ifndef EN_P0
#define EN_P0 1
#endif
#ifndef EN_FFT
#define EN_FFT 1
#endif
#ifndef EN_QKV
#define EN_QKV 1
#endif
#ifndef EN_MISC
#define EN_MISC 1
#endif
#ifndef EN_ATT
#define EN_ATT 1
#endif
#ifndef EN_RES
#define EN_RES 1
#endif
#ifndef EN_GU
#define EN_GU 1
#endif
#ifndef MK_PROBE
#define MK_PROBE 0
#endif
#ifndef MK_MASK_A
#define MK_MASK_A 0u
#endif
#ifndef MK_MASK_B
#define MK_MASK_B 0u
#endif
#ifndef MK_SLEEP_US
#define MK_SLEEP_US 0
#endif
#ifndef MK_EXTRA_SYNC
#define MK_EXTRA_SYNC 0
#endif
#ifndef MK_CG_ONLY
#define MK_CG_ONLY 0
#endif
#ifndef ATT_SDEPTH
#define ATT_SDEPTH 2
#endif
#ifndef ATT_SB
#define ATT_SB 0
#endif
#ifndef ATT_NEGM
#define ATT_NEGM 0
#endif
#ifndef GU_ALIGN
#define GU_ALIGN true
#endif
#ifndef GEMM_SP2
#define GEMM_SP2 true
#endif
#ifndef MK_PROBE2
#define MK_PROBE2 0
#endif
#ifndef MK_PA
#define MK_PA 0
#endif
#ifndef MK_PB
#define MK_PB 1
#endif
#ifndef MK_DREV
#define MK_DREV 1
#endif
#ifndef MK_ONE_LAUNCH
#define MK_ONE_LAUNCH 1
#endif

__device__ __forceinline__ int mk_tid() { int t = threadIdx.x; asm volatile("" : "+v"(t)); return t; }
namespace pg8 {
#define PG8_LAS __attribute__((address_space(3)))
typedef unsigned short bf16_t;
typedef short bf16x8 __attribute__((ext_vector_type(8)));
typedef float f32x4 __attribute__((ext_vector_type(4)));
typedef unsigned u32x4 __attribute__((ext_vector_type(4)));
constexpr int BM = 256, BK = 64, HALF = 128, HTB = HALF * BK * 2  , STAGE_BYTES = 8 * HTB, NXCD = 8, WGM = 8;

__host__ __device__ __forceinline__ int lds_byte(int r, int c) { const int st = (r >> 4) * 2 + (c >> 5), rr = r & 15, cc = c & 31, ob = rr * 64 + cc * 2; return st * 1024 + (ob ^ (((ob >> 9) & 1) << 5)); }
__host__ __device__ __forceinline__ void stage_rc(int b, int& R, int& C) { const int st = b / 1024, sb = b % 1024, swz = sb ^ (((sb >> 9) & 1) << 5); R = (st >> 1) * 16 + swz / 64; C = (st & 1) * 32 + (swz % 64) / 2; }
__host__ __device__ __forceinline__ int perm32(int rho) { const int n = rho >> 4, i = rho & 15; return 8 * (i >> 2) + 4 * n + (i & 3); }

struct Unit { int pm, pn; };
struct Gemm { const bf16_t* A; const bf16_t* Bt; int M, N, K; };

struct StaticOrder {
    int nM, nN, nwg, G, c, rev;
    __host__ __device__ void init(int M, int N, int G_, int c_) { nM = M / BM; nN = N / BM; nwg = nM * nN; G = G_; c = c_; rev = 0; }
    __host__ __device__ bool next(int i, Unit& u) const {
        const long L = (long)i * G + c; if (L >= nwg) return false;
        int wgid = (int)L; { const int q = nwg / NXCD, r = nwg % NXCD, xcd = wgid % NXCD, off = wgid / NXCD; wgid = (xcd < r ? xcd * (q + 1) : r * (q + 1) + (xcd - r) * q) + off; }
        const int nig = WGM * nN, gid = wgid / nig, fm = gid * WGM, gsz = (nM - fm) < WGM ? (nM - fm) : WGM;
        u.pm = fm + ((wgid % nig) % gsz); u.pn = (wgid % nig) / gsz; if (rev) u.pm = nM - 1 - u.pm; return true;
    }
    __device__ __forceinline__ void a_ready(const Unit&) const {}
    __device__ __forceinline__ void done(const Unit&) const {}
};

__device__ __forceinline__ unsigned cvt_pk_bf16(float lo, float hi) { unsigned r; asm volatile("v_cvt_pk_bf16_f32 %0, %1, %2" : "=v"(r) : "v"(lo), "v"(hi)); return r; }
typedef float f32x2 __attribute__((ext_vector_type(2)));
typedef float f32x2 __attribute__((ext_vector_type(2)));

__device__ __forceinline__ float bflo(unsigned w) { return __uint_as_float(w << 16); }
__device__ __forceinline__ float bfhi(unsigned w) { return __uint_as_float(w & 0xffff0000u); }
__device__ __forceinline__ float rstd_of(const float* rssp, size_t row) { const f32x4 p = *(const f32x4*)(rssp + row * 4); return __builtin_amdgcn_rsqf(((p[0] + p[1]) + (p[2] + p[3])) * (1.0f / 1024.0f) + 1e-6f); }
struct EpiResB {
    static constexpr bool PERM = true, AFTER_DRAIN = false;
    const bf16_t* xin; bf16_t* xout; float* fout; float* rssp; PG8_LAS float* P;
    __device__ __forceinline__ void operator()(const f32x4 (&acc)[2][2][4][2], const Unit& u, int wr, int wc, int fr, int fq) const {
        const int row0 = u.pm * BM + wr * 64 + fr, col0 = u.pn * BM + wc * 32 + 8 * fq;
#pragma unroll
        for (int ai = 0; ai < 2; ++ai) {
            u32x4 xo[4][2];
#pragma unroll
            for (int m = 0; m < 4; ++m)
#pragma unroll
                for (int bj = 0; bj < 2; ++bj) xo[m][bj] = *(const u32x4*)(xin + (size_t)(row0 + ai * HALF + m * 16) * 1024 + col0 + bj * HALF);
#pragma unroll
            for (int m = 0; m < 4; ++m) {
                const size_t roff = (size_t)(row0 + ai * HALF + m * 16) * 1024 + col0; float ss = 0.f;
#pragma unroll
                for (int bj = 0; bj < 2; ++bj) {
                    const u32x4 w = xo[m][bj]; const f32x4 a0 = acc[ai][bj][m][0], a1 = acc[ai][bj][m][1]; f32x4 v0, v1;
                    v0[0] = bflo(w.x) + a0[0]; v0[1] = bfhi(w.x) + a0[1]; v0[2] = bflo(w.y) + a0[2]; v0[3] = bfhi(w.y) + a0[3];
                    v1[0] = bflo(w.z) + a1[0]; v1[1] = bfhi(w.z) + a1[1]; v1[2] = bflo(w.w) + a1[2]; v1[3] = bfhi(w.w) + a1[3];
                    ss += (v0[0] * v0[0] + v0[1] * v0[1]) + (v0[2] * v0[2] + v0[3] * v0[3]) + (v1[0] * v1[0] + v1[1] * v1[1]) + (v1[2] * v1[2] + v1[3] * v1[3]);
                    if (fout) { *(f32x4*)(fout + roff + bj * HALF) = v0; *(f32x4*)(fout + roff + bj * HALF + 4) = v1; }
                    else { u32x4 o; o.x = cvt_pk_bf16(v0[0], v0[1]); o.y = cvt_pk_bf16(v0[2], v0[3]); o.z = cvt_pk_bf16(v1[0], v1[1]); o.w = cvt_pk_bf16(v1[2], v1[3]); *(u32x4*)(xout + roff + bj * HALF) = o; }
                }
                if (rssp) { ss += __shfl_xor(ss, 16); ss += __shfl_xor(ss, 32); if (fq == 0) P[(ai * HALF + wr * 64 + m * 16 + fr) * 4 + wc] = ss; }
            }
        }
        if (rssp) {
            asm volatile("s_waitcnt lgkmcnt(0)" ::: "memory"); __builtin_amdgcn_s_barrier(); asm volatile("" ::: "memory");
            const int t = (wr * 4 + wc) * 64 + fq * 16 + fr;
            if (t < 256) { const f32x4 p = *((const PG8_LAS f32x4*)P + t); rssp[(size_t)(u.pm * BM + t) * 4 + u.pn] = (p[0] + p[1]) + (p[2] + p[3]); }
        }
    }
};
__device__ __forceinline__ float silu_mul(float g, float u) { return g * u * __builtin_amdgcn_rcpf(1.0f + __builtin_amdgcn_exp2f(-1.4426950408889634f * g)); }
struct EpiSwiGLU {
    static constexpr bool PERM = true, AFTER_DRAIN = false;
    bf16_t* H; int ldh; const float* rssp;
    __device__ __forceinline__ void operator()(const f32x4 (&acc)[2][2][4][2], const Unit& u, int wr, int wc, int fr, int fq) const {
        const int row0 = u.pm * BM + wr * 64 + fr, col0 = u.pn * HALF + wc * 32 + 8 * fq;
        f32x4 pp[2][4];
#pragma unroll
        for (int ai = 0; ai < 2; ++ai)
#pragma unroll
            for (int m = 0; m < 4; ++m) pp[ai][m] = *(const f32x4*)(rssp + (size_t)(row0 + ai * HALF + m * 16) * 4);
#pragma unroll
        for (int ai = 0; ai < 2; ++ai)
#pragma unroll
            for (int m = 0; m < 4; ++m) { const int row = row0 + ai * HALF + m * 16; bf16_t* rowp = H + (size_t)row * ldh + col0; const f32x4 p = pp[ai][m]; const float rs = __builtin_amdgcn_rsqf(((p[0] + p[1]) + (p[2] + p[3])) * (1.0f / 1024.0f) + 1e-6f);
                const f32x4 g0 = acc[ai][0][m][0] * rs, g1 = acc[ai][0][m][1] * rs, u0 = acc[ai][1][m][0] * rs, u1 = acc[ai][1][m][1] * rs;
                u32x4 w;
                w.x = cvt_pk_bf16(silu_mul(g0[0], u0[0]), silu_mul(g0[1], u0[1])); w.y = cvt_pk_bf16(silu_mul(g0[2], u0[2]), silu_mul(g0[3], u0[3]));
                w.z = cvt_pk_bf16(silu_mul(g1[0], u1[0]), silu_mul(g1[1], u1[1])); w.w = cvt_pk_bf16(silu_mul(g1[2], u1[2]), silu_mul(g1[3], u1[3]));
                *(u32x4*)rowp = w; }
    }
};
struct EpiQKV {
    static constexpr bool PERM = true, AFTER_DRAIN = false;
    bf16_t *Q, *K, *V; const float* rssp;
    const float* qkg;
    const float* rope;
    PG8_LAS float* P2;
    float qscale;
    __device__ __forceinline__ void operator()(const f32x4 (&acc)[2][2][4][2], const Unit& u, int wr, int wc, int fr, int fq) const {
        const int row0 = u.pm * BM + wr * 64 + fr;
        bf16_t* base = u.pn < 4 ? Q + u.pn * BM : (u.pn == 4 ? K : V); const int ldc = u.pn < 4 ? 1024 : 256;
        const int col0 = wc * 32 + 8 * fq;
        f32x4 pp[2][4]; float rs[2][4];
#pragma unroll
        for (int ai = 0; ai < 2; ++ai)
#pragma unroll
            for (int m = 0; m < 4; ++m) pp[ai][m] = *(const f32x4*)(rssp + (size_t)(row0 + ai * HALF + m * 16) * 4);
#pragma unroll
        for (int ai = 0; ai < 2; ++ai)
#pragma unroll
            for (int m = 0; m < 4; ++m) { const f32x4 p = pp[ai][m]; rs[ai][m] = __builtin_amdgcn_rsqf(((p[0] + p[1]) + (p[2] + p[3])) * (1.0f / 1024.0f) + 1e-6f); }
        if (u.pn == 5) {
#pragma unroll
            for (int ai = 0; ai < 2; ++ai)
#pragma unroll
                for (int m = 0; m < 4; ++m) { bf16_t* rowp = base + (size_t)(row0 + ai * HALF + m * 16) * ldc + col0;
#pragma unroll
                    for (int bj = 0; bj < 2; ++bj) { const f32x4 v0 = acc[ai][bj][m][0] * rs[ai][m], v1 = acc[ai][bj][m][1] * rs[ai][m]; u32x4 w;
                        w.x = cvt_pk_bf16(v0[0], v0[1]); w.y = cvt_pk_bf16(v0[2], v0[3]); w.z = cvt_pk_bf16(v1[0], v1[1]); w.w = cvt_pk_bf16(v1[2], v1[3]);
                        *(u32x4*)(rowp + bj * HALF) = w; } }
            return;
        }
#pragma unroll
        for (int ai = 0; ai < 2; ++ai)
#pragma unroll
            for (int m = 0; m < 4; ++m)
#pragma unroll
                for (int bj = 0; bj < 2; ++bj) { const f32x4 v0 = acc[ai][bj][m][0] * rs[ai][m], v1 = acc[ai][bj][m][1] * rs[ai][m];
                    float ss = (v0[0] * v0[0] + v0[1] * v0[1]) + (v0[2] * v0[2] + v0[3] * v0[3]) + (v1[0] * v1[0] + v1[1] * v1[1]) + (v1[2] * v1[2] + v1[3] * v1[3]);
                    ss += __shfl_xor(ss, 16); ss += __shfl_xor(ss, 32);
                    if (fq == 0) P2[((ai * HALF + wr * 64 + m * 16 + fr) * 2 + bj) * 4 + wc] = ss; }
        asm volatile("s_waitcnt lgkmcnt(0)" ::: "memory"); __builtin_amdgcn_s_barrier(); asm volatile("" ::: "memory");
        const float* gp = qkg + (u.pn == 4 ? 128 : 0) + col0; const float hs = u.pn == 4 ? 1.0f : qscale;
        const f32x4 g0 = *(const f32x4*)gp * hs, g1 = *(const f32x4*)(gp + 4) * hs;
        const int ib = 16 * (wc & 1) + 4 * fq;
#pragma unroll
        for (int ai = 0; ai < 2; ++ai)
#pragma unroll
            for (int m = 0; m < 4; ++m) { const int row = row0 + ai * HALF + m * 16; bf16_t* rowp = base + (size_t)row * ldc + col0;
                const int t = row < 16384 ? (row & 8191) : ((row - 16384) & 4095); const int pos = wc < 2 ? (t >> 6) : (t & 63);
                const f32x4 cs0 = *(const f32x4*)(rope + (size_t)(pos * 32 + ib) * 2), cs1 = *(const f32x4*)(rope + (size_t)(pos * 32 + ib + 2) * 2);
#pragma unroll
                for (int bj = 0; bj < 2; ++bj) { const f32x4 pr = *((const PG8_LAS f32x4*)P2 + ((ai * HALF + wr * 64 + m * 16 + fr) * 2 + bj));
                    const float rk = rs[ai][m] * __builtin_amdgcn_rsqf(((pr[0] + pr[1]) + (pr[2] + pr[3])) * (1.0f / 128.0f) + 1e-6f);
                    const f32x4 y0 = acc[ai][bj][m][0] * rk * g0, y1 = acc[ai][bj][m][1] * rk * g1; u32x4 w;
                    w.x = cvt_pk_bf16(y0[0] * cs0[0] - y0[1] * cs0[1], y0[0] * cs0[1] + y0[1] * cs0[0]); w.y = cvt_pk_bf16(y0[2] * cs0[2] - y0[3] * cs0[3], y0[2] * cs0[3] + y0[3] * cs0[2]);
                    w.z = cvt_pk_bf16(y1[0] * cs1[0] - y1[1] * cs1[1], y1[0] * cs1[1] + y1[1] * cs1[0]); w.w = cvt_pk_bf16(y1[2] * cs1[2] - y1[3] * cs1[3], y1[2] * cs1[3] + y1[3] * cs1[2]);
                    *(u32x4*)(rowp + bj * HALF) = w; } }
    }
};
template <class Epi, class Sched, bool ALIGN_EPI = false, bool SP2 = false>
__device__ __forceinline__ void gemm_phase(PG8_LAS unsigned char* lds, const Gemm g, const Sched& S, const Epi& E) {
    const int tid = mk_tid(), wid = __builtin_amdgcn_readfirstlane(tid >> 6), lane = tid & 63, wr = wid >> 2, wc = wid & 3, fr = lane & 15, fq = lane >> 4;
    const int K = g.K, nt = K / BK;
    unsigned voffA[2], voffB[2];
#pragma unroll
    for (int i = 0; i < 2; ++i) { int R, C; stage_rc(tid * 16 + i * 8192, R, C); const int Rb = Epi::PERM ? ((R & ~31) + perm32(R & 31)) : R;
        voffA[i] = (unsigned)(R * K + C) * 2u; voffB[i] = (unsigned)(Rb * K + C) * 2u; }
    const size_t kstep = (size_t)(BK * 2);
    const size_t hstep = (size_t)HALF * K * 2;
    const size_t tstep = 2 * hstep;
    const unsigned ldsw = (unsigned)wid * 1024u;
    const int aoff = lds_byte(wr * 64 + fr, fq * 8), boff = lds_byte(wc * 32 + fr, fq * 8);
#define PG8_SA(b, h) (((b) * 2 + (h)) * HTB)
#define PG8_SB(b, h) ((4 + (b) * 2 + (h)) * HTB)
#define PG8_STAGE(bufoff, gbase, voff) do { _Pragma("unroll") for (int _i = 0; _i < 2; ++_i) \
        __builtin_amdgcn_global_load_lds((const unsigned*)((const char*)(gbase) + (voff)[_i]), (PG8_LAS unsigned*)(lds + (bufoff) + ldsw + _i * 8192), 16, 0, 0); } while (0)
#define PG8_LDA(dst, b, h) do { _Pragma("unroll") for (int m = 0; m < 4; ++m) _Pragma("unroll") for (int k = 0; k < 2; ++k) dst[m][k] = *(const PG8_LAS bf16x8*)(lds + PG8_SA(b, h) + aoff + m * 2048 + k * 1024); } while (0)
#define PG8_LDB(dst, b, h) do { _Pragma("unroll") for (int n = 0; n < 2; ++n) _Pragma("unroll") for (int k = 0; k < 2; ++k) dst[n][k] = *(const PG8_LAS bf16x8*)(lds + PG8_SB(b, h) + boff + n * 2048 + k * 1024); } while (0)
#define PG8_MMA(ai, bj, At, Bt) do { __builtin_amdgcn_s_setprio(1); _Pragma("unroll") for (int m = 0; m < 4; ++m) _Pragma("unroll") for (int n = 0; n < 2; ++n) _Pragma("unroll") for (int k = 0; k < 2; ++k) \
        acc[ai][bj][m][n] = __builtin_amdgcn_mfma_f32_16x16x32_bf16(Bt[n][k], At[m][k], acc[ai][bj][m][n], 0, 0, 0); __builtin_amdgcn_s_setprio(0); } while (0)
#define PG8_WAIT_V(n) asm volatile("s_waitcnt vmcnt(" #n ")" ::: "memory")
#define PG8_WAIT_L(n) asm volatile("s_waitcnt lgkmcnt(" #n ")" ::: "memory")
#define PG8_BAR __builtin_amdgcn_s_barrier()
#define PG8_SCHED __builtin_amdgcn_sched_barrier(0)
    Unit cur, nxt; int ui = 0;
    if (!S.next(0, cur)) return;
    f32x4 acc[2][2][4][2];
#pragma unroll
    for (int a = 0; a < 2; ++a)
#pragma unroll
        for (int b = 0; b < 2; ++b)
#pragma unroll
            for (int m = 0; m < 4; ++m)
#pragma unroll
                for (int n = 0; n < 2; ++n) acc[a][b][m][n] = (f32x4){0.f, 0.f, 0.f, 0.f};
    bf16x8 At[4][2], B0[2][2], B1[2][2];
    const char* cA = (const char*)g.A + (size_t)cur.pm * tstep; const char* cB = (const char*)g.Bt + (size_t)cur.pn * tstep;
    S.a_ready(cur);
    if constexpr (SP2) {
        PG8_STAGE(PG8_SB(0, 0), cB, voffB); PG8_STAGE(PG8_SB(0, 1), cB + hstep, voffB); PG8_STAGE(PG8_SA(0, 0), cA, voffA); PG8_STAGE(PG8_SA(0, 1), cA + hstep, voffA);
        if (wr == 1) PG8_BAR;
        PG8_WAIT_V(2); PG8_BAR;
        PG8_STAGE(PG8_SB(1, 0), cB + kstep, voffB); PG8_STAGE(PG8_SA(1, 0), cA + kstep, voffA); PG8_STAGE(PG8_SB(1, 1), cB + hstep + kstep, voffB);
        PG8_WAIT_V(6); PG8_BAR;
    } else {
        PG8_STAGE(PG8_SB(0, 0), cB, voffB); PG8_STAGE(PG8_SA(0, 0), cA, voffA); PG8_STAGE(PG8_SB(0, 1), cB + hstep, voffB); PG8_STAGE(PG8_SA(0, 1), cA + hstep, voffA);
        if (wr == 1) PG8_BAR;
        PG8_WAIT_V(4); PG8_BAR;
        PG8_STAGE(PG8_SB(1, 0), cB + kstep, voffB); PG8_STAGE(PG8_SA(1, 0), cA + kstep, voffA); PG8_STAGE(PG8_SB(1, 1), cB + hstep + kstep, voffB);
        PG8_WAIT_V(6); PG8_BAR;
    }
    for (;;) {
        const bool has_next = S.next(ui + 1, nxt);
        const char* nA = has_next ? (const char*)g.A + (size_t)nxt.pm * tstep : cA; const char* nB = has_next ? (const char*)g.Bt + (size_t)nxt.pn * tstep : cB;
        for (int t = 0; t < nt; t += 2) {
            const bool last = (t == nt - 2);
            const char* a1 = cA + (size_t)(t + 1) * kstep;
            const char* a2 = last ? nA : cA + (size_t)(t + 2) * kstep; const char* b2 = last ? nB : cB + (size_t)(t + 2) * kstep;
            const char* a3 = a2 + kstep; const char* b3 = b2 + kstep;
            if (last && has_next) S.a_ready(nxt);
            if constexpr (SP2) {
            PG8_LDB(B0, 0, 0); PG8_LDB(B1, 0, 1); PG8_SCHED; PG8_LDA(At, 0, 0); PG8_STAGE(PG8_SA(1, 1), a1 + hstep, voffA);
            PG8_WAIT_V(8); PG8_WAIT_L(0); PG8_BAR; PG8_MMA(0, 0, At, B0); PG8_MMA(0, 1, At, B1); PG8_BAR; PG8_SCHED;
            PG8_LDA(At, 0, 1); PG8_STAGE(PG8_SB(0, 0), b2, voffB); PG8_STAGE(PG8_SB(0, 1), b2 + hstep, voffB); PG8_STAGE(PG8_SA(0, 0), a2, voffA);
            PG8_WAIT_V(8); PG8_WAIT_L(0); PG8_BAR; PG8_MMA(1, 0, At, B0); PG8_MMA(1, 1, At, B1); PG8_BAR; PG8_SCHED;
            PG8_LDB(B0, 1, 0); PG8_LDB(B1, 1, 1); PG8_SCHED; PG8_LDA(At, 1, 0); PG8_STAGE(PG8_SA(0, 1), a2 + hstep, voffA);
            PG8_WAIT_V(8); PG8_WAIT_L(0); PG8_BAR; PG8_MMA(0, 0, At, B0); PG8_MMA(0, 1, At, B1); PG8_BAR; PG8_SCHED;
            PG8_LDA(At, 1, 1); PG8_STAGE(PG8_SB(1, 0), b3, voffB); PG8_STAGE(PG8_SB(1, 1), b3 + hstep, voffB); PG8_STAGE(PG8_SA(1, 0), a3, voffA);
            PG8_WAIT_V(8); PG8_WAIT_L(0); PG8_BAR; PG8_MMA(1, 0, At, B0); PG8_MMA(1, 1, At, B1); PG8_BAR; PG8_SCHED;
            } else {
            PG8_LDB(B0, 0, 0); PG8_SCHED; PG8_LDA(At, 0, 0); PG8_STAGE(PG8_SA(1, 1), a1 + hstep, voffA);
            PG8_WAIT_L(8); PG8_BAR; PG8_WAIT_L(0); PG8_MMA(0, 0, At, B0); PG8_BAR; PG8_SCHED;
            PG8_LDB(B1, 0, 1); PG8_STAGE(PG8_SB(0, 0), b2, voffB);
            PG8_BAR; PG8_WAIT_L(0); PG8_MMA(0, 1, At, B1); PG8_BAR;
            PG8_LDA(At, 0, 1); PG8_STAGE(PG8_SA(0, 0), a2, voffA);
            PG8_BAR; PG8_WAIT_L(0); PG8_MMA(1, 0, At, B0); PG8_BAR; PG8_SCHED;
            PG8_STAGE(PG8_SB(0, 1), b2 + hstep, voffB);
            PG8_WAIT_V(6); PG8_BAR; PG8_MMA(1, 1, At, B1); PG8_BAR;
            PG8_LDB(B0, 1, 0); PG8_SCHED; PG8_LDA(At, 1, 0); PG8_STAGE(PG8_SA(0, 1), a2 + hstep, voffA);
            PG8_WAIT_L(8); PG8_BAR; PG8_WAIT_L(0); PG8_MMA(0, 0, At, B0); PG8_BAR; PG8_SCHED;
            PG8_LDB(B1, 1, 1); PG8_STAGE(PG8_SB(1, 0), b3, voffB);
            PG8_BAR; PG8_WAIT_L(0); PG8_MMA(0, 1, At, B1); PG8_BAR;
            PG8_LDA(At, 1, 1); PG8_STAGE(PG8_SA(1, 0), a3, voffA);
            PG8_BAR; PG8_WAIT_L(0); PG8_MMA(1, 0, At, B0); PG8_BAR; PG8_SCHED;
            PG8_STAGE(PG8_SB(1, 1), b3 + hstep, voffB);
            PG8_WAIT_V(6); PG8_BAR; PG8_MMA(1, 1, At, B1); PG8_BAR;
            }
        }
        if constexpr (ALIGN_EPI) { if (wr == 0) PG8_BAR; }
        if constexpr (!Epi::AFTER_DRAIN) { E(acc, cur, wr, wc, fr, fq); S.done(cur); }
        if (!has_next) break;
#pragma unroll
        for (int a = 0; a < 2; ++a)
#pragma unroll
            for (int b = 0; b < 2; ++b)
#pragma unroll
                for (int m = 0; m < 4; ++m)
#pragma unroll
                    for (int n = 0; n < 2; ++n) acc[a][b][m][n] = (f32x4){0.f, 0.f, 0.f, 0.f};
        cur = nxt; cA = nA; cB = nB; ++ui;
        if constexpr (ALIGN_EPI) { if (wr == 1) PG8_BAR; }
    }
    PG8_WAIT_V(0);
    if constexpr (!ALIGN_EPI) { if (wr == 0) PG8_BAR; }
    PG8_BAR;
    if constexpr (Epi::AFTER_DRAIN) { E.fused(acc, cur, wr, wc, fr, fq, lds, wid, lane); S.done(cur); }
#undef PG8_SA
#undef PG8_SB
#undef PG8_STAGE
#undef PG8_LDA
#undef PG8_LDB
#undef PG8_MMA
#undef PG8_WAIT_V
#undef PG8_WAIT_L
#undef PG8_BAR
#undef PG8_SCHED
}
}

namespace att {
using bf16 = __hip_bfloat16;
constexpr int   D = 128, NW = 8, QBLK = 32, KVBLK = 64;
constexpr float SCALE = 0.088388347648318440f;
constexpr float THR = 8.f;
constexpr int SDEPTH = ATT_SDEPTH;
constexpr int LDQ = 1024, LDK = 256, LDO = 1024;
constexpr size_t SHM_V = KVBLK * D * 2, SHM_K = KVBLK * D * 2, SHM_ATTN = 2 * SHM_V + 2 * SHM_K + NW * 64 * 4;
constexpr size_t OST_OFF = 69632;
using bf16x8 = __attribute__((ext_vector_type(8))) short;
using s16x4  = __attribute__((ext_vector_type(4))) short;
using f32x16 = __attribute__((ext_vector_type(16))) float;
using f32x8  = __attribute__((ext_vector_type(8))) float;
using u32x4  = __attribute__((ext_vector_type(4))) unsigned;
#define KSWZ(row, colB) ((row) * 256 + ((colB) ^ (((row) & 7) << 4)))
#define SBAR() __builtin_amdgcn_sched_barrier(0)
__device__ __forceinline__ int crow(int r, int hi) { return (r & 3) + 8 * (r >> 2) + 4 * hi; }
__device__ __forceinline__ unsigned cvtpk(float lo, float hi) {
  unsigned r; asm volatile("v_cvt_pk_bf16_f32 %0, %1, %2" : "=v"(r) : "v"(lo), "v"(hi)); return r;
}
template <typename TIn> struct Stage;
template <> struct Stage<bf16>  { using T = bf16x8;
  __device__ static __forceinline__ T ld8(const bf16* p) { return *reinterpret_cast<const bf16x8*>(p); }
  __device__ static __forceinline__ bf16x8 tobf(T x) { return x; } };
template <> struct Stage<float> { using T = f32x8;
  __device__ static __forceinline__ T ld8(const float* p) { return *reinterpret_cast<const f32x8*>(p); }
  __device__ static __forceinline__ bf16x8 tobf(T x) {
    u32x4 w = {cvtpk(x[0], x[1]), cvtpk(x[2], x[3]), cvtpk(x[4], x[5]), cvtpk(x[6], x[7])}; return *reinterpret_cast<bf16x8*>(&w); } };

__device__ __forceinline__ void partialSM(f32x16& p0, f32x16& p1, float& m_reg, float& mn, float& alpha) {
  constexpr float C = SCALE * 1.4426950408889634f;
  float pmax = p0[0]; for (int r = 1; r < 16; ++r) pmax = fmaxf(pmax, p0[r]); for (int r = 0; r < 16; ++r) pmax = fmaxf(pmax, p1[r]);
  { auto rr = __builtin_amdgcn_permlane32_swap(__float_as_uint(pmax), __float_as_uint(pmax), false, false);
    pmax = fmaxf(__uint_as_float(rr[0]), __uint_as_float(rr[1])); }
  if (__builtin_expect(__all(pmax - m_reg <= THR / SCALE), 1)) { mn = m_reg; alpha = 1.f; }
  else { mn = fmaxf(m_reg, pmax); alpha = __builtin_amdgcn_exp2f((m_reg - mn) * C); m_reg = mn; }
  float mnC = -mn * C;
  for (int r = 0; r < 16; ++r) p0[r] = fmaf(p0[r], C, mnC); for (int r = 0; r < 16; ++r) p1[r] = fmaf(p1[r], C, mnC);
  for (int r = 0; r < 16; ++r) p0[r] = __builtin_amdgcn_exp2f(p0[r]);
}
__device__ __forceinline__ void finishSM(f32x16& p0, f32x16& p1, float alpha, float& l_reg, bf16x8& pa0, bf16x8& pa1, bf16x8& pa2, bf16x8& pa3) {
  for (int r = 0; r < 16; ++r) p1[r] = __builtin_amdgcn_exp2f(p1[r]);
  float ps = 0; for (int r = 0; r < 16; ++r) ps += p0[r]; for (int r = 0; r < 16; ++r) ps += p1[r];
  { auto rr = __builtin_amdgcn_permlane32_swap(__float_as_uint(ps), __float_as_uint(ps), false, false);
    ps = __uint_as_float(rr[0]) + __uint_as_float(rr[1]); }
  l_reg = l_reg * alpha + ps;
#define PK4(P, BASE, OUT) do { unsigned a0 = cvtpk(P[BASE + 0], P[BASE + 1]), a1 = cvtpk(P[BASE + 2], P[BASE + 3]);   \
    unsigned b0 = cvtpk(P[BASE + 4], P[BASE + 5]), b1 = cvtpk(P[BASE + 6], P[BASE + 7]);                              \
    auto r0 = __builtin_amdgcn_permlane32_swap(a0, b0, false, false); auto r1 = __builtin_amdgcn_permlane32_swap(a1, b1, false, false); \
    u32x4 w = {r0[0], r1[0], r0[1], r1[1]}; OUT = *reinterpret_cast<bf16x8*>(&w); } while (0)
  PK4(p0, 0, pa0); PK4(p0, 8, pa1); PK4(p1, 0, pa2); PK4(p1, 8, pa3);
#undef PK4
}
__device__ __forceinline__ void qkt(f32x16& p0, f32x16& p1, const bf16* Ks, const bf16x8* qr, int r32, int hi) {
  p0 = f32x16{}; p1 = f32x16{};
  for (int d0 = 0; d0 < 8; ++d0) { int cb = (d0 * 16 + hi * 8) * 2;
    bf16x8 b0 = *reinterpret_cast<const bf16x8*>((const char*)Ks + KSWZ(r32, cb));
    bf16x8 b1 = *reinterpret_cast<const bf16x8*>((const char*)Ks + KSWZ(32 + r32, cb));
    p0 = __builtin_amdgcn_mfma_f32_32x32x16_bf16(b0, qr[d0], p0, 0, 0, 0);
    p1 = __builtin_amdgcn_mfma_f32_32x32x16_bf16(b1, qr[d0], p1, 0, 0, 0); }
}
__device__ __forceinline__ int v_st(int k, int c) { const int kk = (k & ~0xC) | ((k & 4) << 1) | ((k & 8) >> 1); return ((kk >> 3) * 4 + (c >> 5)) * 512 + ((kk & 7) * 32 + (c & 31)) * 2; }
__device__ __forceinline__ int v_rd_base(int lane) { return ((lane & 3) << 3) | (((lane >> 2) & 3) << 6) | (((lane >> 4) & 1) << 5) | (((lane >> 5) & 1) << 8); }
constexpr int v_rd_off(int d0, int ks, int half) { return d0 * 512 + ks * 4096 + half * 2048; }
template <int OFF> __device__ __forceinline__ s16x4 tr_read(int vb) {
  s16x4 r; asm volatile("ds_read_b64_tr_b16 %0, %1 offset:%2" : "=&v"(r) : "v"(vb), "i"(OFF) : "memory"); return r;
}
template <int D0> __device__ __forceinline__ void pv_one(f32x16& od, int vb, bf16x8 pa0, bf16x8 pa1, bf16x8 pa2, bf16x8 pa3) {
  const s16x4 l0 = tr_read<v_rd_off(D0, 0, 0)>(vb), h0 = tr_read<v_rd_off(D0, 0, 1)>(vb), l1 = tr_read<v_rd_off(D0, 1, 0)>(vb), h1 = tr_read<v_rd_off(D0, 1, 1)>(vb);
  const s16x4 l2 = tr_read<v_rd_off(D0, 2, 0)>(vb), h2 = tr_read<v_rd_off(D0, 2, 1)>(vb), l3 = tr_read<v_rd_off(D0, 3, 0)>(vb), h3 = tr_read<v_rd_off(D0, 3, 1)>(vb);
  asm volatile("s_waitcnt lgkmcnt(0)" ::: "memory"); SBAR();
#define PK(L, H) (bf16x8){L[0], L[1], L[2], L[3], H[0], H[1], H[2], H[3]}
  od = __builtin_amdgcn_mfma_f32_32x32x16_bf16(pa0, PK(l0, h0), od, 0, 0, 0);
  od = __builtin_amdgcn_mfma_f32_32x32x16_bf16(pa1, PK(l1, h1), od, 0, 0, 0);
  od = __builtin_amdgcn_mfma_f32_32x32x16_bf16(pa2, PK(l2, h2), od, 0, 0, 0);
  od = __builtin_amdgcn_mfma_f32_32x32x16_bf16(pa3, PK(l3, h3), od, 0, 0, 0);
#undef PK
}
__device__ __forceinline__ void pv_d0(f32x16* o, int vb, bf16x8 pa0, bf16x8 pa1, bf16x8 pa2, bf16x8 pa3) {
  pv_one<0>(o[0], vb, pa0, pa1, pa2, pa3); pv_one<1>(o[1], vb, pa0, pa1, pa2, pa3); pv_one<2>(o[2], vb, pa0, pa1, pa2, pa3); pv_one<3>(o[3], vb, pa0, pa1, pa2, pa3);
}

__device__ __forceinline__ float bf2f(short s) { return __uint_as_float(((unsigned)(unsigned short)s) << 16); }

__device__ __forceinline__ void qkt2(f32x16& p0, f32x16& p1, const bf16* Ks, const bf16x8* qr, const f32x16& negm, int r32, int hi) {
  p0 = negm; p1 = negm;
#pragma unroll
  for (int d0 = 0; d0 < 8; ++d0) { int cb = (d0 * 16 + hi * 8) * 2;
    bf16x8 b0 = *reinterpret_cast<const bf16x8*>((const char*)Ks + KSWZ(r32, cb));
    bf16x8 b1 = *reinterpret_cast<const bf16x8*>((const char*)Ks + KSWZ(32 + r32, cb));
    p0 = __builtin_amdgcn_mfma_f32_32x32x16_bf16(b0, qr[d0], p0, 0, 0, 0); p1 = __builtin_amdgcn_mfma_f32_32x32x16_bf16(b1, qr[d0], p1, 0, 0, 0); }
}
__device__ __forceinline__ void expA(f32x16& p0, float negmc) {
#pragma unroll
  for (int r = 0; r < 16; ++r) p0[r] = __builtin_amdgcn_exp2f(ATT_NEGM ? p0[r] : p0[r] + negmc);
}
__device__ __forceinline__ void finishSM2(f32x16& p0, f32x16& p1, float negmc, float& l_reg, bf16x8& pa0, bf16x8& pa1, bf16x8& pa2, bf16x8& pa3) {
#pragma unroll
  for (int r = 0; r < 16; ++r) p1[r] = __builtin_amdgcn_exp2f(ATT_NEGM ? p1[r] : p1[r] + negmc);
  float ps = 0;
#pragma unroll
  for (int r = 0; r < 16; ++r) ps += p0[r];
#pragma unroll
  for (int r = 0; r < 16; ++r) ps += p1[r];
  l_reg += ps;
#define PK4(P, BASE, OUT) do { unsigned a0 = cvtpk(P[BASE + 0], P[BASE + 1]), a1 = cvtpk(P[BASE + 2], P[BASE + 3]);   \
    unsigned b0 = cvtpk(P[BASE + 4], P[BASE + 5]), b1 = cvtpk(P[BASE + 6], P[BASE + 7]);                              \
    auto r0 = __builtin_amdgcn_permlane32_swap(a0, b0, false, false); auto r1 = __builtin_amdgcn_permlane32_swap(a1, b1, false, false); \
    u32x4 w = {r0[0], r1[0], r0[1], r1[1]}; OUT = *reinterpret_cast<bf16x8*>(&w); } while (0)
  PK4(p0, 0, pa0); PK4(p0, 8, pa1); PK4(p1, 0, pa2); PK4(p1, 8, pa3);
#undef PK4
}

__device__ __forceinline__ void attn_unit(const bf16* Qb, const bf16* __restrict__ Kh, const bf16* __restrict__ Vh,
                                          bf16* Ob, int seq, int t0, const float* __restrict__ qgain, const float2* __restrict__ rope, float negmc, char* lds) {
  using St = Stage<bf16>;
  const int tid = mk_tid(), wid = tid >> 6, lane = tid & 63, r32 = lane & 31, hi = lane >> 5;
  bf16* V_lds = (bf16*)lds; bf16* K_lds = (bf16*)(lds + 2 * SHM_V);
  float* ws = (float*)(lds + 2 * SHM_V + 2 * SHM_K) + wid * 64; float* li_l = ws;
  float l_reg = 0; f32x16 o[4] = {}; bf16x8 qr[8]; f32x16 negm; for (int r = 0; r < 16; ++r) negm[r] = ATT_NEGM ? negmc : 0.f; if (ATT_NEGM) asm volatile("" : "+v"(negm));
  const bf16* Qw = Qb + (long)(wid * QBLK + r32) * LDQ + hi * 8;
#pragma unroll
  for (int d0 = 0; d0 < 8; ++d0) qr[d0] = St::ld8(Qw + d0 * 16);
  (void)t0; (void)qgain; (void)rope;
  const int sr = tid >> 4, sc = (tid & 15) * 8, vst0 = v_st(sr, sc), vst1 = v_st(32 + sr, sc);
  const int vb0 = (int)(uintptr_t)V_lds + v_rd_base(lane);
  struct { typename St::T vs0, vs1, ks0, ks1; } sr_[SDEPTH];
#define SLOAD(i, k0) do { sr_[i].vs0 = St::ld8(&Vh[(long)((k0) + sr) * LDK + sc]); sr_[i].vs1 = St::ld8(&Vh[(long)((k0) + 32 + sr) * LDK + sc]); \
    sr_[i].ks0 = St::ld8(&Kh[(long)((k0) + sr) * LDK + sc]); sr_[i].ks1 = St::ld8(&Kh[(long)((k0) + 32 + sr) * LDK + sc]); } while (0)
#define SWRITE(b, i) do { *(bf16x8*)((char*)V_lds + (b) * SHM_V + vst0) = St::tobf(sr_[i].vs0);          \
    *(bf16x8*)((char*)V_lds + (b) * SHM_V + vst1) = St::tobf(sr_[i].vs1); int kc = sc * 2;               \
    *(bf16x8*)((char*)K_lds + (b) * SHM_K + KSWZ(sr, kc)) = St::tobf(sr_[i].ks0);                       \
    *(bf16x8*)((char*)K_lds + (b) * SHM_K + KSWZ(32 + sr, kc)) = St::tobf(sr_[i].ks1); } while (0)
#define SWAIT() do { if constexpr (SDEPTH == 2) asm volatile("s_waitcnt vmcnt(4)" ::: "memory"); else asm volatile("s_waitcnt vmcnt(0)" ::: "memory"); } while (0)
  f32x16 pA0, pA1, pB0, pB1; bf16x8 pa0, pa1, pa2, pa3; const int NT = seq / KVBLK;
  constexpr int SE = 0, SO = SDEPTH - 1;
  SLOAD(SE, 0); asm volatile("s_waitcnt vmcnt(0)" ::: "memory"); SWRITE(0, SE); __syncthreads();
  qkt2(pA0, pA1, K_lds, qr, negm, r32, hi); expA(pA0, negmc);
  SLOAD(SO, KVBLK); if constexpr (SDEPTH == 2) { if (2 < NT) SLOAD(SE, 2 * KVBLK); }
  SWAIT(); SWRITE(1, SO); __syncthreads();
  for (int j = 1; j + 1 < NT; j += 2) {
    SBAR(); qkt2(pB0, pB1, (bf16*)((char*)K_lds + SHM_K), qr, negm, r32, hi); if (ATT_SB) SBAR();
    finishSM2(pA0, pA1, negmc, l_reg, pa0, pa1, pa2, pa3); SBAR();
    SLOAD(SO, (j + SDEPTH) * KVBLK); SBAR();
    pv_d0(o, vb0, pa0, pa1, pa2, pa3); SBAR(); expA(pB0, negmc); SBAR();
    __syncthreads(); SWAIT(); SWRITE(0, SE);
    __syncthreads();
    SBAR(); qkt2(pA0, pA1, K_lds, qr, negm, r32, hi); if (ATT_SB) SBAR();
    finishSM2(pB0, pB1, negmc, l_reg, pa0, pa1, pa2, pa3); SBAR();
    if (SDEPTH == 1 || j + 3 < NT) SLOAD(SE, (j + 1 + SDEPTH) * KVBLK); SBAR();
    pv_d0(o, vb0 + (int)SHM_V, pa0, pa1, pa2, pa3); SBAR(); expA(pA0, negmc); SBAR();
    __syncthreads(); SWAIT(); SWRITE(1, SO);
    __syncthreads();
  }
  SBAR(); qkt2(pB0, pB1, (bf16*)((char*)K_lds + SHM_K), qr, negm, r32, hi);
  finishSM2(pA0, pA1, negmc, l_reg, pa0, pa1, pa2, pa3); SBAR();
  pv_d0(o, vb0, pa0, pa1, pa2, pa3); expA(pB0, negmc);
  __syncthreads();
  finishSM2(pB0, pB1, negmc, l_reg, pa0, pa1, pa2, pa3); SBAR();
  pv_d0(o, vb0 + (int)SHM_V, pa0, pa1, pa2, pa3);
  { auto rr = __builtin_amdgcn_permlane32_swap(__float_as_uint(l_reg), __float_as_uint(l_reg), false, false); l_reg = __uint_as_float(rr[0]) + __uint_as_float(rr[1]); }
  if (hi == 0) li_l[r32] = l_reg; asm volatile("s_waitcnt lgkmcnt(0)" ::: "memory");
  float rli[16];
#pragma unroll
  for (int r = 0; r < 16; ++r) rli[r] = __builtin_amdgcn_rcpf(li_l[crow(r, hi)]);
  { bf16* stg = (bf16*)(lds + OST_OFF) + wid * (32 * 128);
#pragma unroll
    for (int r = 0; r < 16; ++r) { const int orow = crow(r, hi);
#pragma unroll
      for (int d0 = 0; d0 < 4; ++d0) stg[orow * 128 + d0 * 32 + r32] = __float2bfloat16(o[d0][r] * rli[r]); }
    asm volatile("s_waitcnt lgkmcnt(0)" ::: "memory");
    bf16* Ow = Ob + (long)(wid * QBLK) * LDO;
#pragma unroll
    for (int i = 0; i < 8; ++i) { const int row = i * 4 + (lane >> 4), ch = lane & 15; const u32x4 v = *(const u32x4*)(stg + row * 128 + ch * 8); *(u32x4*)(Ow + (long)row * LDO + ch * 8) = v; }
    asm volatile("s_waitcnt lgkmcnt(0)" ::: "memory"); }
  __syncthreads();
#undef SLOAD
#undef SWRITE
#undef SWAIT
}
}

#define LAS __attribute__((address_space(3)))
typedef unsigned short bf16_t;
typedef unsigned v4u __attribute__((ext_vector_type(4)));
typedef float f32x4 __attribute__((ext_vector_type(4)));
typedef float f32x16 __attribute__((ext_vector_type(16)));
typedef short bf16x8 __attribute__((ext_vector_type(8)));
typedef short s16x4 __attribute__((ext_vector_type(4)));
#define LDS_WAIT() asm volatile("s_waitcnt lgkmcnt(0)" ::: "memory")

constexpr int NWAVES = 8, NTHREADS = 512;
constexpr int DM = 1024, DFF = 2816, NQKV = 1536;
constexpr int NTOK_P = 16384, NTOK_S = 32768, NTOK = 49152, SEQ_P = 8192, SEQ_S = 4096, NB_P = 2, NB_S = 8;
constexpr float EPS = 1e-6f;
constexpr size_t MiB = 1u << 20;
constexpr size_t WS_WGU = 1 * MiB, WS_WD = 45 * MiB, WS_WQKV = 67 * MiB, WS_WO = 73 * MiB, WS_W2 = 77 * MiB, WS_A1P = 85 * MiB, WS_A1S = 89 * MiB, WS_A2 = 90 * MiB, WS_ROPE = 90 * MiB + 65536, WS_QKG = 90 * MiB + 131072;
constexpr size_t WS_POOL = 92 * MiB, WS_RSS = 476 * MiB, WS_END = 482 * MiB, WS_TS = 90 * MiB + 196608;
constexpr size_t WS_F = WS_POOL, WS_T = WS_POOL + 192 * MiB, WS_HID = WS_POOL, WS_QO = WS_POOL, WS_K = WS_POOL + 96 * MiB, WS_V = WS_POOL + 120 * MiB, WS_XH = WS_POOL + 288 * MiB;
constexpr size_t RSS_STRIDE = (size_t)49152 * 4;
constexpr int LDS_BYTES = 147456;

__device__ __forceinline__ unsigned f2bf(float f) { unsigned u = __builtin_bit_cast(unsigned, f); return (u + 0x7fffu + ((u >> 16) & 1u)) >> 16; }
__device__ __forceinline__ unsigned pk2(float lo, float hi) { return f2bf(lo) | (f2bf(hi) << 16); }
__device__ __forceinline__ float wave_sum(float v) {
#pragma unroll
    for (int o = 1; o < 64; o <<= 1) v += __shfl_xor(v, o);
    return v;
}

template <class RowMap>
__device__ __forceinline__ void transpose_item(const float* __restrict__ W, int K, int N, bf16_t* WT, int ldk, const float* __restrict__ gain, RowMap rm, LAS float* scr, int item, int lane) {
    const int nblk = N / 64, kb = item / nblk, nb = item % nblk, k0 = 64 * kb, n0 = 64 * nb;
#pragma unroll
    for (int h = 0; h < 2; ++h) {
        float v[32];
#pragma unroll
        for (int i = 0; i < 32; ++i) v[i] = W[(size_t)(k0 + 32 * h + i) * N + n0 + lane];
#pragma unroll
        for (int i = 0; i < 32; ++i) { const int kk = 32 * h + i; float x = v[i]; if (gain) x *= gain[k0 + kk]; scr[kk * 64 + (lane ^ (kk & 0x38))] = x; }
    }
    LDS_WAIT(); asm volatile("" ::: "memory");
    const int c = lane & 7;
#pragma unroll
    for (int j = 0; j < 8; ++j) { const int n = (lane >> 3) + 8 * j; const LAS float* s = scr + (8 * c) * 64 + (n ^ (8 * c));
        v4u o; o.x = pk2(s[0 * 64], s[1 * 64]); o.y = pk2(s[2 * 64], s[3 * 64]); o.z = pk2(s[4 * 64], s[5 * 64]); o.w = pk2(s[6 * 64], s[7 * 64]);
        *(v4u*)(WT + (size_t)rm(n0 + n) * ldk + k0 + 8 * c) = o; }
    LDS_WAIT(); asm volatile("" ::: "memory");
}
struct RmId { __device__ __forceinline__ int operator()(int n) const { return n; } };
struct RmGU { int off; __device__ __forceinline__ int operator()(int n) const { return ((n >> 7) << 8) + (n & 127) + off; } };

__device__ __forceinline__ void cvt_row2(const float* xa, const float* xb, bf16_t* oa, bf16_t* ob, float* ra, float* rb, int lane) {
    const f32x4* pa = (const f32x4*)xa + lane; const f32x4* pb = (const f32x4*)xb + lane;
    f32x4 va[4], vb[4]; float sa = 0.f, sb = 0.f;
#pragma unroll
    for (int j = 0; j < 4; ++j) { va[j] = pa[64 * j]; vb[j] = pb[64 * j]; }
#pragma unroll
    for (int j = 0; j < 4; ++j) { sa += (va[j].x * va[j].x + va[j].y * va[j].y) + (va[j].z * va[j].z + va[j].w * va[j].w); sb += (vb[j].x * vb[j].x + vb[j].y * vb[j].y) + (vb[j].z * vb[j].z + vb[j].w * vb[j].w); }
    unsigned long long* qa = (unsigned long long*)oa + lane; unsigned long long* qb = (unsigned long long*)ob + lane;
#pragma unroll
    for (int j = 0; j < 4; ++j) { qa[64 * j] = (unsigned long long)pk2(va[j].x, va[j].y) | ((unsigned long long)pk2(va[j].z, va[j].w) << 32); qb[64 * j] = (unsigned long long)pk2(vb[j].x, vb[j].y) | ((unsigned long long)pk2(vb[j].z, vb[j].w) << 32); }
    sa = wave_sum(sa); sb = wave_sum(sb);
    if (lane == 0) { *(f32x4*)ra = (f32x4){sa, 0.f, 0.f, 0.f}; *(f32x4*)rb = (f32x4){sb, 0.f, 0.f, 0.f}; }
}

template <int OFF> __device__ __forceinline__ s16x4 tr_read_off(unsigned vb) {
    s16x4 r; asm volatile("ds_read_b64_tr_b16 %0, %1 offset:%2" : "=&v"(r) : "v"(vb), "i"(OFF) : "memory"); return r;
}
template <int KS, int NKS> struct BLoad {
    static __device__ __forceinline__ void run(bf16x8 (&b0)[NKS], bf16x8 (&b1)[NKS], unsigned base0, unsigned base1) {
        const s16x4 l0 = tr_read_off<(16 * KS) * 128>(base0), h0 = tr_read_off<(16 * KS + 4) * 128>(base0);
        const s16x4 l1 = tr_read_off<(16 * KS) * 128>(base1), h1 = tr_read_off<(16 * KS + 4) * 128>(base1);
        asm volatile("s_waitcnt lgkmcnt(0)" ::: "memory");
        b0[KS] = (bf16x8){l0[0], l0[1], l0[2], l0[3], h0[0], h0[1], h0[2], h0[3]};
        b1[KS] = (bf16x8){l1[0], l1[1], l1[2], l1[3], h1[0], h1[1], h1[2], h1[3]};
        if constexpr (KS + 1 < NKS) BLoad<KS + 1, NKS>::run(b0, b1, base0, base1);
    }
};
template <int KT, int MT, bool SC>
__device__ __forceinline__ void fft_unit(const bf16_t* __restrict__ A, const bf16_t* __restrict__ in, size_t in_stride, bf16_t* out, size_t so1, size_t so0, char* wl, int lane, const float* rs = nullptr, size_t rs_stride = 0, bf16_t* out2 = nullptr, long so1b = 0) {
    constexpr int NKS = KT / 16;
    const int r32 = lane & 31, hi = lane >> 5;
    { const int lr = lane >> 3, ch = lane & 7;
      v4u dv[KT / 8]; f32x4 pq[SC ? KT / 8 : 1];
#pragma unroll
      for (int i = 0; i < KT / 8; ++i) dv[i] = *(const v4u*)(in + (size_t)(i * 8 + lr) * in_stride + ch * 8);
      if constexpr (SC) {
#pragma unroll
          for (int i = 0; i < KT / 8; ++i) pq[i] = *(const f32x4*)(rs + (size_t)(i * 8 + lr) * rs_stride * 4);
      }
#pragma unroll
      for (int i = 0; i < KT / 8; ++i) { const int row = i * 8 + lr; v4u v = dv[i];
          if constexpr (SC) { const float r = __builtin_amdgcn_rsqf(((pq[i][0] + pq[i][1]) + (pq[i][2] + pq[i][3])) * (1.0f / 1024.0f) + 1e-6f);
              v.x = pg8::cvt_pk_bf16(pg8::bflo(v.x) * r, pg8::bfhi(v.x) * r); v.y = pg8::cvt_pk_bf16(pg8::bflo(v.y) * r, pg8::bfhi(v.y) * r); v.z = pg8::cvt_pk_bf16(pg8::bflo(v.z) * r, pg8::bfhi(v.z) * r); v.w = pg8::cvt_pk_bf16(pg8::bflo(v.w) * r, pg8::bfhi(v.w) * r); }
          *(v4u*)(wl + row * 128 + 16 * (ch ^ (((row >> 1) & 1) << 2))) = v; } }
    LDS_WAIT(); asm volatile("" ::: "memory");
    bf16x8 b0[NKS], b1[NKS];
    { const int blk = (lane >> 4) & 1, q = (lane & 15) >> 2, p = lane & 3, qb = (q >> 1) & 1;
      const unsigned basel = (unsigned)(uintptr_t)wl + (unsigned)((8 * hi + q) * 128 + 16 * (2 * blk + (p >> 1)) + 8 * (p & 1));
      BLoad<0, NKS>::run(b0, b1, basel + 64u * (unsigned)qb, basel + 64u * (unsigned)(1 - qb)); }
    asm volatile("" ::: "memory");
    bf16_t* stg = (bf16_t*)wl;
    bf16x8 af[NKS], an[NKS];
#pragma unroll
    for (int ks = 0; ks < NKS; ++ks) an[ks] = *(const bf16x8*)(A + (size_t)r32 * KT + 16 * ks + 8 * hi);
#pragma unroll 1
    for (int mb = 0; mb < MT / 32; ++mb) {
#pragma unroll
        for (int ks = 0; ks < NKS; ++ks) af[ks] = an[ks];
        { const int mbn = mb + 1 < MT / 32 ? mb + 1 : mb;
#pragma unroll
          for (int ks = 0; ks < NKS; ++ks) an[ks] = *(const bf16x8*)(A + (size_t)(32 * mbn + r32) * KT + 16 * ks + 8 * hi); }
        f32x16 c0 = {}, c1 = {};
#pragma unroll
        for (int ks = 0; ks < NKS; ++ks) { c0 = __builtin_amdgcn_mfma_f32_32x32x16_bf16(af[ks], b0[ks], c0, 0, 0, 0); c1 = __builtin_amdgcn_mfma_f32_32x32x16_bf16(af[ks], b1[ks], c1, 0, 0, 0); }
#pragma unroll
        for (int r = 0; r < 16; ++r) { const int orow = (r & 3) + 8 * (r >> 2) + 4 * hi; stg[orow * 64 + r32] = (bf16_t)f2bf(c0[r]); stg[orow * 64 + 32 + r32] = (bf16_t)f2bf(c1[r]); }
        LDS_WAIT(); asm volatile("" ::: "memory");
#pragma unroll
        for (int i = 0; i < 4; ++i) { const int row = i * 8 + (lane >> 3), ch = lane & 7, m = 32 * mb + row; const v4u v = *(const v4u*)(stg + row * 64 + ch * 8);
            *(v4u*)(out + (size_t)(m >> 1) * so1 + (size_t)(m & 1) * so0 + ch * 8) = v;
            if (out2) { const unsigned sg = (m & 1) ? 0x80008000u : 0u; v4u w = v; w.x ^= sg; w.y ^= sg; w.z ^= sg; w.w ^= sg;
                *(v4u*)(out2 + (long)(m >> 1) * so1b + (long)(m & 1) * (long)so0 + ch * 8) = w; } }
        LDS_WAIT(); asm volatile("" ::: "memory");
    }
}

typedef __attribute__((address_space(1))) unsigned gu32;
#define XB_TMO      128
#define XB_XCNT(j)  (256  + 64 * (j))
#define XB_XSUB(j)  (1280 + 64 * (j))
#define XB_XGEN(j)  (2304 + 64 * (j))
#define XB_TOP      3328
#define XB_TOPGEN   3392
#define XCD_BAR_WORDS 3456
#define XB_SPIN_CAP (1u << 22)

__device__ __forceinline__ unsigned xb_ld(unsigned* p)              { return __hip_atomic_load(p, __ATOMIC_RELAXED, __HIP_MEMORY_SCOPE_AGENT); }
__device__ __forceinline__ unsigned xb_add(unsigned* p, unsigned v) { return __hip_atomic_fetch_add(p, v, __ATOMIC_RELAXED, __HIP_MEMORY_SCOPE_AGENT); }
__device__ __forceinline__ unsigned xb_xcc_id() { return (unsigned)__builtin_amdgcn_s_getreg((3 << 11) | 20) & 0xFu; }
#define XB_SPIN(cond, bar) do { unsigned _sp = 0; while (cond) { __builtin_amdgcn_s_sleep(1); \
    if ((++_sp & 255u) == 0u) { if (xb_ld(&(bar)[XB_TMO])) break; if (_sp > XB_SPIN_CAP) { atomicAdd(&(bar)[XB_TMO], 1u); break; } } } } while (0)

struct XcdBarrier {
    unsigned* bar; unsigned x;
    volatile LAS unsigned* st;
};

__device__ __forceinline__ XcdBarrier xcd_barrier_post(unsigned* bar, volatile LAS unsigned* st) {
    XcdBarrier b; b.bar = bar; b.x = xb_xcc_id(); b.st = st;
    if (threadIdx.x == 0) (void)xb_add(&bar[XB_XCNT(b.x)], 1u);
    return b;
}
__device__ __forceinline__ void xcd_barrier_complete(unsigned* bar, unsigned x, unsigned& nloc, unsigned& nx) {
    const unsigned G = gridDim.x * gridDim.y * gridDim.z;
    unsigned sum, cnt, mine, sp = 0u;
    for (;;) {
        sum = 0u; cnt = 0u; mine = 0u;
#pragma unroll
        for (unsigned j = 0; j < 16; ++j) { const unsigned c = xb_ld(&bar[XB_XCNT(j)]); sum += c; cnt += (c > 0u) ? 1u : 0u; mine = (j == x) ? c : mine; }
        if (sum == G) break;
        __builtin_amdgcn_s_sleep(1);
        if ((++sp & 255u) == 0u) { if (xb_ld(&bar[XB_TMO])) break; if (sp > XB_SPIN_CAP) { atomicAdd(&bar[XB_TMO], 1u); break; } }
    }
    nloc = mine > 0u ? mine : 1u; nx = cnt > 0u ? cnt : 1u;
}

__device__ __forceinline__ void xcd_barrier(const XcdBarrier& b) {
    asm volatile("s_waitcnt vmcnt(0)" ::: "memory");
    __syncthreads();
    if (threadIdx.x == 0) {
        unsigned* bar = b.bar;
        __builtin_amdgcn_s_waitcnt(0);
        unsigned nloc = b.st[0], nx = b.st[1];
        if (nloc == 0u) { xcd_barrier_complete(bar, b.x, nloc, nx); b.st[0] = nloc; b.st[1] = nx; }
        const unsigned old = xb_add(&bar[XB_XSUB(b.x)], 1u);
        const unsigned gen = old / nloc;
        if (old + 1u == (gen + 1u) * nloc) {
            __builtin_amdgcn_fence(__ATOMIC_RELEASE, "agent");
            asm volatile("s_waitcnt vmcnt(0)" ::: "memory");
            const unsigned og = xb_add(&bar[XB_TOP], 1u);
            const unsigned tg = og / nx;
            if (og + 1u == (tg + 1u) * nx) xb_add(&bar[XB_TOPGEN], 1u);
            else XB_SPIN(xb_ld(&bar[XB_TOPGEN]) == tg, bar);
            __builtin_amdgcn_fence(__ATOMIC_ACQUIRE, "agent");
            xb_add(&bar[XB_XGEN(b.x)], 1u);
            asm volatile("s_waitcnt vmcnt(0)" ::: "memory");
        } else {
            XB_SPIN(xb_ld(&bar[XB_XGEN(b.x)]) == gen, bar);
            __builtin_amdgcn_fence(__ATOMIC_ACQUIRE, "agent");
            asm volatile("s_waitcnt vmcnt(0)" ::: "memory");
        }
    }
    __syncthreads();
}
constexpr int NPH_C = 21;
__device__ const float CS128[256] = {1.000000000e+00f, 9.987954562e-01f, 9.951847267e-01f, 9.891765100e-01f, 9.807852804e-01f, 9.700312532e-01f, 9.569403357e-01f, 9.415440652e-01f, 9.238795325e-01f, 9.039892931e-01f, 8.819212643e-01f, 8.577286100e-01f, 8.314696123e-01f, 8.032075315e-01f, 7.730104534e-01f, 7.409511254e-01f, 7.071067812e-01f, 6.715589548e-01f, 6.343932842e-01f, 5.956993045e-01f, 5.555702330e-01f, 5.141027442e-01f, 4.713967368e-01f, 4.275550934e-01f, 3.826834324e-01f, 3.368898534e-01f, 2.902846773e-01f, 2.429801799e-01f, 1.950903220e-01f, 1.467304745e-01f, 9.801714033e-02f, 4.906767433e-02f, 6.123233996e-17f, -4.906767433e-02f, -9.801714033e-02f, -1.467304745e-01f, -1.950903220e-01f, -2.429801799e-01f, -2.902846773e-01f, -3.368898534e-01f, -3.826834324e-01f, -4.275550934e-01f, -4.713967368e-01f, -5.141027442e-01f, -5.555702330e-01f, -5.956993045e-01f, -6.343932842e-01f, -6.715589548e-01f, -7.071067812e-01f, -7.409511254e-01f, -7.730104534e-01f, -8.032075315e-01f, -8.314696123e-01f, -8.577286100e-01f, -8.819212643e-01f, -9.039892931e-01f, -9.238795325e-01f, -9.415440652e-01f, -9.569403357e-01f, -9.700312532e-01f, -9.807852804e-01f, -9.891765100e-01f, -9.951847267e-01f, -9.987954562e-01f, -1.000000000e+00f, -9.987954562e-01f, -9.951847267e-01f, -9.891765100e-01f, -9.807852804e-01f, -9.700312532e-01f, -9.569403357e-01f, -9.415440652e-01f, -9.238795325e-01f, -9.039892931e-01f, -8.819212643e-01f, -8.577286100e-01f, -8.314696123e-01f, -8.032075315e-01f, -7.730104534e-01f, -7.409511254e-01f, -7.071067812e-01f, -6.715589548e-01f, -6.343932842e-01f, -5.956993045e-01f, -5.555702330e-01f, -5.141027442e-01f, -4.713967368e-01f, -4.275550934e-01f, -3.826834324e-01f, -3.368898534e-01f, -2.902846773e-01f, -2.429801799e-01f, -1.950903220e-01f, -1.467304745e-01f, -9.801714033e-02f, -4.906767433e-02f, -1.836970199e-16f, 4.906767433e-02f, 9.801714033e-02f, 1.467304745e-01f, 1.950903220e-01f, 2.429801799e-01f, 2.902846773e-01f, 3.368898534e-01f, 3.826834324e-01f, 4.275550934e-01f, 4.713967368e-01f, 5.141027442e-01f, 5.555702330e-01f, 5.956993045e-01f, 6.343932842e-01f, 6.715589548e-01f, 7.071067812e-01f, 7.409511254e-01f, 7.730104534e-01f, 8.032075315e-01f, 8.314696123e-01f, 8.577286100e-01f, 8.819212643e-01f, 9.039892931e-01f, 9.238795325e-01f, 9.415440652e-01f, 9.569403357e-01f, 9.700312532e-01f, 9.807852804e-01f, 9.891765100e-01f, 9.951847267e-01f, 9.987954562e-01f, 0.000000000e+00f, 4.906767433e-02f, 9.801714033e-02f, 1.467304745e-01f, 1.950903220e-01f, 2.429801799e-01f, 2.902846773e-01f, 3.368898534e-01f, 3.826834324e-01f, 4.275550934e-01f, 4.713967368e-01f, 5.141027442e-01f, 5.555702330e-01f, 5.956993045e-01f, 6.343932842e-01f, 6.715589548e-01f, 7.071067812e-01f, 7.409511254e-01f, 7.730104534e-01f, 8.032075315e-01f, 8.314696123e-01f, 8.577286100e-01f, 8.819212643e-01f, 9.039892931e-01f, 9.238795325e-01f, 9.415440652e-01f, 9.569403357e-01f, 9.700312532e-01f, 9.807852804e-01f, 9.891765100e-01f, 9.951847267e-01f, 9.987954562e-01f, 1.000000000e+00f, 9.987954562e-01f, 9.951847267e-01f, 9.891765100e-01f, 9.807852804e-01f, 9.700312532e-01f, 9.569403357e-01f, 9.415440652e-01f, 9.238795325e-01f, 9.039892931e-01f, 8.819212643e-01f, 8.577286100e-01f, 8.314696123e-01f, 8.032075315e-01f, 7.730104534e-01f, 7.409511254e-01f, 7.071067812e-01f, 6.715589548e-01f, 6.343932842e-01f, 5.956993045e-01f, 5.555702330e-01f, 5.141027442e-01f, 4.713967368e-01f, 4.275550934e-01f, 3.826834324e-01f, 3.368898534e-01f, 2.902846773e-01f, 2.429801799e-01f, 1.950903220e-01f, 1.467304745e-01f, 9.801714033e-02f, 4.906767433e-02f, 1.224646799e-16f, -4.906767433e-02f, -9.801714033e-02f, -1.467304745e-01f, -1.950903220e-01f, -2.429801799e-01f, -2.902846773e-01f, -3.368898534e-01f, -3.826834324e-01f, -4.275550934e-01f, -4.713967368e-01f, -5.141027442e-01f, -5.555702330e-01f, -5.956993045e-01f, -6.343932842e-01f, -6.715589548e-01f, -7.071067812e-01f, -7.409511254e-01f, -7.730104534e-01f, -8.032075315e-01f, -8.314696123e-01f, -8.577286100e-01f, -8.819212643e-01f, -9.039892931e-01f, -9.238795325e-01f, -9.415440652e-01f, -9.569403357e-01f, -9.700312532e-01f, -9.807852804e-01f, -9.891765100e-01f, -9.951847267e-01f, -9.987954562e-01f, -1.000000000e+00f, -9.987954562e-01f, -9.951847267e-01f, -9.891765100e-01f, -9.807852804e-01f, -9.700312532e-01f, -9.569403357e-01f, -9.415440652e-01f, -9.238795325e-01f, -9.039892931e-01f, -8.819212643e-01f, -8.577286100e-01f, -8.314696123e-01f, -8.032075315e-01f, -7.730104534e-01f, -7.409511254e-01f, -7.071067812e-01f, -6.715589548e-01f, -6.343932842e-01f, -5.956993045e-01f, -5.555702330e-01f, -5.141027442e-01f, -4.713967368e-01f, -4.275550934e-01f, -3.826834324e-01f, -3.368898534e-01f, -2.902846773e-01f, -2.429801799e-01f, -1.950903220e-01f, -1.467304745e-01f, -9.801714033e-02f, -4.906767433e-02f};
struct Args { const float* in[12]; float* out; unsigned char* ws; int ph_lo, ph_hi; };

__global__ void __launch_bounds__(NTHREADS, 2) mk_fwd(Args args) {
    extern __shared__ __attribute__((aligned(16))) unsigned char lds[];
    const int G = gridDim.x; const int bx = blockIdx.x; const int vcu = (G % 8 == 0) ? (bx % 8) * (G / 8) + bx / 8 : bx;
    const int NGW = G * NWAVES;
    unsigned char* ws = args.ws; float* X = args.out;
    bf16_t* Wgu = (bf16_t*)(ws + WS_WGU); bf16_t* Wd = (bf16_t*)(ws + WS_WD); bf16_t* Wqkv = (bf16_t*)(ws + WS_WQKV); bf16_t* Wo = (bf16_t*)(ws + WS_WO); bf16_t* W2 = (bf16_t*)(ws + WS_W2);
    bf16_t* A1P = (bf16_t*)(ws + WS_A1P); bf16_t* A1S = (bf16_t*)(ws + WS_A1S); bf16_t* A2 = (bf16_t*)(ws + WS_A2); bf16_t* A2M = (bf16_t*)(ws + WS_A2 + 32768); bf16_t* A2Z = (bf16_t*)(ws + WS_A2 + 98304); bf16_t* A2H = (bf16_t*)(ws + WS_A2 + 163840); float2* ROPE = (float2*)(ws + WS_ROPE); float* QKG = (float*)(ws + WS_QKG);
    bf16_t* XB0 = (bf16_t*)args.out; bf16_t* XBH = (bf16_t*)(ws + WS_XH); float* RSS = (float*)(ws + WS_RSS); bf16_t* FB = (bf16_t*)(ws + WS_F); bf16_t* TB = (bf16_t*)(ws + WS_T); bf16_t* HID = (bf16_t*)(ws + WS_HID);
    bf16_t* QO = (bf16_t*)(ws + WS_QO); bf16_t* KB = (bf16_t*)(ws + WS_K); bf16_t* VB = (bf16_t*)(ws + WS_V);
    LAS unsigned char* ldsl = (LAS unsigned char*)lds;
    const int lo = args.ph_lo, hi = args.ph_hi;
    int ph = 0;
    volatile LAS unsigned* MISC = (volatile LAS unsigned*)(ldsl + 131072 + 8192);
    if (threadIdx.x < 64) MISC[threadIdx.x] = 0u;
    __syncthreads();
    XcdBarrier xbar; xbar.bar = (unsigned*)(ws + 16384); xbar.x = xb_xcc_id(); xbar.st = MISC + 8;
    if (bx == 0) { for (int i = threadIdx.x; i < XCD_BAR_WORDS; i += NTHREADS) xbar.bar[i] = 0u; }
    unsigned long long* TS = (unsigned long long*)(ws + WS_TS);
    if (MK_PROBE && bx == 0 && threadIdx.x == 0) TS[0] = __builtin_amdgcn_s_memrealtime();
#define PH_BEGIN if (ph >= lo && ph < hi) { const int tid = mk_tid(), lane = tid & 63, wave = __builtin_amdgcn_readfirstlane(tid >> 6), gw = vcu * NWAVES + wave; (void)lane; (void)gw;
#define PH_END } ++ph; if (ph > lo && ph < hi) { if (ph == 1 || MK_CG_ONLY) { cg::this_grid().sync(); if (ph == 1 && threadIdx.x == 0) (void)xb_add(&xbar.bar[XB_XCNT(xbar.x)], 1u); } else xcd_barrier(xbar); } if (MK_PROBE && bx == 0 && threadIdx.x == 0) TS[ph] = __builtin_amdgcn_s_memrealtime();

    PH_BEGIN
    if (EN_P0) {
        LAS float* scr = (LAS float*)(ldsl + wave * 16384);
        if (MK_PROBE2 && bx == 0 && threadIdx.x == 0) TS[40] = __builtin_amdgcn_s_memrealtime();
        constexpr int I_G = 16 * 44, I_D = 44 * 16, I_QKV = 16 * 24, I_O = 16 * 16;
        constexpr int NITEMS = 4 * (2 * I_G + I_D) + 2 * (I_QKV + I_O);
        for (int it = gw; it < NITEMS; it += NGW) {
            int r = it;
            if (r < 4 * I_G) { const int l = r / I_G; transpose_item(args.in[9] + (size_t)l * DM * DFF, DM, DFF, Wgu + (size_t)l * 2 * DFF * DM, DM, args.in[3] + l * DM, RmGU{0}, scr, r % I_G, lane); continue; } r -= 4 * I_G;
            if (r < 4 * I_G) { const int l = r / I_G; transpose_item(args.in[10] + (size_t)l * DM * DFF, DM, DFF, Wgu + (size_t)l * 2 * DFF * DM, DM, args.in[3] + l * DM, RmGU{128}, scr, r % I_G, lane); continue; } r -= 4 * I_G;
            if (r < 4 * I_D) { const int l = r / I_D; transpose_item(args.in[11] + (size_t)l * DFF * DM, DFF, DM, Wd + (size_t)l * DM * DFF, DFF, (const float*)nullptr, RmId{}, scr, r % I_D, lane); continue; } r -= 4 * I_D;
            if (r < 2 * I_QKV) { const int j = r / I_QKV; transpose_item(args.in[5] + (size_t)j * DM * NQKV, DM, NQKV, Wqkv + (size_t)j * NQKV * DM, DM, args.in[2] + (2 * j + 1) * DM, RmId{}, scr, r % I_QKV, lane); continue; } r -= 2 * I_QKV;
            { const int j = r / I_O; transpose_item(args.in[8] + (size_t)j * DM * DM, DM, DM, Wo + (size_t)j * DM * DM, DM, (const float*)nullptr, RmId{}, scr, r % I_O, lane); }
        }
        if (MK_PROBE2) { __syncthreads(); if (bx == 0 && threadIdx.x == 0) TS[41] = __builtin_amdgcn_s_memrealtime(); }
        {
          for (int task = gw; task < 2048; task += NGW) {
              const int nb = task & 15, cc = (task >> 4) & 3, g = (task >> 6) & 7, p = (task >> 9) & 1, j = task >> 10;
              const int n = nb * 64 + lane; const float* w = args.in[4] + (size_t)j * DM * DM + (size_t)(g * 128) * DM + n; const float* tb = CS128 + p * 128;
              float acc[32];
#pragma unroll
              for (int ci = 0; ci < 32; ++ci) acc[ci] = 0.f;
              for (int jp0 = 0; jp0 < 128; jp0 += 8) { float wv[8];
#pragma unroll
                  for (int d = 0; d < 8; ++d) wv[d] = w[(size_t)(jp0 + d) * DM];
#pragma unroll
                  for (int d = 0; d < 8; ++d)
#pragma unroll
                      for (int ci = 0; ci < 32; ++ci) acc[ci] += tb[((cc * 32 + ci) * (jp0 + d)) & 127] * wv[d]; }
              const float* gain = args.in[2] + (2 * j) * DM + g * 128 + cc * 32;
              bf16_t* dst = W2 + (size_t)j * DM * 2048 + (size_t)n * 2048 + p * 1024 + g * 128 + cc * 32;
#pragma unroll
              for (int q4 = 0; q4 < 4; ++q4) { v4u o; const float sc = 0.08838834764831845f;
                  o.x = pk2(acc[8 * q4 + 0] * gain[8 * q4 + 0] * sc, acc[8 * q4 + 1] * gain[8 * q4 + 1] * sc); o.y = pk2(acc[8 * q4 + 2] * gain[8 * q4 + 2] * sc, acc[8 * q4 + 3] * gain[8 * q4 + 3] * sc);
                  o.z = pk2(acc[8 * q4 + 4] * gain[8 * q4 + 4] * sc, acc[8 * q4 + 5] * gain[8 * q4 + 5] * sc); o.w = pk2(acc[8 * q4 + 6] * gain[8 * q4 + 6] * sc, acc[8 * q4 + 7] * gain[8 * q4 + 7] * sc);
                  *(v4u*)(dst + 8 * q4) = o; }
          }
          LDS_WAIT(); asm volatile("" ::: "memory");
        }
        if (MK_PROBE2) { __syncthreads(); if (bx == 0 && threadIdx.x == 0) TS[42] = __builtin_amdgcn_s_memrealtime(); }
        { const int gt = gw * 64 + lane, NGT = NGW * 64;
          for (int e2 = gt; e2 < 64 * 256 * 64; e2 += NGT) {
              const int s1 = (e2 & 63) * 2, m = (e2 >> 6) & 255, s2 = e2 >> 14, k1 = m >> 1, pp = m & 1; float v[2];
#pragma unroll
              for (int d = 0; d < 2; ++d) { const int s = 64 * (s1 + d) + s2, r = (k1 * s) & 8191; const float x = (float)r * (1.0f / 4096.0f); v[d] = (pp ? -sinpif(x) : cospif(x)) * 0.08838834764831845f; if (m == 1) v[d] = ((s1 + d) & 1) ? -0.08838834764831845f : 0.08838834764831845f; }
              ((unsigned*)A1P)[e2] = pk2(v[0], v[1]); }
          for (int e2 = gt; e2 < 64 * 128 * 32; e2 += NGT) {
              const int s1 = (e2 & 31) * 2, m = (e2 >> 5) & 127, s2 = e2 >> 12, k1 = m >> 1, pp = m & 1; float v[2];
#pragma unroll
              for (int d = 0; d < 2; ++d) { const int s = 64 * (s1 + d) + s2, r = (k1 * s) & 4095; const float x = (float)r * (1.0f / 2048.0f); v[d] = (pp ? -sinpif(x) : cospif(x)) * 0.125f; if (m == 1) v[d] = ((s1 + d) & 1) ? -0.125f : 0.125f; }
              ((unsigned*)A1S)[e2] = pk2(v[0], v[1]); }
          for (int e2 = gt; e2 < 128 * 64; e2 += NGT) {
              const int k = (e2 & 63) * 2, m = e2 >> 6, k2 = m >> 1, pp = m & 1, p = k >> 6; float v[2];
#pragma unroll
              for (int d = 0; d < 2; ++d) { const int s2 = (k + d) & 63, r = (k2 * s2) & 63; const float x = (float)r * (1.0f / 32.0f); const float c = cospif(x), s = sinpif(x);
                  v[d] = (pp == 0 ? (p == 0 ? c : s) : (p == 0 ? -s : c)) * 0.125f; }
              ((unsigned*)A2)[e2] = pk2(v[0], v[1]); }
          for (int e2 = gt; e2 < 128 * 64; e2 += NGT) {
              const int k = (e2 & 63) * 2, m = e2 >> 6, k2 = m >> 1, pp = m & 1, p = k >> 6; float v[2];
#pragma unroll
              for (int d = 0; d < 2; ++d) { const int s2 = (k + d) & 63, r = ((k2 + 1) * s2) & 63; const float x = (float)r * (1.0f / 32.0f); const float c = cospif(x), s = sinpif(x);
                  v[d] = (pp == 0 ? (p == 0 ? c : -s) : (p == 0 ? -s : -c)) * 0.125f; }
              ((unsigned*)A2M)[e2] = pk2(v[0], v[1]); }
          for (int e2 = gt; e2 < 128 * 64; e2 += NGT) {
              const int k = (e2 & 63) * 2, m = e2 >> 6, k2 = m >> 1, pp = m & 1, p = k >> 6; float vz[2], vh[2];
#pragma unroll
              for (int d = 0; d < 2; ++d) { const int s2 = (k + d) & 63; const int r = (k2 * s2) & 63; const float x = (float)r * (1.0f / 32.0f);
                  vz[d] = p == 0 ? (pp == 0 ? cospif(x) : -sinpif(x)) * 0.125f : 0.f;
                  const int rh = (s2 * (2 * k2 + 1)) & 127; const float xh = (float)rh * (1.0f / 64.0f);
                  vh[d] = p == 1 ? (pp == 0 ? cospif(xh) : -sinpif(xh)) * 0.125f : 0.f; }
              ((unsigned*)A2Z)[e2] = pk2(vz[0], vz[1]); ((unsigned*)A2H)[e2] = pk2(vh[0], vh[1]); }
          if (gw == 0) {
#pragma unroll
              for (int j2 = 0; j2 < 2; ++j2) { float mq = fmaxf(fabsf(args.in[6][j2 * 128 + lane]), fabsf(args.in[6][j2 * 128 + 64 + lane])), mk = fmaxf(fabsf(args.in[7][j2 * 128 + lane]), fabsf(args.in[7][j2 * 128 + 64 + lane]));
#pragma unroll
                  for (int o = 1; o < 64; o <<= 1) { mq = fmaxf(mq, __shfl_xor(mq, o)); mk = fmaxf(mk, __shfl_xor(mk, o)); }
                  if (lane == 0) QKG[512 + j2] = -(128.0f * 1.02f * mq * mk) * (att::SCALE * 1.4426950408889634f); }
          }
          for (int e = gt; e < 512; e += NGT) { const int j = e >> 8, r = e & 255; QKG[e] = r < 128 ? args.in[6][j * 128 + r] : args.in[7][j * 128 + r - 128]; }
          for (int e = gt; e < 128 * 32; e += NGT) { const int i = e & 31, pos = e >> 5; const float inv = powf(10000.0f, -(float)i * (1.0f / 32.0f)); const float a = (float)pos * inv; ROPE[e] = make_float2(cosf(a), sinf(a)); }
        }
        if (MK_PROBE2) { __syncthreads(); if (bx == 0 && threadIdx.x == 0) TS[43] = __builtin_amdgcn_s_memrealtime(); }
        for (int m = 2 * gw; m < NTOK; m += 2 * NGW) { const float* src = m < NTOK_P ? args.in[0] + (size_t)m * DM : args.in[1] + (size_t)(m - NTOK_P) * DM; cvt_row2(src, src + DM, XB0 + (size_t)m * DM, XB0 + (size_t)(m + 1) * DM, RSS + (size_t)m * 4, RSS + (size_t)(m + 1) * 4, lane); }
    }
    PH_END

    for (int layer = 0; layer < 4; ++layer) {
        const int jj = layer >> 1;
        const float* rss_mix = RSS + (size_t)(2 * layer) * RSS_STRIDE;
        float* rss_ffn = RSS + (size_t)(2 * layer + 1) * RSS_STRIDE;
        float* rss_next = RSS + (size_t)(2 * layer + 2) * RSS_STRIDE;
        bf16_t* XBF = layer == 3 ? XBH : XB0;
        PG8_LAS float* Pscr = (PG8_LAS float*)(ldsl + 131072);
        if ((layer & 1) == 0) {
            PH_BEGIN
            if (EN_FFT) {
                char* wl = (char*)lds + wave * 16384;
                for (int u = gw; u < 2048; u += NGW) { const int cb = u & 15, s2 = (u >> 4) & 63, b = u >> 10; const size_t tok = (size_t)b * SEQ_P + s2;
                    fft_unit<128, 128, true>(A1P + (size_t)s2 * 256 * 128, XB0 + tok * DM + cb * 64, (size_t)64 * DM, TB + ((size_t)b * 2 * SEQ_P + s2) * DM + cb * 64, (size_t)2 * 64 * DM, (size_t)64 * DM, wl, lane, rss_mix + tok * 4, (size_t)64); }
                for (int u = gw; u < 8192; u += NGW) { const int cb = u & 15, s2 = (u >> 4) & 63, b = u >> 10; const size_t tok = (size_t)NTOK_P + (size_t)b * SEQ_S + s2;
                    fft_unit<64, 64, true>(A1S + (size_t)s2 * 128 * 64, XB0 + tok * DM + cb * 64, (size_t)64 * DM, TB + ((size_t)2 * NTOK_P + (size_t)b * 2 * SEQ_S + s2) * DM + cb * 64, (size_t)2 * 64 * DM, (size_t)64 * DM, wl, lane, rss_mix + tok * 4, (size_t)64); }
            }
            PH_END
            PH_BEGIN
            if (EN_FFT) {
                char* wl = (char*)lds + wave * 16384;
                for (int u = gw; u < 2080 + 4224; u += NGW) {
                    const bool P = u < 2080; const int v = P ? u : u - 2080; const int cb = v & 15; const int q = v >> 4; const int nk = P ? 65 : 33; const int b = q / nk, k1 = q - b * nk;
                    const int N1h = P ? 64 : 32, N1 = 2 * N1h; const size_t tok0 = P ? (size_t)b * SEQ_P : (size_t)NTOK_P + (size_t)b * SEQ_S;
                    const int k1s = k1 == N1h ? 0 : k1; const bf16_t* Am = k1 == 0 ? A2Z : (k1 == N1h ? A2H : A2);
                    const size_t trow = 2 * tok0 + (size_t)k1s * 128;
                    bf16_t* o2 = (k1 != 0 && k1 != N1h) ? FB + (tok0 + (size_t)(N1 - k1) + (size_t)N1 * 63) * 2048 + cb * 64 : (bf16_t*)nullptr;
                    fft_unit<128, 128, false>(Am, TB + trow * DM + cb * 64, (size_t)DM, FB + (tok0 + k1) * 2048 + cb * 64, (size_t)N1 * 2048, (size_t)1024, wl, lane, nullptr, 0, o2, -(long)N1 * 2048);
                }
            }
            PH_END
        } else {
            PH_BEGIN
            if (EN_QKV) {
                pg8::Gemm g{XB0, Wqkv + (size_t)jj * NQKV * DM, NTOK, NQKV, DM}; pg8::StaticOrder S; S.init(NTOK, NQKV, G, bx);
                pg8::EpiQKV E{QO, KB, VB, rss_mix, QKG + jj * 256, (const float*)ROPE, (PG8_LAS float*)(ldsl + 131072), att::SCALE * 1.4426950408889634f};
                pg8::gemm_phase<pg8::EpiQKV, pg8::StaticOrder, GU_ALIGN, GEMM_SP2>(ldsl, g, S, E);
            }
            PH_END
            PH_BEGIN
            if (EN_ATT) {
                const float* qg = QKG + jj * 256; const float negmc = QKG[512 + jj];
                for (int j = vcu; j < 1536; j += G) {
                    int b, h, qb, tok0, seq;
                    if (j < 512) { const int bh = j >> 5; qb = j & 31; b = bh >> 3; h = bh & 7; tok0 = b * SEQ_P; seq = SEQ_P; }
                    else { const int v = j - 512, bh = v >> 4; qb = v & 15; b = bh >> 3; h = bh & 7; tok0 = NTOK_P + b * SEQ_S; seq = SEQ_S; }
                    const att::bf16* Qb = (const att::bf16*)QO + ((size_t)tok0 + qb * 256) * 1024 + h * 128;
                    const att::bf16* Kh = (const att::bf16*)KB + (size_t)tok0 * 256 + (h >> 2) * 128;
                    const att::bf16* Vh = (const att::bf16*)VB + (size_t)tok0 * 256 + (h >> 2) * 128;
                    att::attn_unit(Qb, Kh, Vh, (att::bf16*)Qb, seq, qb * 256, qg, ROPE, negmc, (char*)lds);
                }
            }
            PH_END
        }
        PH_BEGIN
        if (EN_RES) {
            pg8::Gemm g = (layer & 1) ? pg8::Gemm{QO, Wo + (size_t)jj * DM * DM, NTOK, DM, DM} : pg8::Gemm{FB, W2 + (size_t)jj * DM * 2048, NTOK, DM, 2048};
            pg8::StaticOrder S; S.init(NTOK, DM, G, bx); pg8::EpiResB E{XB0, XBF, (float*)nullptr, rss_ffn, Pscr};
            pg8::gemm_phase<pg8::EpiResB, pg8::StaticOrder, true, GEMM_SP2>(ldsl, g, S, E);
        }
        PH_END
        PH_BEGIN
        if (EN_GU) {
            if (MK_SLEEP_US) { const unsigned long long t0 = __builtin_amdgcn_s_memrealtime(); while (__builtin_amdgcn_s_memrealtime() - t0 < 100ull * MK_SLEEP_US) __builtin_amdgcn_s_sleep(64); }
            pg8::Gemm g{XBF, Wgu + (size_t)layer * 2 * DFF * DM, NTOK, 2 * DFF, DM}; pg8::StaticOrder S; S.init(NTOK, 2 * DFF, G, bx);
            pg8::EpiSwiGLU E{HID, DFF, rss_ffn};
            pg8::gemm_phase<pg8::EpiSwiGLU, pg8::StaticOrder, GU_ALIGN, GEMM_SP2>(ldsl, g, S, E);
        }
        PH_END
        PH_BEGIN
        if (EN_RES) {
            pg8::Gemm g{HID, Wd + (size_t)layer * DM * DFF, NTOK, DM, DFF}; pg8::StaticOrder S; S.init(NTOK, DM, G, bx); S.rev = MK_DREV;
            pg8::EpiResB E{XBF, XB0, layer == 3 ? X : (float*)nullptr, layer == 3 ? (float*)nullptr : rss_next, Pscr};
            pg8::gemm_phase<pg8::EpiResB, pg8::StaticOrder, true, GEMM_SP2>(ldsl, g, S, E);
        }
        PH_END
    }
#undef PH_BEGIN
#undef PH_END
    for (int i = 0; i < MK_EXTRA_SYNC; ++i) cg::this_grid().sync();
    if (MK_PROBE && bx == 0 && threadIdx.x == 0) {
        unsigned long long sa = 0, sb = 0; const unsigned long long tot = TS[NPH_C] - TS[0];
        for (int i = 0; i < NPH_C; ++i) { const unsigned long long d = TS[i + 1] - TS[i]; if ((MK_MASK_A >> i) & 1u) sa += d; if ((MK_MASK_B >> i) & 1u) sb += d; }
        if (MK_PROBE2) { unsigned long long q[5] = {TS[40], TS[41], TS[42], TS[43], TS[1]}; sa = q[MK_PA + 1] - q[MK_PA]; sb = q[MK_PB + 1] - q[MK_PB]; sa *= 10; sb *= 10; }
        const unsigned long long pa = (sa * 100 + tot / 2) / tot, pb = (sb * 100 + tot / 2) / tot;
        const unsigned long long D = 2000ull * (pa * 100 + pb);
        while (__builtin_amdgcn_s_memrealtime() - TS[NPH_C] < D) __builtin_amdgcn_s_sleep(32);
    }
}
constexpr int NPHASES = NPH_C;

extern "C" void kernel_launch(void* const* d_in, const int* in_sizes, int n_in, void* d_out, int out_size, void* d_ws, size_t ws_size, hipStream_t stream) {
    static int grid = 0;
    if (grid == 0) {
        if (n_in != 12 || out_size != NTOK * DM || ws_size < WS_END) { fprintf(stderr, "kernel_launch: unexpected shapes: n_in %d out %d ws %zu (need %zu)\n", n_in, out_size, ws_size, (size_t)WS_END); grid = -1; return; }
        int dev = 0, cus = 0, per_cu = 0;
        hipGetDevice(&dev); hipDeviceGetAttribute(&cus, hipDeviceAttributeMultiprocessorCount, dev);
        if (hipFuncSetAttribute((const void*)mk_fwd, hipFuncAttributeMaxDynamicSharedMemorySize, LDS_BYTES) != hipSuccess) { fprintf(stderr, "kernel_launch: hipFuncSetAttribute failed\n"); grid = -1; return; }
        if (hipOccupancyMaxActiveBlocksPerMultiprocessor(&per_cu, (const void*)mk_fwd, NTHREADS, LDS_BYTES) != hipSuccess || per_cu < 1) { fprintf(stderr, "kernel_launch: occupancy query gave %d\n", per_cu); per_cu = 1; }
        (void)hipGetLastError();
        grid = cus * per_cu;
        fprintf(stderr, "kernel_launch: grid %d (cus %d x %d)\n", grid, cus, per_cu);
    }
    if (grid < 0) return;
    Args a{};
    for (int i = 0; i < 12; ++i) a.in[i] = (const float*)d_in[i];
    a.out = (float*)d_out; a.ws = (unsigned char*)d_ws;
#if MK_ONE_LAUNCH
    a.ph_lo = 0; a.ph_hi = NPHASES;
    void* kargs[] = {&a};
    hipError_t e = hipLaunchCooperativeKernel((const void*)mk_fwd, dim3(grid), dim3(NTHREADS), kargs, LDS_BYTES, stream);
    if (e != hipSuccess) fprintf(stderr, "kernel_launch: cooperative launch failed: %s (grid %d)\n", hipGetErrorString(e), grid);
#else
    for (int p = 0; p < NPHASES; ++p) { a.ph_lo = p; a.ph_hi = p + 1; hipLaunchKernelGGL(mk_fwd, dim3(grid), dim3(NTHREADS), LDS_BYTES, stream, a); }
    hipError_t e = hipPeekAtLastError();
    if (e != hipSuccess) fprintf(stderr, "kernel_launch: launch failed: %s\n", hipGetErrorString(e));
#endif
}
```
